# Optimizing an MI355X kernel written in HIP

```python
import math
import jax
import jax.numpy as jnp
from jax import lax
import numpy as np

D_MODEL = 1024
BATCH = 2
SEQ = 8192
DEPTH = 2

N_MIXERS = 2
CONV_WIDTH = 3
N_HEADS = 8
HEAD_DIM = 64
V_DIM = 2 * HEAD_DIM
ROPE_THETA = 500000.0
ROT_DIM = HEAD_DIM // 4
Q_BLOCK = 128
D_FF = 2816
N_EXPERTS = 8
TOP_K = 2
D_FF_EXPERT = 3584
RMS_EPS = 1e-6
N_CONV_LAYERS = (DEPTH + 1) // 2
N_ATTN_LAYERS = DEPTH // 2

kernel_name = 'hybrid_shortconv_diffattn_moe_encoder'


def rmsnorm(x, g):
    xf = x.astype(jnp.float32)
    y = xf * lax.rsqrt(jnp.mean(xf * xf, axis=-1, keepdims=True) + RMS_EPS)
    return (y * g.astype(jnp.float32)).astype(x.dtype)


def swiglu(h, w1, w3, w2):
    return (jax.nn.silu(h @ w1) * (h @ w3)) @ w2


def short_conv_mixer(h, w_in, conv_w, w_out):
    S = h.shape[1]
    b_gate, c_gate, v = jnp.split(h @ w_in, 3, axis=-1)
    u = c_gate * v
    pad = CONV_WIDTH // 2
    up = jnp.pad(u, ((0, 0), (pad, pad), (0, 0)))
    conv = sum(up[:, j:j + S] * conv_w[j] for j in range(CONV_WIDTH))
    return (b_gate * conv) @ w_out


def rope_partial(t, cos, sin):
    half = ROT_DIM // 2
    t1 = t[..., :half]
    t2 = t[..., half:ROT_DIM]
    return jnp.concatenate([t1 * cos - t2 * sin, t2 * cos + t1 * sin, t[..., ROT_DIM:]], axis=-1)


def diff_attention(h, positions, w_in, q_norm, k_norm, lam_q1, lam_k1, lam_q2, lam_k2, subln, w_out, lambda_init):
    Bsz, S, _ = h.shape
    q, k, v = jnp.split(h @ w_in, 3, axis=-1)
    q = rmsnorm(q.reshape(Bsz, S, N_HEADS, 2, HEAD_DIM), q_norm)
    k = rmsnorm(k.reshape(Bsz, S, N_HEADS, 2, HEAD_DIM), k_norm)
    v = v.reshape(Bsz, S, N_HEADS, V_DIM)
    inv_freq = ROPE_THETA ** (-jnp.arange(0, ROT_DIM, 2, dtype=jnp.float32) / ROT_DIM)
    ang = positions.astype(jnp.float32)[..., None] * inv_freq
    cos = jnp.cos(ang)[:, :, None, None, :].astype(h.dtype)
    sin = jnp.sin(ang)[:, :, None, None, :].astype(h.dtype)
    q = rope_partial(q, cos, sin) * (HEAD_DIM ** -0.5)
    k = rope_partial(k, cos, sin)
    lam = (jnp.exp(jnp.sum(lam_q1.astype(jnp.float32) * lam_k1.astype(jnp.float32)))
           - jnp.exp(jnp.sum(lam_q2.astype(jnp.float32) * lam_k2.astype(jnp.float32)))
           + lambda_init)
    n_blk = S // Q_BLOCK
    qb = q.reshape(Bsz, n_blk, Q_BLOCK, N_HEADS, 2, HEAD_DIM).transpose(1, 0, 2, 3, 4, 5)

    def block(q_blk):
        s = jnp.einsum('bqhcd,bkhcd->bhcqk', q_blk, k).astype(jnp.float32)
        p = jax.nn.softmax(s, axis=-1)
        a = p[:, :, 0] - lam * p[:, :, 1]
        return jnp.einsum('bhqk,bkhe->bqhe', a.astype(v.dtype), v)

    o = lax.map(block, qb)
    o = o.transpose(1, 0, 2, 3, 4).reshape(Bsz, S, N_HEADS, V_DIM)
    o = rmsnorm(o, subln) * (1.0 - lambda_init)
    return o.reshape(Bsz, S, N_HEADS * V_DIM) @ w_out


def moe_swiglu(h, router, w1, w3, w2):
    Bsz, S, D = h.shape
    t = h.reshape(Bsz * S, D)
    logits = (t @ router).astype(jnp.float32)
    top_v, top_i = lax.top_k(logits, TOP_K)
    gates = jax.nn.softmax(top_v, axis=-1)
    combine = jnp.sum(jax.nn.one_hot(top_i, N_EXPERTS, dtype=jnp.float32) * gates[..., None], axis=1)
    out = jnp.zeros_like(t)
    for e in range(N_EXPERTS):
        out = out + combine[:, e:e + 1].astype(t.dtype) * swiglu(t, w1[e], w3[e], w2[e])
    return out.reshape(Bsz, S, D)


def setup_inputs(seed: int = 0) -> dict:
    key = jax.random.key(seed)
    ks = iter(jax.random.split(key, 32))
    D = D_MODEL
    QKV = 2 * N_HEADS * HEAD_DIM * 2 + N_HEADS * V_DIM

    def nrm(shape, scale):
        return jax.random.normal(next(ks), shape, jnp.float32) * scale

    def gain(shape):
        return 1.0 + 0.05 * jax.random.normal(next(ks), shape, jnp.float32)

    return {
        'x': jax.random.normal(next(ks), (BATCH, SEQ, D), jnp.float32),
        'positions': jnp.broadcast_to(jnp.arange(SEQ, dtype=jnp.int32), (BATCH, SEQ)),
        'norm_mix': gain((DEPTH, D)),
        'norm_ffn': gain((DEPTH, D)),
        'conv_in': nrm((N_CONV_LAYERS, D, 3 * D), D ** -0.5),
        'conv_w': nrm((N_CONV_LAYERS, CONV_WIDTH, D), CONV_WIDTH ** -0.5),
        'conv_out': nrm((N_CONV_LAYERS, D, D), D ** -0.5),
        'attn_in': nrm((N_ATTN_LAYERS, D, QKV), D ** -0.5),
        'q_norm': gain((N_ATTN_LAYERS, HEAD_DIM)),
        'k_norm': gain((N_ATTN_LAYERS, HEAD_DIM)),
        'lam_q1': nrm((N_ATTN_LAYERS, HEAD_DIM), 0.1),
        'lam_k1': nrm((N_ATTN_LAYERS, HEAD_DIM), 0.1),
        'lam_q2': nrm((N_ATTN_LAYERS, HEAD_DIM), 0.1),
        'lam_k2': nrm((N_ATTN_LAYERS, HEAD_DIM), 0.1),
        'subln': gain((N_ATTN_LAYERS, V_DIM)),
        'attn_out': nrm((N_ATTN_LAYERS, N_HEADS * V_DIM, D), (N_HEADS * V_DIM) ** -0.5),
        'ffn_w1': nrm((N_CONV_LAYERS, D, D_FF), D ** -0.5),
        'ffn_w3': nrm((N_CONV_LAYERS, D, D_FF), D ** -0.5),
        'ffn_w2': nrm((N_CONV_LAYERS, D_FF, D), D_FF ** -0.5),
        'router': nrm((N_ATTN_LAYERS, D, N_EXPERTS), D ** -0.5),
        'moe_w1': nrm((N_ATTN_LAYERS, N_EXPERTS, D, D_FF_EXPERT), D ** -0.5),
        'moe_w3': nrm((N_ATTN_LAYERS, N_EXPERTS, D, D_FF_EXPERT), D ** -0.5),
        'moe_w2': nrm((N_ATTN_LAYERS, N_EXPERTS, D_FF_EXPERT, D), D_FF_EXPERT ** -0.5),
    }


def reference(x, positions, norm_mix, norm_ffn, conv_in, conv_w, conv_out, attn_in, q_norm, k_norm,
              lam_q1, lam_k1, lam_q2, lam_k2, subln, attn_out, ffn_w1, ffn_w3, ffn_w2,
              router, moe_w1, moe_w3, moe_w2):
    for i in range(DEPTH):
        j = i // N_MIXERS
        h = rmsnorm(x, norm_mix[i])
        if i % N_MIXERS == 0:
            x = x + short_conv_mixer(h, conv_in[j], conv_w[j], conv_out[j])
        else:
            lambda_init = 0.8 - 0.6 * math.exp(-0.3 * i)
            x = x + diff_attention(h, positions, attn_in[j], q_norm[j], k_norm[j], lam_q1[j], lam_k1[j],
                                   lam_q2[j], lam_k2[j], subln[j], attn_out[j], lambda_init)
        h = rmsnorm(x, norm_ffn[i])
        f = i // 2
        if i % 2 == 0:
            x = x + swiglu(h, ffn_w1[f], ffn_w3[f], ffn_w2[f])
        else:
            x = x + moe_swiglu(h, router[f], moe_w1[f], moe_w3[f], moe_w2[f])
    return x
```

```cpp
#include <hip/hip_runtime.h>
#include <hip/hip_bf16.h>
#include <cstdio>
#include <cstdint>
namespace pg8 {
#define PG8_LAS __attribute__((address_space(3)))
typedef unsigned short bf16_t;
typedef short bf16x8 __attribute__((ext_vector_type(8)));
typedef float f32x4 __attribute__((ext_vector_type(4)));
typedef unsigned u32x4 __attribute__((ext_vector_type(4)));
typedef unsigned u32x2 __attribute__((ext_vector_type(2)));
typedef int v8i_t __attribute__((ext_vector_type(8)));
typedef int v4i_t __attribute__((ext_vector_type(4)));
__device__ __forceinline__ v8i_t cat8(bf16x8 a, bf16x8 b) { const v4i_t x = __builtin_bit_cast(v4i_t, a), y = __builtin_bit_cast(v4i_t, b); return (v8i_t){x[0], x[1], x[2], x[3], y[0], y[1], y[2], y[3]}; }
constexpr int BM = 256, BK = 64, HALF = 128, HTB = HALF * BK * 2  , STAGE_BYTES = 8 * HTB, NXCD = 8, WGM = 8;
constexpr float RMS_EPS = 1e-6f;

__host__ __device__ __forceinline__ int lds_byte(int r, int c) { const int st = (r >> 4) * 2 + (c >> 5), rr = r & 15, cc = c & 31, ob = rr * 64 + cc * 2; return st * 1024 + (ob ^ (((ob >> 9) & 1) << 5)); }
__host__ __device__ __forceinline__ void stage_rc(int b, int& R, int& C) { const int st = b / 1024, sb = b % 1024, swz = sb ^ (((sb >> 9) & 1) << 5); R = (st >> 1) * 16 + swz / 64; C = (st & 1) * 32 + (swz % 64) / 2; }
__host__ __device__ __forceinline__ int perm32(int rho) { const int n = rho >> 4, i = rho & 15; return 8 * (i >> 2) + 4 * n + (i & 3); }

struct Unit { int pm, pn, t, j, k0; };
struct Gemm { const bf16_t* A; const bf16_t* Bt; int M, N, K, ld; };

struct StaticOrder {
    int nM, nN, nwg, G, c;
    __host__ __device__ void init(int M, int N, int G_, int c_) { nM = M / BM; nN = N / BM; nwg = nM * nN; G = G_; c = c_; }
    __host__ __device__ bool next(int i, Unit& u) const {
        const long L = (long)i * G + c; if (L >= nwg) return false;
        int wgid = (int)L; { const int q = nwg / NXCD, r = nwg % NXCD, xcd = wgid % NXCD, off = wgid / NXCD; wgid = (xcd < r ? xcd * (q + 1) : r * (q + 1) + (xcd - r) * q) + off; }
        const int nig = WGM * nN, gid = wgid / nig, fm = gid * WGM, gsz = (nM - fm) < WGM ? (nM - fm) : WGM;
        u.pm = fm + ((wgid % nig) % gsz); u.pn = (wgid % nig) / gsz; u.t = u.pm; u.j = u.pn; u.k0 = 0; return true;
    }
    __device__ __forceinline__ void a_ready(const Unit&) const {}
    __device__ __forceinline__ void done(const Unit&) const {}
};
struct MoeOrder {
    StaticOrder so; int t0, nN, a_local; const PG8_LAS int* texp;
    __device__ void init(int ntc, int nN_, int G_, int c_, int t0_, int a_local_, const PG8_LAS int* texp_) { so.init(ntc * BM, nN_ * BM, G_, c_); t0 = t0_; nN = nN_; a_local = a_local_; texp = texp_; }
    __device__ __forceinline__ bool next(int i, Unit& u) const {
        if (!so.next(i, u)) return false;
        const int tl = u.pm; u.t = t0 + tl; u.j = u.pn; u.pm = a_local ? tl : u.t; u.pn = texp[u.t] * nN + u.j; u.k0 = 0; return true;
    }
    __device__ __forceinline__ void a_ready(const Unit&) const {}
    __device__ __forceinline__ void done(const Unit&) const {}
};

struct SplitOrder {
    int n, G, c, nsplit, ks, nN, t_first, a_first; const PG8_LAS int* texp;
    __device__ void init(int ntl, int nN_, int nsplit_, int ks_, int G_, int c_, int t_first_, int a_first_, const PG8_LAS int* texp_) { n = ntl * nN_ * nsplit_; G = G_; c = c_; nsplit = nsplit_; ks = ks_; nN = nN_; t_first = t_first_; a_first = a_first_; texp = texp_; }
    __device__ __forceinline__ bool next(int i, Unit& u) const {
        const int L = i * G + c; if (L >= n) return false;
        const int piece = L % nsplit, rest = L / nsplit, pn = rest % nN, tl = rest / nN;
        u.t = t_first + tl; u.j = pn; u.pm = a_first + tl; u.pn = texp[u.t] * nN + pn; u.k0 = piece * ks; return true;
    }
    __device__ __forceinline__ void a_ready(const Unit&) const {}
    __device__ __forceinline__ void done(const Unit&) const {}
};

__device__ __forceinline__ unsigned cvt_pk_bf16(float lo, float hi) { unsigned r; asm volatile("v_cvt_pk_bf16_f32 %0, %1, %2" : "=v"(r) : "v"(lo), "v"(hi)); return r; }
__device__ __forceinline__ float sum16(const float* p) {
    const f32x4 a = *(const f32x4*)p, b = *(const f32x4*)(p + 4), c = *(const f32x4*)(p + 8), d = *(const f32x4*)(p + 12);
    return (((a[0] + a[1]) + (a[2] + a[3])) + ((b[0] + b[1]) + (b[2] + b[3]))) + (((c[0] + c[1]) + (c[2] + c[3])) + ((d[0] + d[1]) + (d[2] + d[3])));
}
__device__ __forceinline__ float sum16x(const float* p, int fq) {
    const f32x4 a = *(const f32x4*)(p + 4 * fq); float s = (a[0] + a[1]) + (a[2] + a[3]);
    s += __shfl_xor(s, 32); s += __shfl_xor(s, 16); return s;
}
__device__ __forceinline__ float rstd_of(float ssq) { return __builtin_amdgcn_rsqf(ssq * (1.0f / 1024.0f) + RMS_EPS); }

template <int MODE> struct EpiRowBf16 {
    static constexpr bool PERM = true, AFTER_DRAIN = false;
    bf16_t* O; int ldc; const float* rowv; int ks; size_t piece_stride; int row_sub;
    __device__ __forceinline__ void operator()(const f32x4 (&acc)[2][2][4][2], const Unit& u, int wr, int wc, int fr, int fq) const {
        const int r0 = u.t * BM + wr * 64 + fr, col0 = u.j * BM + wc * 32 + 8 * fq;
        bf16_t* Ob = O; int rsub = 0; if (ks) { Ob += (size_t)(u.k0 / ks) * piece_stride; rsub = row_sub; }
        float sv[2][4];
#pragma unroll
        for (int ai = 0; ai < 2; ++ai)
#pragma unroll
            for (int m = 0; m < 4; ++m) sv[ai][m] = rowv[r0 + ai * HALF + m * 16];
        asm volatile("" ::: "memory");
#pragma unroll
        for (int ai = 0; ai < 2; ++ai)
#pragma unroll
            for (int m = 0; m < 4; ++m) { const int row = r0 + ai * HALF + m * 16; float s = sv[ai][m]; if (MODE == 0) s = rstd_of(s);
                bf16_t* rowp = Ob + (size_t)(row - rsub) * ldc + col0;
#pragma unroll
                for (int bj = 0; bj < 2; ++bj) { const f32x4 v0 = acc[ai][bj][m][0] * s, v1 = acc[ai][bj][m][1] * s;
                    u32x4 w; w.x = cvt_pk_bf16(v0[0], v0[1]); w.y = cvt_pk_bf16(v0[2], v0[3]); w.z = cvt_pk_bf16(v1[0], v1[1]); w.w = cvt_pk_bf16(v1[2], v1[3]);
                    *(u32x4*)(rowp + bj * HALF) = w; } }
    }
};
struct EpiResid {
    static constexpr bool PERM = true, AFTER_DRAIN = false;
    bf16_t* xb; float* ssqp;
    __device__ __forceinline__ void operator()(const f32x4 (&acc)[2][2][4][2], const Unit& u, int wr, int wc, int fr, int fq) const {
        const int r0 = u.pm * BM + wr * 64 + fr, col0 = u.pn * BM + wc * 32 + 8 * fq;
#pragma unroll
        for (int ai = 0; ai < 2; ++ai) {
            u32x4 pre[4][2];
#pragma unroll
            for (int m = 0; m < 4; ++m) { const size_t off = (size_t)(r0 + ai * HALF + m * 16) * 1024 + col0;
#pragma unroll
                for (int bj = 0; bj < 2; ++bj) pre[m][bj] = *(const u32x4*)(xb + off + bj * HALF); }
            asm volatile("" ::: "memory");
#pragma unroll
            for (int m = 0; m < 4; ++m) { const int row = r0 + ai * HALF + m * 16; const size_t off = (size_t)row * 1024 + col0; float ss = 0.f;
#pragma unroll
                for (int bj = 0; bj < 2; ++bj) { const u32x4 p = pre[m][bj]; float v[8];
#pragma unroll
                    for (int q = 0; q < 4; ++q) { v[2 * q] = __uint_as_float(p[q] << 16) + acc[ai][bj][m][q >> 1][(2 * q) & 3]; v[2 * q + 1] = __uint_as_float(p[q] & 0xffff0000u) + acc[ai][bj][m][q >> 1][(2 * q + 1) & 3]; }
                    u32x4 w; w.x = cvt_pk_bf16(v[0], v[1]); w.y = cvt_pk_bf16(v[2], v[3]); w.z = cvt_pk_bf16(v[4], v[5]); w.w = cvt_pk_bf16(v[6], v[7]);
                    *(u32x4*)(xb + off + bj * HALF) = w;
#pragma unroll
                    for (int q = 0; q < 8; ++q) ss += v[q] * v[q]; }
                if (ssqp) { ss += __shfl_xor(ss, 16); ss += __shfl_xor(ss, 32); if (fq == 0) ssqp[(size_t)row * 16 + u.pn * 4 + wc] = ss; } }
            asm volatile("" ::: "memory");
        }
    }
};
struct EpiConvIn {
    static constexpr bool PERM = true, AFTER_DRAIN = false;
    bf16_t* Bg; bf16_t* U; const float* ssq;
    __device__ __forceinline__ void operator()(const f32x4 (&acc)[2][2][4][2], const Unit& u, int wr, int wc, int fr, int fq) const {
        const int r0 = u.pm * BM + wr * 64 + fr;
        float sv[2][4];
#pragma unroll
        for (int ai = 0; ai < 2; ++ai)
#pragma unroll
            for (int m = 0; m < 4; ++m) sv[ai][m] = ssq[r0 + ai * HALF + m * 16];
        asm volatile("" ::: "memory");
        if (u.pn < 4) { const int col0 = u.pn * BM + wc * 32 + 8 * fq;
#pragma unroll
            for (int ai = 0; ai < 2; ++ai)
#pragma unroll
                for (int m = 0; m < 4; ++m) { const int row = r0 + ai * HALF + m * 16; const float s = rstd_of(sv[ai][m]);
                    bf16_t* rowp = Bg + (size_t)row * 1024 + col0;
#pragma unroll
                    for (int bj = 0; bj < 2; ++bj) { const f32x4 v0 = acc[ai][bj][m][0] * s, v1 = acc[ai][bj][m][1] * s;
                        u32x4 w; w.x = cvt_pk_bf16(v0[0], v0[1]); w.y = cvt_pk_bf16(v0[2], v0[3]); w.z = cvt_pk_bf16(v1[0], v1[1]); w.w = cvt_pk_bf16(v1[2], v1[3]);
                        *(u32x4*)(rowp + bj * HALF) = w; } }
        } else { const int col0 = (u.pn - 4) * HALF + wc * 32 + 8 * fq;
#pragma unroll
            for (int ai = 0; ai < 2; ++ai)
#pragma unroll
                for (int m = 0; m < 4; ++m) { const int row = r0 + ai * HALF + m * 16; const float s = rstd_of(sv[ai][m]), s2 = s * s;
                    const f32x4 h0 = (acc[ai][0][m][0] * acc[ai][1][m][0]) * s2, h1 = (acc[ai][0][m][1] * acc[ai][1][m][1]) * s2;
                    u32x4 w; w.x = cvt_pk_bf16(h0[0], h0[1]); w.y = cvt_pk_bf16(h0[2], h0[3]); w.z = cvt_pk_bf16(h1[0], h1[1]); w.w = cvt_pk_bf16(h1[2], h1[3]);
                    *(u32x4*)(U + (size_t)row * 1024 + col0) = w; }
        }
    }
};
typedef float f32x2v __attribute__((ext_vector_type(2)));
template <int MODE, bool OUT8 = false> struct EpiSwiGLU {
    static constexpr bool PERM = true, AFTER_DRAIN = false;
    bf16_t* H; int ldh; const float* rowv; int t0; float oscale;
    __device__ __forceinline__ void operator()(const f32x4 (&acc)[2][2][4][2], const Unit& u, int wr, int wc, int fr, int fq) const {
        const int rl0 = wr * 64 + fr, col0 = u.j * HALF + wc * 32 + 8 * fq;
        float sv[2][4];
        if constexpr (MODE == 0) { f32x4 pq[2][4];
#pragma unroll
            for (int ai = 0; ai < 2; ++ai)
#pragma unroll
                for (int m = 0; m < 4; ++m) pq[ai][m] = *(const f32x4*)(rowv + (size_t)(u.t * BM + rl0 + ai * HALF + m * 16) * 16 + 4 * fq);
#pragma unroll
            for (int ai = 0; ai < 2; ++ai)
#pragma unroll
                for (int m = 0; m < 4; ++m) { const f32x4 a = pq[ai][m]; float q = (a[0] + a[1]) + (a[2] + a[3]); q += __shfl_xor(q, 32); q += __shfl_xor(q, 16); sv[ai][m] = rstd_of(q); }
        } else {
#pragma unroll
            for (int ai = 0; ai < 2; ++ai)
#pragma unroll
                for (int m = 0; m < 4; ++m) sv[ai][m] = rowv[u.t * BM + rl0 + ai * HALF + m * 16];
        }
        asm volatile("" ::: "memory");
#pragma unroll
        for (int ai = 0; ai < 2; ++ai)
#pragma unroll
            for (int m = 0; m < 4; ++m) { const int rl = rl0 + ai * HALF + m * 16;
                const float s = sv[ai][m];
                const float sn = -1.4426950408889634f * s, s2 = OUT8 ? s * s * oscale : s * s;
                const f32x2v sn2 = {sn, sn}, so2 = {s2, s2}, one2 = {1.0f, 1.0f};
                float h[8];
#pragma unroll
                for (int n = 0; n < 2; ++n)
#pragma unroll
                    for (int q = 0; q < 2; ++q) { const f32x4 A = acc[ai][0][m][n], B = acc[ai][1][m][n];
                        const f32x2v a2 = {A[2 * q], A[2 * q + 1]}, b2 = {B[2 * q], B[2 * q + 1]};
                        const f32x2v t2 = a2 * sn2; f32x2v e2; e2.x = __builtin_amdgcn_exp2f(t2.x); e2.y = __builtin_amdgcn_exp2f(t2.y);
                        const f32x2v d2 = e2 + one2; f32x2v r2; r2.x = __builtin_amdgcn_rcpf(d2.x); r2.y = __builtin_amdgcn_rcpf(d2.y);
                        const f32x2v h2 = (a2 * b2) * (r2 * so2); h[n * 4 + 2 * q] = h2.x; h[n * 4 + 2 * q + 1] = h2.y; }
                if constexpr (OUT8) { int p0 = 0, p1 = 0;
                    p0 = __builtin_amdgcn_cvt_pk_fp8_f32(h[0], h[1], p0, false); p0 = __builtin_amdgcn_cvt_pk_fp8_f32(h[2], h[3], p0, true);
                    p1 = __builtin_amdgcn_cvt_pk_fp8_f32(h[4], h[5], p1, false); p1 = __builtin_amdgcn_cvt_pk_fp8_f32(h[6], h[7], p1, true);
                    u32x2 w; w.x = (unsigned)p0; w.y = (unsigned)p1; *(u32x2*)((unsigned char*)H + (size_t)((u.t - t0) * BM + rl) * ldh + col0) = w; }
                else { u32x4 w; w.x = cvt_pk_bf16(h[0], h[1]); w.y = cvt_pk_bf16(h[2], h[3]); w.z = cvt_pk_bf16(h[4], h[5]); w.w = cvt_pk_bf16(h[6], h[7]);
                    *(u32x4*)(H + (size_t)((u.t - t0) * BM + rl) * ldh + col0) = w; } }
    }
};
constexpr float QSCALE = 0.125f * 1.4426950408889634f;
struct EpiQKV {
    static constexpr bool PERM = true, AFTER_DRAIN = false;
    bf16_t* O; bf16_t* KH; bf16_t* VH; const float* ssqp; const PG8_LAS float* gtab; const float* rope;
    __device__ __forceinline__ void operator()(const f32x4 (&acc)[2][2][4][2], const Unit& u, int wr, int wc, int fr, int fq) const {
        const int type = u.pn >> 2;
        const PG8_LAS float* gn = gtab + (type == 0 ? 0 : 64) + 8 * fq;
        const int r0 = u.pm * BM + wr * 64 + fr, col0 = u.pn * BM + 64 * wc + 8 * fq;
        const float sg = fq == 0 ? -1.f : 1.f;
        float rsv[2][4];
        { f32x4 pq[2][4];
#pragma unroll
          for (int ai = 0; ai < 2; ++ai)
#pragma unroll
              for (int m = 0; m < 4; ++m) { const size_t row = (size_t)(r0 + ai * HALF + m * 16); pq[ai][m] = *(const f32x4*)(ssqp + row * 16 + 4 * fq); }
#pragma unroll
          for (int ai = 0; ai < 2; ++ai)
#pragma unroll
              for (int m = 0; m < 4; ++m) { const f32x4 a = pq[ai][m]; float q = (a[0] + a[1]) + (a[2] + a[3]); q += __shfl_xor(q, 32); q += __shfl_xor(q, 16); rsv[ai][m] = rstd_of(q); } }
        asm volatile("" ::: "memory");
        const int lfr = fr;
#pragma unroll
        for (int ai = 0; ai < 2; ++ai) {
            f32x4 rq[4];
            if (type < 2) {
#pragma unroll
                for (int m = 0; m < 4; ++m) rq[m] = *(const f32x4*)(rope + (size_t)(r0 + ai * HALF + m * 16) * 16 + 4 * fq); }
            asm volatile("" ::: "memory");
#pragma unroll
            for (int m = 0; m < 4; ++m) { const int row = r0 + ai * HALF + m * 16; const float rs = rsv[ai][m];
                f32x4 v[2][2];
                if (type < 2) {
                    float ss = 0.f;
#pragma unroll
                    for (int bj = 0; bj < 2; ++bj)
#pragma unroll
                        for (int n = 0; n < 2; ++n) { const f32x4 a = acc[ai][bj][m][n]; ss += (a[0] * a[0] + a[1] * a[1]) + (a[2] * a[2] + a[3] * a[3]); }
                    ss += __shfl_xor(ss, 16); ss += __shfl_xor(ss, 32);
                    const float sc = rs * __builtin_amdgcn_rsqf(ss * (rs * rs * (1.0f / 64.0f)) + RMS_EPS);
#pragma unroll
                    for (int bj = 0; bj < 2; ++bj)
#pragma unroll
                        for (int n = 0; n < 2; ++n) v[bj][n] = acc[ai][bj][m][n] * (*(const PG8_LAS f32x4*)(gn + 32 * bj + 4 * n) * sc);
                    f32x4 p[2];
#pragma unroll
                    for (int n = 0; n < 2; ++n)
#pragma unroll
                        for (int e = 0; e < 4; ++e) p[n][e] = __shfl_xor(v[0][n][e], 16);
                    { const f32x4 mine = rq[m];
#pragma unroll
                      for (int n = 0; n < 2; ++n) { f32x4 c_, s_;
#pragma unroll
                          for (int e = 0; e < 4; ++e) { c_[e] = __shfl(mine[e], 16 * n + lfr); s_[e] = __shfl(mine[e], 32 + 16 * n + lfr); }
                          if (fq < 2) v[0][n] = v[0][n] * c_ + (p[n] * s_) * sg; } }
                } else {
#pragma unroll
                    for (int bj = 0; bj < 2; ++bj)
#pragma unroll
                        for (int n = 0; n < 2; ++n) v[bj][n] = acc[ai][bj][m][n] * rs;
                }
                if (type < 2) {
                    unsigned char* rowp8; if (type == 0) rowp8 = (unsigned char*)O + (size_t)row * 1024 + col0;
                    else { const int hh = 2 * (u.pn & 3) + (wc >> 1), bb = row >> 13, ss_ = row & 8191; rowp8 = (unsigned char*)KH + ((size_t)(bb * 8 + hh) * 8192 + ss_) * 128 + (wc & 1) * 64 + 8 * fq; }
#pragma unroll
                    for (int bj = 0; bj < 2; ++bj) { int p0 = 0, p1 = 0;
                        p0 = __builtin_amdgcn_cvt_pk_fp8_f32(v[bj][0][0], v[bj][0][1], p0, false); p0 = __builtin_amdgcn_cvt_pk_fp8_f32(v[bj][0][2], v[bj][0][3], p0, true);
                        p1 = __builtin_amdgcn_cvt_pk_fp8_f32(v[bj][1][0], v[bj][1][1], p1, false); p1 = __builtin_amdgcn_cvt_pk_fp8_f32(v[bj][1][2], v[bj][1][3], p1, true);
                        u32x2 w; w.x = (unsigned)p0; w.y = (unsigned)p1; *(u32x2*)(rowp8 + 32 * bj) = w; }
                } else {
                    const int hh = 2 * (u.pn & 3) + (wc >> 1), bb = row >> 13, ss_ = row & 8191, tt = ss_ >> 6;
                    const int kk = 16 * (m & 1) + fr, pos = 32 * ((kk >> 2) & 1) + (kk & 3) + 4 * (kk >> 3) + 16 * (m >> 1);
                    unsigned char* tb = (unsigned char*)VH + (((size_t)(bb * 8 + hh) * 128 + tt) * 128 + (wc & 1) * 64 + 8 * fq) * 64 + pos;
#pragma unroll
                    for (int bj = 0; bj < 2; ++bj)
#pragma unroll
                        for (int n = 0; n < 2; ++n) { int pk = 0; pk = __builtin_amdgcn_cvt_pk_fp8_f32(v[bj][n][0], v[bj][n][1], pk, false); pk = __builtin_amdgcn_cvt_pk_fp8_f32(v[bj][n][2], v[bj][n][3], pk, true);
#pragma unroll
                            for (int e = 0; e < 4; ++e) tb[(32 * bj + 4 * n + e) * 64] = (unsigned char)((unsigned)pk >> (8 * e)); }
                } }
        }
    }
};

template <class Epi, class Sched, bool ALIGN_EPI = false, bool SP2 = false, bool F8 = false>
__device__ __forceinline__ void gemm_phase(PG8_LAS unsigned char* lds, const Gemm g, const Sched& S, const Epi& E) {
    int tid = threadIdx.x; asm volatile("" : "+v"(tid));
    const int wid = __builtin_amdgcn_readfirstlane(tid >> 6), lane = tid & 63, wr = wid >> 2, wc = wid & 3, fr = lane & 15, fq = lane >> 4;
    const int K = g.K, nt = K / BK, LD = g.ld ? g.ld : g.K;
    unsigned voffA[2], voffB[2];
#pragma unroll
    for (int i = 0; i < 2; ++i) { int R, C; stage_rc(tid * 16 + i * 8192, R, C); const int Rb = Epi::PERM ? ((R & ~31) + perm32(R & 31)) : R;
        voffA[i] = (unsigned)(R * LD + C) * 2u; voffB[i] = (unsigned)(Rb * LD + C) * 2u; }
    const size_t kstep = (size_t)(BK * 2);
    const size_t hstep = (size_t)HALF * LD * 2;
    const size_t tstep = 2 * hstep;
    const unsigned ldsw = (unsigned)wid * 1024u;
    const int aoff = lds_byte(wr * 64 + fr, fq * 8), boff = lds_byte(wc * 32 + fr, fq * 8);
#define PG8_SA(b, h) (((b) * 2 + (h)) * HTB)
#define PG8_SB(b, h) ((4 + (b) * 2 + (h)) * HTB)
#define PG8_STAGE(bufoff, gbase, voff) do { _Pragma("unroll") for (int _i = 0; _i < 2; ++_i) \
        __builtin_amdgcn_global_load_lds((const unsigned*)((const char*)(gbase) + (voff)[_i]), (PG8_LAS unsigned*)(lds + (bufoff) + ldsw + _i * 8192), 16, 0, 0); } while (0)
#define PG8_LDA(dst, b, h) do { if constexpr (F8) { _Pragma("unroll") for (int m = 0; m < 4; ++m) { const v4i_t x_ = *(const PG8_LAS v4i_t*)(lds + PG8_SA(b, h) + aoff + m * 2048), y_ = *(const PG8_LAS v4i_t*)(lds + PG8_SA(b, h) + aoff + m * 2048 + 1024); \
        dst##8[m] = (v8i_t){x_[0], x_[1], x_[2], x_[3], y_[0], y_[1], y_[2], y_[3]}; } } \
    else { _Pragma("unroll") for (int m = 0; m < 4; ++m) _Pragma("unroll") for (int k = 0; k < 2; ++k) dst[m][k] = *(const PG8_LAS bf16x8*)(lds + PG8_SA(b, h) + aoff + m * 2048 + k * 1024); } } while (0)
#define PG8_LDB(dst, b, h) do { if constexpr (F8) { _Pragma("unroll") for (int n = 0; n < 2; ++n) { const v4i_t x_ = *(const PG8_LAS v4i_t*)(lds + PG8_SB(b, h) + boff + n * 2048), y_ = *(const PG8_LAS v4i_t*)(lds + PG8_SB(b, h) + boff + n * 2048 + 1024); \
        dst##8[n] = (v8i_t){x_[0], x_[1], x_[2], x_[3], y_[0], y_[1], y_[2], y_[3]}; } } \
    else { _Pragma("unroll") for (int n = 0; n < 2; ++n) _Pragma("unroll") for (int k = 0; k < 2; ++k) dst[n][k] = *(const PG8_LAS bf16x8*)(lds + PG8_SB(b, h) + boff + n * 2048 + k * 1024); } } while (0)
#define PG8_MMA(ai, bj, At, Bt) do { if constexpr (F8) __builtin_amdgcn_sched_barrier(0); __builtin_amdgcn_s_setprio(1); \
    if constexpr (F8) { _Pragma("unroll") for (int m = 0; m < 4; ++m) _Pragma("unroll") for (int n = 0; n < 2; ++n) \
        asm volatile("v_mfma_scale_f32_16x16x128_f8f6f4 %0, %1, %2, %0, %3, %3 op_sel_hi:[0,0,0]" : "+v"(acc[ai][bj][m][n]) : "v"(Bt##8[n]), "v"(At##8[m]), "v"(sc8_)); } \
    else { _Pragma("unroll") for (int m = 0; m < 4; ++m) _Pragma("unroll") for (int n = 0; n < 2; ++n) _Pragma("unroll") for (int k = 0; k < 2; ++k) \
        acc[ai][bj][m][n] = __builtin_amdgcn_mfma_f32_16x16x32_bf16(Bt[n][k], At[m][k], acc[ai][bj][m][n], 0, 0, 0); } \
    __builtin_amdgcn_s_setprio(0); if constexpr (F8) __builtin_amdgcn_sched_barrier(0); } while (0)
#define PG8_WAIT_V(n) asm volatile("s_waitcnt vmcnt(" #n ")" ::: "memory")
#define PG8_WAIT_L(n) asm volatile("s_waitcnt lgkmcnt(" #n ")" ::: "memory")
#define PG8_BAR __builtin_amdgcn_s_barrier()
#define PG8_SCHED __builtin_amdgcn_sched_barrier(0)
    Unit cur, nxt; int ui = 0;
    if (!S.next(0, cur)) return;
    f32x4 acc[2][2][4][2];
#pragma unroll
    for (int a = 0; a < 2; ++a)
#pragma unroll
        for (int b = 0; b < 2; ++b)
#pragma unroll
            for (int m = 0; m < 4; ++m)
#pragma unroll
                for (int n = 0; n < 2; ++n) acc[a][b][m][n] = (f32x4){0.f, 0.f, 0.f, 0.f};
    const int sc8_ = 0x7f7f7f7f;
    bf16x8 At[4][2], B0[2][2], B1[2][2]; v8i_t At8[4], B08[2], B18[2];
    const char* cA = (const char*)g.A + (size_t)cur.pm * tstep + (size_t)cur.k0 * 2; const char* cB = (const char*)g.Bt + (size_t)cur.pn * tstep + (size_t)cur.k0 * 2;
    S.a_ready(cur);
    if constexpr (SP2) {
        PG8_STAGE(PG8_SB(0, 0), cB, voffB); PG8_STAGE(PG8_SB(0, 1), cB + hstep, voffB); PG8_STAGE(PG8_SA(0, 0), cA, voffA); PG8_STAGE(PG8_SA(0, 1), cA + hstep, voffA);
        if (wr == 1) PG8_BAR;
        PG8_WAIT_V(2); PG8_BAR;
        PG8_STAGE(PG8_SB(1, 0), cB + kstep, voffB); PG8_STAGE(PG8_SA(1, 0), cA + kstep, voffA); PG8_STAGE(PG8_SB(1, 1), cB + hstep + kstep, voffB);
        PG8_WAIT_V(6); PG8_BAR;
    } else {
        PG8_STAGE(PG8_SB(0, 0), cB, voffB); PG8_STAGE(PG8_SA(0, 0), cA, voffA); PG8_STAGE(PG8_SB(0, 1), cB + hstep, voffB); PG8_STAGE(PG8_SA(0, 1), cA + hstep, voffA);
        if (wr == 1) PG8_BAR;
        PG8_WAIT_V(4); PG8_BAR;
        PG8_STAGE(PG8_SB(1, 0), cB + kstep, voffB); PG8_STAGE(PG8_SA(1, 0), cA + kstep, voffA); PG8_STAGE(PG8_SB(1, 1), cB + hstep + kstep, voffB);
        PG8_WAIT_V(6); PG8_BAR;
    }
    for (;;) {
        const bool has_next = S.next(ui + 1, nxt);
        const char* nA = has_next ? (const char*)g.A + (size_t)nxt.pm * tstep + (size_t)nxt.k0 * 2 : cA; const char* nB = has_next ? (const char*)g.Bt + (size_t)nxt.pn * tstep + (size_t)nxt.k0 * 2 : cB;
#pragma clang loop unroll(disable)
        for (int t = 0; t < nt; t += 2) {
            const bool last = (t == nt - 2);
            const char* a1 = cA + (size_t)(t + 1) * kstep;
            const char* a2 = last ? nA : cA + (size_t)(t + 2) * kstep; const char* b2 = last ? nB : cB + (size_t)(t + 2) * kstep;
            const char* a3 = a2 + kstep; const char* b3 = b2 + kstep;
            if (last && has_next) S.a_ready(nxt);
            if constexpr (SP2) {
            PG8_LDB(B0, 0, 0); PG8_LDB(B1, 0, 1); PG8_SCHED; PG8_LDA(At, 0, 0); PG8_STAGE(PG8_SA(1, 1), a1 + hstep, voffA);
            PG8_WAIT_V(8); PG8_WAIT_L(0); PG8_BAR; PG8_MMA(0, 0, At, B0); PG8_MMA(0, 1, At, B1); PG8_BAR; PG8_SCHED;
            PG8_LDA(At, 0, 1); PG8_STAGE(PG8_SB(0, 0), b2, voffB); PG8_STAGE(PG8_SB(0, 1), b2 + hstep, voffB); PG8_STAGE(PG8_SA(0, 0), a2, voffA);
            PG8_WAIT_V(8); PG8_WAIT_L(0); PG8_BAR; PG8_MMA(1, 0, At, B0); PG8_MMA(1, 1, At, B1); PG8_BAR; PG8_SCHED;
            PG8_LDB(B0, 1, 0); PG8_LDB(B1, 1, 1); PG8_SCHED; PG8_LDA(At, 1, 0); PG8_STAGE(PG8_SA(0, 1), a2 + hstep, voffA);
            PG8_WAIT_V(8); PG8_WAIT_L(0); PG8_BAR; PG8_MMA(0, 0, At, B0); PG8_MMA(0, 1, At, B1); PG8_BAR; PG8_SCHED;
            PG8_LDA(At, 1, 1); PG8_STAGE(PG8_SB(1, 0), b3, voffB); PG8_STAGE(PG8_SB(1, 1), b3 + hstep, voffB); PG8_STAGE(PG8_SA(1, 0), a3, voffA);
            PG8_WAIT_V(8); PG8_WAIT_L(0); PG8_BAR; PG8_MMA(1, 0, At, B0); PG8_MMA(1, 1, At, B1); PG8_BAR; PG8_SCHED;
            } else {
            PG8_LDB(B0, 0, 0); PG8_SCHED; PG8_LDA(At, 0, 0); PG8_STAGE(PG8_SA(1, 1), a1 + hstep, voffA);
            PG8_WAIT_L(8); PG8_BAR; PG8_WAIT_L(0); PG8_MMA(0, 0, At, B0); PG8_BAR; PG8_SCHED;
            PG8_LDB(B1, 0, 1); PG8_STAGE(PG8_SB(0, 0), b2, voffB);
            PG8_BAR; PG8_WAIT_L(0); PG8_MMA(0, 1, At, B1); PG8_BAR;
            PG8_LDA(At, 0, 1); PG8_STAGE(PG8_SA(0, 0), a2, voffA);
            PG8_BAR; PG8_WAIT_L(0); PG8_MMA(1, 0, At, B0); PG8_BAR; PG8_SCHED;
            PG8_STAGE(PG8_SB(0, 1), b2 + hstep, voffB);
            PG8_WAIT_V(6); PG8_BAR; PG8_MMA(1, 1, At, B1); PG8_BAR;
            PG8_LDB(B0, 1, 0); PG8_SCHED; PG8_LDA(At, 1, 0); PG8_STAGE(PG8_SA(0, 1), a2 + hstep, voffA);
            PG8_WAIT_L(8); PG8_BAR; PG8_WAIT_L(0); PG8_MMA(0, 0, At, B0); PG8_BAR; PG8_SCHED;
            PG8_LDB(B1, 1, 1); PG8_STAGE(PG8_SB(1, 0), b3, voffB);
            PG8_BAR; PG8_WAIT_L(0); PG8_MMA(0, 1, At, B1); PG8_BAR;
            PG8_LDA(At, 1, 1); PG8_STAGE(PG8_SA(1, 0), a3, voffA);
            PG8_BAR; PG8_WAIT_L(0); PG8_MMA(1, 0, At, B0); PG8_BAR; PG8_SCHED;
            PG8_STAGE(PG8_SB(1, 1), b3 + hstep, voffB);
            PG8_WAIT_V(6); PG8_BAR; PG8_MMA(1, 1, At, B1); PG8_BAR;
            }
        }
        if constexpr (F8) asm volatile("s_nop 15\n\ts_nop 15" ::: "memory");
        if constexpr (ALIGN_EPI) { if (wr == 0) PG8_BAR; }
        if constexpr (!Epi::AFTER_DRAIN) { E(acc, cur, wr, wc, fr, fq); S.done(cur); }
        if (!has_next) break;
#pragma unroll
        for (int a = 0; a < 2; ++a)
#pragma unroll
            for (int b = 0; b < 2; ++b)
#pragma unroll
                for (int m = 0; m < 4; ++m)
#pragma unroll
                    for (int n = 0; n < 2; ++n) acc[a][b][m][n] = (f32x4){0.f, 0.f, 0.f, 0.f};
        cur = nxt; cA = nA; cB = nB; ++ui;
        if constexpr (ALIGN_EPI) { if (wr == 1) PG8_BAR; }
    }
    PG8_WAIT_V(0);
    if constexpr (!ALIGN_EPI) { if (wr == 0) PG8_BAR; }
    PG8_BAR;
    if constexpr (Epi::AFTER_DRAIN) { E.fused(acc, cur, wr, wc, fr, fq, lds, wid, lane); S.done(cur); }
#undef PG8_SA
#undef PG8_SB
#undef PG8_STAGE
#undef PG8_LDA
#undef PG8_LDB
#undef PG8_MMA
#undef PG8_WAIT_V
#undef PG8_WAIT_L
#undef PG8_BAR
#undef PG8_SCHED
}
}

namespace dattn {
using bf16x8 = __attribute__((ext_vector_type(8))) short;
using s16x4  = __attribute__((ext_vector_type(4))) short;
using f32x16 = __attribute__((ext_vector_type(16))) float;
using u32x4  = __attribute__((ext_vector_type(4))) unsigned;
typedef unsigned short bf16_t;
typedef __attribute__((address_space(3))) const char* lds_cptr;
typedef short v4i16_t __attribute__((ext_vector_type(4)));
typedef int v8i_t __attribute__((ext_vector_type(8)));
typedef int v4i_t __attribute__((ext_vector_type(4)));
constexpr int SEQ = 8192, LDQ = 1024, LDR = 128, KVBLK = 64, NT = SEQ / KVBLK;
constexpr int SLOT_B = 16384, NSLOT = 4, V_IN_SLOT = 8192;
constexpr int OFF_COMB = 0, OFF_STG = 65536, OFF_WS = 131072, ATTN_LDS_BYTES = OFF_WS + 8 * 64 * 4;
#define KSWZ(row, colB) ((row) * 256 + ((colB) ^ (((row) & 7) << 4)))
#define SBAR() __builtin_amdgcn_sched_barrier(0)
__device__ __forceinline__ int crow(int r, int hi) { return (r & 3) + 8 * (r >> 2) + 4 * hi; }
__device__ __forceinline__ unsigned cvtpk(float lo, float hi) { unsigned r; asm volatile("v_cvt_pk_bf16_f32 %0, %1, %2" : "=v"(r) : "v"(lo), "v"(hi)); return r; }
__device__ __forceinline__ void glds16(const void* gsrc, unsigned lds_dst) { unsigned keep;
  asm volatile("s_mov_b32 %0, m0\n\ts_mov_b32 m0, %2\n\ts_nop 0\n\tglobal_load_lds_dwordx4 %1, off\n\ts_mov_b32 m0, %0" : "=&s"(keep) : "v"(gsrc), "s"(lds_dst) : "memory"); }
__device__ __forceinline__ s16x4 vtr(lds_cptr p) { return __builtin_bit_cast(s16x4, __builtin_amdgcn_ds_read_tr16_b64_v4i16((__attribute__((address_space(3))) v4i16_t*)p)); }
__device__ __forceinline__ v8i_t kfrag32(lds_cptr p0, lds_cptr p1) { const v4i_t x_ = *(const __attribute__((address_space(3))) v4i_t*)p0, y_ = *(const __attribute__((address_space(3))) v4i_t*)p1; return (v8i_t){x_[0], x_[1], x_[2], x_[3], y_[0], y_[1], y_[2], y_[3]}; }
__device__ __forceinline__ int v_rd_base(int lane) { return ((lane & 3) << 3) | (((lane >> 2) & 3) << 6) | (((lane >> 4) & 1) << 5) | (((lane >> 5) & 1) << 8); }
constexpr int v_rd_off(int d0, int ks, int half) { return d0 * 512 + ks * 4096 + half * 2048; }
#define WAIT_BAR(N) asm volatile("s_waitcnt vmcnt(" #N ") lgkmcnt(0)\n\ts_barrier" ::: "memory")
#define MF(A, B, C) __builtin_amdgcn_mfma_f32_32x32x16_bf16(A, B, C, 0, 0, 0)
typedef short v2s_t __attribute__((ext_vector_type(2)));
typedef float v4f_t __attribute__((ext_vector_type(4)));
__device__ __forceinline__ void glds_kv(const void* kbase, const void* vbase, unsigned koff, unsigned voff, unsigned lds_k, unsigned lds_v) { unsigned keep;
  asm volatile("s_mov_b32 %0, m0\n\ts_mov_b32 m0, %5\n\ts_nop 0\n\tglobal_load_lds_dwordx4 %1, %3\n\ts_mov_b32 m0, %6\n\ts_nop 0\n\tglobal_load_lds_dwordx4 %2, %4\n\ts_mov_b32 m0, %0"
               : "=&s"(keep) : "v"(koff), "v"(voff), "s"(kbase), "s"(vbase), "s"(lds_k), "s"(lds_v) : "memory"); }
__device__ __forceinline__ int pk4_bf8(float a, float b, float c, float d) { int r;
  asm("v_cvt_scalef32_pk_bf8_f32 %0, %1, %2, %3" : "=v"(r) : "v"(a), "v"(b), "s"(16.0f));
  asm("v_cvt_scalef32_pk_bf8_f32 %0, %1, %2, %3 op_sel:[0,0,0,1]" : "+v"(r) : "v"(c), "v"(d), "s"(16.0f)); return r; }
#define PK8(P, B, W0, W1) do { W0 = pk4_bf8(P[B], P[B + 1], P[B + 2], P[B + 3]); W1 = pk4_bf8(P[B + 4], P[B + 5], P[B + 6], P[B + 7]); } while (0)
__device__ __forceinline__ float fadd_s(float a, float b) { float r; asm("v_add_f32_e32 %0, %1, %2" : "=v"(r) : "v"(a), "v"(b)); return r; }
#define SUM8(P, B) fadd_s(fadd_s(fadd_s(P[B], P[B + 1]), fadd_s(P[B + 2], P[B + 3])), fadd_s(fadd_s(P[B + 4], P[B + 5]), fadd_s(P[B + 6], P[B + 7])))
__device__ __forceinline__ bf16x8 vfrag(lds_cptr vp, int off0, int off1) { const s16x4 l_ = vtr(vp + off0), h_ = vtr(vp + off1); return (bf16x8){l_[0], l_[1], l_[2], l_[3], h_[0], h_[1], h_[2], h_[3]}; }
#define VFRAG(d0, ks) vfrag(vp_, v_rd_off(d0, ks, 0), v_rd_off(d0, ks, 1))

template <bool SHIFT> __device__ __forceinline__ void attn_unit(int b, int h, int qb, const unsigned char* __restrict__ Q8, const unsigned char* __restrict__ KH8, const unsigned char* __restrict__ VT8, bf16_t* __restrict__ O, float lam, float negmb, float osc, const float* __restrict__ subg, char* lds) {
  int tid = threadIdx.x; asm volatile("" : "+v"(tid));
  const int lane = tid & 63, r32 = lane & 31, hi = lane >> 5; const int wid = __builtin_amdgcn_readfirstlane(tid >> 6);
  const int comp = wid >> 2, qs = wid & 3;
  const unsigned lds0 = (unsigned)(uintptr_t)lds; const lds_cptr lds3 = (lds_cptr)lds;
  float* wsf = (float*)(lds + OFF_WS) + wid * 64;
  const long rowbase = (long)b * SEQ; const int q0 = qb * 128;
  const unsigned char* Kh = KH8 + (long)(b * 8 + h) * SEQ * 128; const unsigned char* Vh = VT8 + (long)(b * 8 + h) * SEQ * 128;
  int kso, vso;
  { const int row = 8 * wid + (lane >> 3), ch = (lane & 7) ^ ((row >> 1) & 7); kso = row * 128 + ch * 16; }
  { const int d = 16 * wid + (lane >> 2), ch = (lane & 3) ^ ((d >> 2) & 3); vso = d * 64 + ch * 16; }
  const unsigned ldsw = (unsigned)__builtin_amdgcn_readfirstlane(lds0 + wid * 1024);
#define DMA_TILE(t, slotoff) do { const long tb_ = (long)(t) * (KVBLK * 128); glds_kv(Kh + tb_, Vh + tb_, kso, vso, ldsw + (slotoff), ldsw + (slotoff) + V_IN_SLOT); } while (0)
  v8i_t qf;
  { const v4i_t* Qw = (const v4i_t*)(Q8 + (rowbase + q0 + qs * 32 + r32) * 1024 + h * 128 + comp * 64 + hi * 32); const v4i_t x_ = Qw[0], y_ = Qw[1];
    qf = (v8i_t){x_[0], x_[1], x_[2], x_[3], y_[0], y_[1], y_[2], y_[3]}; }
  const int scK = 0x7f7f7f7f, scQ = 0x7b7b7b7b, scP = (int)0x83838383u;
  asm volatile("" ::: "memory");
  DMA_TILE(0, 0); DMA_TILE(1, SLOT_B); DMA_TILE(2, 2 * SLOT_B);
  const int ob_ = ((lane & 15) == ((lane >> 4) & 1)) ? 0x22222222 : 0; const v4i_t onesB = {ob_, ob_, ob_, ob_};
  v4f_t Lacc = {0.f, 0.f, 0.f, 0.f};
#define MFL(PF) asm volatile("v_mfma_scale_f32_16x16x128_f8f6f4 %0, %1, %2, %0, %3, %4 op_sel_hi:[0,0,0] cbsz:1 blgp:4" : "+v"(Lacc) : "v"(PF), "v"(onesB), "v"(scP), "v"(scK))
  const int ka0 = r32 * 128 + (((comp * 4 + 2 * hi) ^ ((r32 >> 1) & 7)) << 4), ka1 = r32 * 128 + (((comp * 4 + 2 * hi + 1) ^ ((r32 >> 1) & 7)) << 4);
#define KFRAG(kp, hb) kfrag32((kp) + ka0 + (hb) * 4096, (kp) + ka1 + (hb) * 4096)
#define VFRAG8(vp, d0) kfrag32((vp) + va0_ + (d0) * 2048, (vp) + va1_ + (d0) * 2048)
#define MFPV(OD, PF, VF) asm volatile("v_mfma_scale_f32_32x32x64_f8f6f4 %0, %1, %2, %0, %3, %4 op_sel_hi:[0,0,0] cbsz:1" : "+v"(OD) : "v"(PF), "v"(VF), "v"(scP), "v"(scK))
#define MFQK(C, KF) asm volatile("v_mfma_scale_f32_32x32x64_f8f6f4 %0, %1, %2, 0, %3, %4 op_sel_hi:[0,0,0]" : "=&v"(C) : "v"(KF), "v"(qf), "v"(scK), "v"(scQ))
  const int va0_ = V_IN_SLOT + r32 * 64 + (((2 * hi) ^ ((r32 >> 2) & 3)) << 4), va1_ = V_IN_SLOT + r32 * 64 + (((2 * hi + 1) ^ ((r32 >> 2) & 3)) << 4);
  f32x16 o[4];
#pragma unroll
  for (int d0 = 0; d0 < 4; ++d0) o[d0] = f32x16{};
  f32x16 pA0, pA1, pB0, pB1;
#define EX(v) __builtin_amdgcn_exp2f(SHIFT ? (v) + negmb : (v))
#define PIN(x) asm volatile("" : "+v"(x))
#define STEP(CX0, CX1, PY0, PY1, ks_, vs_) do { \
    const lds_cptr kp_ = lds3 + (ks_); const lds_cptr vp_ = lds3 + (vs_); \
    const v8i_t kf0 = KFRAG(kp_, 0), kf1 = KFRAG(kp_, 1); \
    int w0_, w1_, w2_, w3_, w4_, w5_, w6_, w7_; SBAR(); \
    MFQK(CX0, kf0); \
    PK8(PY0, 0, w0_, w1_); PK8(PY0, 8, w2_, w3_); SBAR(); \
    MFQK(CX1, kf1); \
    v8i_t vf0 = VFRAG8(vp_, 0), vf1 = VFRAG8(vp_, 1); \
    PK8(PY1, 0, w4_, w5_); PK8(PY1, 8, w6_, w7_); \
    const v8i_t pf_ = {w0_, w1_, w2_, w3_, w4_, w5_, w6_, w7_}; SBAR(); \
      \
    asm volatile("s_nop 1" ::: "memory"); \
    MFPV(o[0], pf_, vf0); v8i_t vf2 = VFRAG8(vp_, 2); \
    _Pragma("unroll") for (int r_ = 0; r_ < 8; ++r_) CX0[r_] = EX(CX0[r_]); SBAR(); \
    MFPV(o[1], pf_, vf1); v8i_t vf3 = VFRAG8(vp_, 3); \
    _Pragma("unroll") for (int r_ = 8; r_ < 16; ++r_) CX0[r_] = EX(CX0[r_]); PIN(CX0); SBAR(); \
    MFPV(o[2], pf_, vf2); \
    _Pragma("unroll") for (int r_ = 0; r_ < 8; ++r_) CX1[r_] = EX(CX1[r_]); SBAR(); \
    MFPV(o[3], pf_, vf3); MFL(pf_); \
    _Pragma("unroll") for (int r_ = 8; r_ < 16; ++r_) CX1[r_] = EX(CX1[r_]); PIN(CX1); SBAR(); \
  } while (0)
  if (wid >= 4) __builtin_amdgcn_s_setprio(1);
  WAIT_BAR(4);
  { const lds_cptr kp_ = lds3; const v8i_t kf0 = KFRAG(kp_, 0), kf1 = KFRAG(kp_, 1);
    MFQK(pA0, kf0); MFQK(pA1, kf1);
    asm volatile("s_nop 15\n\ts_nop 15\n\ts_nop 15\n\ts_nop 15" ::: "memory");
#pragma unroll
    for (int r = 0; r < 16; ++r) { pA0[r] = EX(pA0[r]); pA1[r] = EX(pA1[r]); } }
  WAIT_BAR(2);
#define SLOT(t) ((((t)) & 3) * SLOT_B)
  int j = 1;
  for (; j + 6 < NT; j += 4) {
    DMA_TILE(j + 2, SLOT(3));
    STEP(pB0, pB1, pA0, pA1, SLOT(1), SLOT(0)); WAIT_BAR(2);
    DMA_TILE(j + 3, SLOT(0));
    STEP(pA0, pA1, pB0, pB1, SLOT(2), SLOT(1)); WAIT_BAR(2);
    DMA_TILE(j + 4, SLOT(1));
    STEP(pB0, pB1, pA0, pA1, SLOT(3), SLOT(2)); WAIT_BAR(2);
    DMA_TILE(j + 5, SLOT(2));
    STEP(pA0, pA1, pB0, pB1, SLOT(0), SLOT(3)); WAIT_BAR(2);
  }
  DMA_TILE(j + 2, SLOT(3));
  STEP(pB0, pB1, pA0, pA1, SLOT(1), SLOT(0)); WAIT_BAR(2);
  STEP(pA0, pA1, pB0, pB1, SLOT(2), SLOT(1)); WAIT_BAR(0);
  STEP(pB0, pB1, pA0, pA1, SLOT(3), SLOT(2));
  { int w0_, w1_, w2_, w3_, w4_, w5_, w6_, w7_;
    PK8(pB0, 0, w0_, w1_); PK8(pB0, 8, w2_, w3_); PK8(pB1, 0, w4_, w5_); PK8(pB1, 8, w6_, w7_);
    const v8i_t pf_ = {w0_, w1_, w2_, w3_, w4_, w5_, w6_, w7_};
    const lds_cptr vp_ = lds3 + SLOT(3);
    const v8i_t vf0 = VFRAG8(vp_, 0), vf1 = VFRAG8(vp_, 1), vf2 = VFRAG8(vp_, 2), vf3 = VFRAG8(vp_, 3);
    asm volatile("s_nop 1" ::: "memory");
    MFPV(o[0], pf_, vf0); MFPV(o[1], pf_, vf1); MFPV(o[2], pf_, vf2); MFPV(o[3], pf_, vf3); MFL(pf_);
    asm volatile("s_nop 15\n\ts_nop 15\n\ts_nop 15\n\ts_nop 15\n\ts_nop 15\n\ts_nop 15" ::: "memory");
  }
#undef STEP
#undef VFRAG8
#undef MFPV
#undef MFL
#undef PK8
#undef KFRAG
#undef MFQK
#undef SLOT
#undef DMA_TILE
#undef EX
#undef PIN
  __builtin_amdgcn_s_setprio(0);
  if ((lane & 15) < 2) { const float cf_ = (comp == 0 ? 1.0f : -lam);
    const v4f_t c4 = {cf_ * __builtin_amdgcn_rcpf(Lacc[0]), cf_ * __builtin_amdgcn_rcpf(Lacc[1]), cf_ * __builtin_amdgcn_rcpf(Lacc[2]), cf_ * __builtin_amdgcn_rcpf(Lacc[3])};
    *(v4f_t*)(wsf + 16 * (lane & 15) + 4 * (lane >> 4)) = c4; }
  asm volatile("s_waitcnt lgkmcnt(0)" ::: "memory");
  float rli[16];
#pragma unroll
  for (int r = 0; r < 16; ++r) rli[r] = wsf[crow(r, hi)];
#pragma unroll
  for (int d0 = 0; d0 < 4; ++d0)
#pragma unroll
    for (int r = 0; r < 16; ++r) o[d0][r] *= rli[r];
  __syncthreads();
  float* comb = (float*)(lds + OFF_COMB) + qs * 4096 + lane;
  if (comp == 1) {
#pragma unroll
    for (int d0 = 0; d0 < 4; ++d0)
#pragma unroll
      for (int r = 0; r < 16; ++r) comb[(d0 * 16 + r) * 64] = o[d0][r];
  }
  __syncthreads();
  if (comp == 0) {
#pragma unroll
    for (int d0 = 0; d0 < 4; ++d0)
#pragma unroll
      for (int r = 0; r < 16; ++r) o[d0][r] += comb[(d0 * 16 + r) * 64];
    float gcol[4];
#pragma unroll
    for (int d0 = 0; d0 < 4; ++d0) gcol[d0] = subg[d0 * 32 + r32] * osc;
    bf16_t* stg = (bf16_t*)(lds + OFF_STG) + qs * 4096;
#pragma unroll
    for (int r = 0; r < 16; ++r) {
      float ss = (o[0][r] * o[0][r] + o[1][r] * o[1][r]) + (o[2][r] * o[2][r] + o[3][r] * o[3][r]);
      ss += __shfl_xor(ss, 1); ss += __shfl_xor(ss, 2); ss += __shfl_xor(ss, 4); ss += __shfl_xor(ss, 8); ss += __shfl_xor(ss, 16);
      const float rn = __builtin_amdgcn_rsqf(ss * (1.0f / 128.0f) + 1e-6f);
      const int orow = crow(r, hi);
#pragma unroll
      for (int d0 = 0; d0 < 4; ++d0) { const float v = o[d0][r] * rn * gcol[d0]; stg[orow * 128 + d0 * 32 + r32] = (bf16_t)(cvtpk(v, v) & 0xffffu); }
    }
    asm volatile("s_waitcnt lgkmcnt(0)" ::: "memory");
    bf16_t* Ow = O + (rowbase + q0 + qs * 32) * 1024 + h * 128;
#pragma unroll
    for (int i = 0; i < 8; ++i) { const int row = i * 4 + (lane >> 4), ch = lane & 15; const u32x4 v = *(const u32x4*)(stg + row * 128 + ch * 8); *(u32x4*)(Ow + (long)row * 1024 + ch * 8) = v; }
  }
  __syncthreads();
}
#undef KSWZ
#undef SBAR
#undef WAIT_BAR
#undef MF
#undef PK4
#undef SUM8
#undef VFRAG
}

constexpr int NWAVES = 8;
constexpr int BATCH = 2, SEQ = 8192, D = 1024, M = BATCH * SEQ, NQKV = 3072, DFF = 2816, NE = 8, DFE = 3584, NH = 8;
constexpr float LAMBDA_INIT = 0.35550906759096934f;
constexpr size_t MiB = 1u << 20, KiB = 1u << 10;
constexpr size_t WS_CTL = 0, CTL_ZERO_BYTES = 1 * MiB;
constexpr size_t WS_ROPE = 1 * MiB, WS_SSQP1 = 2 * MiB, WS_SSQP2 = 3 * MiB;
constexpr size_t WS_SSQ0 = 4 * MiB, WS_TOKE = WS_SSQ0 + 64 * KiB, WS_TOKG = WS_TOKE + 64 * KiB, WS_TOKRS = WS_TOKG + 128 * KiB, WS_TOKSLOT = WS_TOKRS + 64 * KiB,
                 WS_HIST = WS_TOKSLOT + 128 * KiB, WS_SLOTRS = WS_HIST + 64 * KiB, WS_SLOTG = WS_SLOTRS + 192 * KiB, WS_META = WS_SLOTG + 192 * KiB, WS_CONST = WS_META + 4 * KiB, WS_RG = WS_CONST + 4 * KiB;
static_assert(WS_RG + 32 * KiB <= 5 * MiB, "small tables");
constexpr size_t WS_WM13 = 8 * MiB, WS_WM2 = 64 * MiB, WS_WCI = 92 * MiB, WS_WCO = 98 * MiB, WS_WAI = 100 * MiB, WS_WAO = 106 * MiB, WS_W13 = 108 * MiB, WS_W2 = 119 * MiB;
constexpr size_t WS_XB = 126 * MiB, WS_R1 = 158 * MiB, WS_GO = 254 * MiB;
constexpr size_t WS_HG = 158 * MiB, WS_Y = 192 * MiB, WS_HIDM = 260 * MiB, WS_YP = 379 * MiB, WS_END = 407 * MiB;
constexpr int MOE_T1 = 128, MOE_LMAX = 8, MOE_NSPLIT = 7, MOE_KS = 512, MOE_TMAX = 136;
constexpr float W8_SCALE = 64.0f, H8_SCALE = 4.0f;
static_assert(WS_WM13 + (size_t)NE * 2 * DFE * D <= WS_WM2 && WS_WM2 + (size_t)NE * D * DFE <= WS_WCI && WS_W13 + (size_t)2 * DFF * D * 2 <= WS_W2 && WS_W2 + (size_t)D * DFF * 2 <= WS_XB, "weights");
static_assert(WS_XB + (size_t)M * D * 2 <= WS_R1 && WS_R1 + (size_t)M * NQKV * 2 <= WS_GO && WS_HG + (size_t)MOE_TMAX * 256 * D <= WS_Y && WS_Y + (size_t)MOE_TMAX * 256 * D * 2 <= WS_HIDM && WS_HIDM + (size_t)MOE_TMAX * 256 * DFE <= WS_YP
              && WS_YP + (size_t)MOE_NSPLIT * MOE_LMAX * 256 * D * 2 <= WS_END && MOE_NSPLIT * MOE_KS == DFE, "activations");
constexpr int CW_BAR = 4096;
constexpr int RING_OFF = 0, RING_BYTES = 135168;
constexpr int LDSCTL_OFF = RING_BYTES, MISC_OFF = LDSCTL_OFF + 320, TEXP_OFF = LDSCTL_OFF + 1024;
constexpr int LDS_BYTES = 147456;
static_assert(dattn::ATTN_LDS_BYTES <= RING_BYTES, "attention scratch");
#define GAS __attribute__((address_space(1)))
#define LAS __attribute__((address_space(3)))
typedef unsigned short bf16;
typedef unsigned v4u __attribute__((ext_vector_type(4)));
typedef float f32x4 __attribute__((ext_vector_type(4)));
typedef GAS unsigned gu32;
#define LDS_WAIT() asm volatile("s_waitcnt lgkmcnt(0)" ::: "memory")
__device__ __forceinline__ unsigned f2bf(float f) { unsigned u = __builtin_bit_cast(unsigned, f); return (u + 0x7fffu + ((u >> 16) & 1u)) >> 16; }
__device__ __forceinline__ unsigned pk2(float lo, float hi) { return f2bf(lo) | (f2bf(hi) << 16); }
struct Inputs { const float* x; const int* positions; const float *norm_mix, *norm_ffn, *conv_in, *conv_w, *conv_out, *attn_in, *q_norm, *k_norm, *lam_q1, *lam_k1, *lam_q2, *lam_k2, *subln, *attn_out,
                *ffn_w1, *ffn_w3, *ffn_w2, *router, *moe_w1, *moe_w3, *moe_w2; };

#define XB_TMO      128
#define XB_XCNT(j)  (256  + 64 * (j))
#define XB_XSUB(j)  (1280 + 64 * (j))
#define XB_XGEN(j)  (2304 + 64 * (j))
#define XB_TOP      3328
#define XB_TOPGEN   3392
#define XCD_BAR_WORDS 3456
#define XB_SPIN_CAP (1u << 18)

__device__ __forceinline__ unsigned xb_ld(unsigned* p)              { return __hip_atomic_load(p, __ATOMIC_RELAXED, __HIP_MEMORY_SCOPE_AGENT); }
__device__ __forceinline__ unsigned xb_add(unsigned* p, unsigned v) { return __hip_atomic_fetch_add(p, v, __ATOMIC_RELAXED, __HIP_MEMORY_SCOPE_AGENT); }
__device__ __forceinline__ unsigned xb_xcc_id() { return (unsigned)__builtin_amdgcn_s_getreg((3 << 11) | 20) & 0xFu; }
#define XB_SPIN(cond, bar) do { unsigned _sp = 0; while (cond) { __builtin_amdgcn_s_sleep(1); \
    if ((++_sp & 255u) == 0u) { if (xb_ld(&(bar)[XB_TMO])) break; if (_sp > XB_SPIN_CAP) { atomicAdd(&(bar)[XB_TMO], 1u); break; } } } } while (0)

struct XcdBarrier {
    unsigned* bar; unsigned x;
    volatile LAS unsigned* st;
};

__device__ __forceinline__ XcdBarrier xcd_barrier_post(unsigned* bar, volatile LAS unsigned* st) {
    XcdBarrier b; b.bar = bar; b.x = xb_xcc_id(); b.st = st;
    if (threadIdx.x == 0) (void)xb_add(&bar[XB_XCNT(b.x)], 1u);
    return b;
}
__device__ __forceinline__ void xcd_barrier_complete(unsigned* bar, unsigned x, unsigned& nloc, unsigned& nx) {
    const unsigned G = gridDim.x * gridDim.y * gridDim.z;
    unsigned sum, cnt, mine, sp = 0u;
    for (;;) {
        sum = 0u; cnt = 0u; mine = 0u;
#pragma unroll
        for (unsigned j = 0; j < 16; ++j) { const unsigned c = xb_ld(&bar[XB_XCNT(j)]); sum += c; cnt += (c > 0u) ? 1u : 0u; mine = (j == x) ? c : mine; }
        if (sum == G) break;
        __builtin_amdgcn_s_sleep(1);
        if ((++sp & 255u) == 0u) { if (xb_ld(&bar[XB_TMO])) break; if (sp > XB_SPIN_CAP) { atomicAdd(&bar[XB_TMO], 1u); break; } }
    }
    nloc = mine > 0u ? mine : 1u; nx = cnt > 0u ? cnt : 1u;
}

__device__ __forceinline__ void xcd_barrier(const XcdBarrier& b) {
    asm volatile("s_waitcnt vmcnt(0)" ::: "memory");
    __syncthreads();
    if (threadIdx.x == 0) {
        unsigned* bar = b.bar;
        __builtin_amdgcn_s_waitcnt(0);
        unsigned nloc = b.st[0], nx = b.st[1];
        if (nloc == 0u) { xcd_barrier_complete(bar, b.x, nloc, nx); b.st[0] = nloc; b.st[1] = nx; }
        const unsigned old = xb_add(&bar[XB_XSUB(b.x)], 1u);
        const unsigned gen = old / nloc;
        if (old + 1u == (gen + 1u) * nloc) {
            __builtin_amdgcn_fence(__ATOMIC_RELEASE, "agent");
            asm volatile("s_waitcnt vmcnt(0)" ::: "memory");
            const unsigned og = xb_add(&bar[XB_TOP], 1u);
            const unsigned tg = og / nx;
            if (og + 1u == (tg + 1u) * nx) xb_add(&bar[XB_TOPGEN], 1u);
            else XB_SPIN(xb_ld(&bar[XB_TOPGEN]) == tg, bar);
            __builtin_amdgcn_fence(__ATOMIC_ACQUIRE, "agent");
            xb_add(&bar[XB_XGEN(b.x)], 1u);
            asm volatile("s_waitcnt vmcnt(0)" ::: "memory");
        } else {
            XB_SPIN(xb_ld(&bar[XB_XGEN(b.x)]) == gen, bar);
            __builtin_amdgcn_fence(__ATOMIC_ACQUIRE, "agent");
            asm volatile("s_waitcnt vmcnt(0)" ::: "memory");
        }
    }
    __syncthreads();
}

struct Frame {
    LAS unsigned char* lds;
    volatile LAS unsigned* MISC;
    gu32* ctl;
    int tid, lane, wave;
    int vcu, G;
};

__device__ __forceinline__ float wave_sum(float v) {
#pragma unroll
    for (int o = 1; o < 64; o <<= 1) v += __shfl_xor(v, o);
    return v;
}
__device__ __forceinline__ float wave_max(float v) {
#pragma unroll
    for (int o = 1; o < 64; o <<= 1) v = fmaxf(v, __shfl_xor(v, o));
    return v;
}
__device__ __forceinline__ float bf2f(unsigned short h) { return __uint_as_float((unsigned)h << 16); }
template <int MAP> __device__ __forceinline__ int rowmap(int n0) {
    if (MAP == 1) return (n0 >> 7) * 256 + (n0 & 127);
    if (MAP == 2) return (n0 >> 7) * 256 + 128 + (n0 & 127);
    if (MAP == 3) return (n0 & ~255) + ((n0 >> 5) & 1) * 128 + ((n0 >> 6) & 3) * 32;
    if (MAP == 4) { if (n0 < D) return n0; const int c = (n0 - D) & (D - 1); return D + (c >> 7) * 256 + (n0 >= 2 * D ? 128 : 0) + (c & 127); }
    return n0;
}
template <int MAP> __device__ __forceinline__ void transpose_item(const float* W, int K, int N, const float* gain, bf16* WT, LAS unsigned* T, int item, int lane) {
    const int nblk = N / 64, kb = item / nblk, nb = item % nblk, k0 = 64 * kb, n0 = 64 * nb;
    const int kk = lane >> 4, nn = (lane & 15) * 4;
    f32x4 a[8], b[8];
    const float* Wp = W + (size_t)(k0 + 2 * kk) * N + n0 + nn;
    float ga[8], gb[8];
#pragma unroll
    for (int i = 0; i < 8; ++i) { ga[i] = gain ? gain[k0 + 8 * i + 2 * kk] : 1.0f; gb[i] = gain ? gain[k0 + 8 * i + 2 * kk + 1] : 1.0f; }
#pragma unroll
    for (int i = 0; i < 8; ++i) { a[i] = __builtin_nontemporal_load((const f32x4*)(Wp + (size_t)(8 * i) * N)); b[i] = __builtin_nontemporal_load((const f32x4*)(Wp + (size_t)(8 * i + 1) * N)); }
    asm volatile("" ::: "memory");
#pragma unroll
    for (int i = 0; i < 8; ++i) {
        if (gain) { a[i] = a[i] * ga[i]; b[i] = b[i] * gb[i]; }
#pragma unroll
        for (int e = 0; e < 4; ++e) T[(nn + e) * 36 + 4 * i + kk] = pg8::cvt_pk_bf16(a[i][e], b[i][e]); }
    LDS_WAIT(); asm volatile("" ::: "memory");
    const int c = lane & 7;
#pragma unroll
    for (int j = 0; j < 8; ++j) { const int n = (lane >> 3) + 8 * j; const v4u o = *(const LAS v4u*)(T + n * 36 + 4 * c);
        const int drow = rowmap<MAP>(n0 + (n & 32)) + (n & 31);
        *(GAS v4u*)(WT + (size_t)drow * K + k0 + 8 * c) = o; }
    LDS_WAIT(); asm volatile("" ::: "memory");
}

template <int MAP> __device__ __forceinline__ void transpose_item8(const float* W, int K, int N, const float* gain, unsigned char* WT, LAS unsigned* T, int item, int lane) {
    const int nblk = N / 64, kb = item / nblk, nb = item % nblk, k0 = 64 * kb, n0 = 64 * nb;
    const int kk = lane >> 4, nn = (lane & 15) * 4;
    f32x4 a[4][4];
    const float* Wp = W + (size_t)(k0 + 4 * kk) * N + n0 + nn;
#pragma unroll
    for (int i = 0; i < 4; ++i)
#pragma unroll
        for (int q = 0; q < 4; ++q) a[i][q] = __builtin_nontemporal_load((const f32x4*)(Wp + (size_t)(16 * i + q) * N));
    asm volatile("" ::: "memory");
#pragma unroll
    for (int i = 0; i < 4; ++i) { const int r = 16 * i + 4 * kk;
        float g[4];
#pragma unroll
        for (int q = 0; q < 4; ++q) g[q] = (gain ? gain[k0 + r + q] : 1.0f) * W8_SCALE;
#pragma unroll
        for (int e = 0; e < 4; ++e) { int p = 0; p = __builtin_amdgcn_cvt_pk_fp8_f32(a[i][0][e] * g[0], a[i][1][e] * g[1], p, false); p = __builtin_amdgcn_cvt_pk_fp8_f32(a[i][2][e] * g[2], a[i][3][e] * g[3], p, true);
            T[(nn + e) * 20 + 4 * i + kk] = (unsigned)p; } }
    LDS_WAIT(); asm volatile("" ::: "memory");
    const int c = lane & 3;
#pragma unroll
    for (int j = 0; j < 4; ++j) { const int n = (lane >> 2) + 16 * j; const v4u o = *(const LAS v4u*)(T + n * 20 + 4 * c);
        const int drow = rowmap<MAP>(n0 + (n & 32)) + (n & 31);
        __builtin_nontemporal_store(o, (GAS v4u*)(WT + (size_t)drow * K + k0 + 16 * c)); }
    LDS_WAIT(); asm volatile("" ::: "memory");
}

__device__ __constant__ double ROPE_TURNS[8] = {
    0.15915494309189535, 0.03086376340470123, 0.005985185712713705, 0.001160663641240061,
    0.00022507907903927653, 4.364795279280289e-05, 8.464330808241401e-06, 1.6414262627950345e-06 };

__device__ __forceinline__ void p0_prologue(Frame& F, const Inputs& I, unsigned char* ws) {
    LAS unsigned* scr = (LAS unsigned*)(F.lds + RING_OFF + F.wave * 16384);
    const int gw = F.vcu * NWAVES + F.wave, NGW = F.G * NWAVES;
    constexpr int I_CI = (D / 64) * (NQKV / 64), I_CO = (D / 64) * (D / 64), I_F13 = (D / 64) * (DFF / 64), I_F2 = (DFF / 64) * (D / 64);
    constexpr int I_M13 = (D / 64) * (DFE / 64), I_M2 = (DFE / 64) * (D / 64);
    constexpr int NITEMS = I_CI + I_CO + 2 * I_F13;
    bf16* WCI = (bf16*)(ws + WS_WCI); bf16* WCO = (bf16*)(ws + WS_WCO); bf16* W13 = (bf16*)(ws + WS_W13);
    for (int it = gw; it < NITEMS; it += NGW) {
        int r = it;
        if (r < I_CI) { transpose_item<4>(I.conv_in, D, NQKV, I.norm_mix, WCI, scr, r, F.lane); continue; } r -= I_CI;
        if (r < I_CO) { transpose_item<0>(I.conv_out, D, D, nullptr, WCO, scr, r, F.lane); continue; } r -= I_CO;
        if (r < I_F13) { transpose_item<1>(I.ffn_w1, D, DFF, I.norm_ffn, W13, scr, r, F.lane); continue; } r -= I_F13;
        transpose_item<2>(I.ffn_w3, D, DFF, I.norm_ffn, W13, scr, r, F.lane);
    }
    bf16* XB = (bf16*)(ws + WS_XB); float* SSQ0 = (float*)(ws + WS_SSQ0); float* ROPE = (float*)(ws + WS_ROPE);
    for (int m0 = gw; m0 < M; m0 += 2 * NGW) {
        f32x4 v[2][4];
#pragma unroll
        for (int h = 0; h < 2; ++h) { const int m = m0 + h * NGW; if (m < M) { const GAS f32x4* xr = (const GAS f32x4*)(I.x + (size_t)m * D) + F.lane;
#pragma unroll
            for (int j = 0; j < 4; ++j) v[h][j] = __builtin_nontemporal_load(xr + 64 * j); } }
#pragma unroll
        for (int h = 0; h < 2; ++h) { const int m = m0 + h * NGW; if (m < M) { GAS unsigned long long* o8 = (GAS unsigned long long*)(XB + (size_t)m * D) + F.lane;
            float s = 0.f;
#pragma unroll
            for (int j = 0; j < 4; ++j) { const f32x4 w = v[h][j]; s += (w.x * w.x + w.y * w.y) + (w.z * w.z + w.w * w.w);
                o8[64 * j] = (unsigned long long)pk2(w.x, w.y) | ((unsigned long long)pk2(w.z, w.w) << 32); }
            s = wave_sum(s);
            if (F.lane == 0) SSQ0[m] = s;
            if (F.lane < 8) { const double t = (double)I.positions[m] * ROPE_TURNS[F.lane]; const float fr = (float)(t - __builtin_floor(t));
                ROPE[(size_t)m * 16 + F.lane] = __builtin_amdgcn_cosf(fr); ROPE[(size_t)m * 16 + 8 + F.lane] = __builtin_amdgcn_sinf(fr); } } }
    }
    { float* RG = (float*)(ws + WS_RG);
      for (int k = gw * 64 + F.lane; k < D; k += NGW * 64) { const float g = I.norm_ffn[D + k];
#pragma unroll
          for (int e = 0; e < 8; ++e) RG[e * D + k] = g * I.router[k * 8 + e]; } }
    if (gw == 0) {
        const float a = wave_sum(I.lam_q1[F.lane] * I.lam_k1[F.lane]), b = wave_sum(I.lam_q2[F.lane] * I.lam_k2[F.lane]);
        const float gq = wave_max(fabsf(I.q_norm[F.lane])), gk = wave_max(fabsf(I.k_norm[F.lane]));
        if (F.lane == 0) { float* C = (float*)(ws + WS_CONST); C[0] = __expf(a) - __expf(b) + LAMBDA_INIT; C[1] = -(8.0f * gq * gk * 1.4426950408889634f * 1.03f + 0.5f); }
    }
}

__device__ __forceinline__ void late_weight_items(Frame& F, const Inputs& I, unsigned char* ws, int gw, int NGW) {
    LAS unsigned* scr = (LAS unsigned*)(F.lds + RING_OFF + F.wave * 16384);
    constexpr int I_CI = (D / 64) * (NQKV / 64), I_CO = (D / 64) * (D / 64), I_F2 = (DFF / 64) * (D / 64);
    constexpr int NITEMS = I_F2 + I_CI + I_CO;
    bf16* WAI = (bf16*)(ws + WS_WAI); bf16* WAO = (bf16*)(ws + WS_WAO); bf16* W2 = (bf16*)(ws + WS_W2);
    for (int it = gw; it < NITEMS; it += NGW) {
        int r = it;
        if (r < I_F2) { transpose_item<0>(I.ffn_w2, DFF, D, nullptr, W2, scr, r, F.lane); continue; } r -= I_F2;
        if (r < I_CI) { transpose_item<3>(I.attn_in, D, NQKV, I.norm_mix + D, WAI, scr, r, F.lane); continue; } r -= I_CI;
        transpose_item<0>(I.attn_out, D, D, nullptr, WAO, scr, r, F.lane);
    }
}

struct W8Item { const float* Wp; const float* gain; unsigned char* WT; int N, K, map, k0, n0; };
__device__ __forceinline__ void w8_desc(const Inputs& I, unsigned char* ws, int it, int lane, W8Item& d) {
    constexpr int I_M13 = (D / 64) * (DFE / 64), I_M2 = (DFE / 64) * (D / 64), N13 = NE * 2 * I_M13;
    int e, r; const float* W;
    if (it < N13) { e = it / (2 * I_M13); r = it - e * 2 * I_M13; const bool second = r >= I_M13; r -= second ? I_M13 : 0; W = (second ? I.moe_w3 : I.moe_w1) + (size_t)e * D * DFE; d.N = DFE; d.K = D; d.gain = I.norm_ffn + D; d.WT = ws + WS_WM13 + (size_t)e * 2 * DFE * D; d.map = second ? 2 : 1; }
    else { const int i2 = it - N13; e = i2 / I_M2; r = i2 - e * I_M2; W = I.moe_w2 + (size_t)e * DFE * D; d.N = D; d.K = DFE; d.gain = nullptr; d.WT = ws + WS_WM2 + (size_t)e * D * DFE; d.map = 0; }
    const int nblk = d.N / 64, pr = r >> 1, kp = pr / nblk, nb = pr - kp * nblk, kb = 2 * kp + (r & 1); d.k0 = 64 * kb; d.n0 = 64 * nb;
    d.Wp = W + (size_t)(d.k0 + 4 * (lane >> 4)) * d.N + d.n0 + (lane & 15) * 4;
}
__device__ __forceinline__ void w8_load(const W8Item& d, f32x4 (&a)[4][4], f32x4 (&gq)[4], int lane) {
    const int kk = lane >> 4;
#pragma unroll
    for (int i = 0; i < 4; ++i) { const f32x4 one = {1.0f, 1.0f, 1.0f, 1.0f}; gq[i] = d.gain ? *(const f32x4*)(d.gain + d.k0 + 16 * i + 4 * kk) : one; }
#pragma unroll
    for (int i = 0; i < 4; ++i)
#pragma unroll
        for (int q = 0; q < 4; ++q) a[i][q] = __builtin_nontemporal_load((const f32x4*)(d.Wp + (size_t)(16 * i + q) * d.N));
}
__device__ __forceinline__ void w8_finish(const W8Item& d, const f32x4 (&a)[4][4], const f32x4 (&gq)[4], LAS unsigned* T, int lane, int half) {
    const int kk = lane >> 4, nn = (lane & 15) * 4;
#pragma unroll
    for (int i = 0; i < 4; ++i) {
        float g[4];
#pragma unroll
        for (int q = 0; q < 4; ++q) g[q] = gq[i][q] * W8_SCALE;
#pragma unroll
        for (int e = 0; e < 4; ++e) { int p = 0; p = __builtin_amdgcn_cvt_pk_fp8_f32(a[i][0][e] * g[0], a[i][1][e] * g[1], p, false); p = __builtin_amdgcn_cvt_pk_fp8_f32(a[i][2][e] * g[2], a[i][3][e] * g[3], p, true);
            T[(nn + e) * 36 + 16 * half + 4 * i + kk] = (unsigned)p; } }
    if (half) {
        LDS_WAIT(); asm volatile("" ::: "memory");
        const int c = lane & 7;
#pragma unroll
        for (int j = 0; j < 8; ++j) { const int n = (lane >> 3) + 8 * j; const v4u o = *(const LAS v4u*)(T + n * 36 + 4 * c);
            const int nb32 = d.n0 + (n & 32); const int drow = (d.map == 0 ? nb32 : (nb32 >> 7) * 256 + (d.map == 2 ? 128 : 0) + (nb32 & 127)) + (n & 31);
            __builtin_nontemporal_store(o, (GAS v4u*)(d.WT + (size_t)drow * d.K + (d.k0 - 64) + 16 * c)); }
        LDS_WAIT(); asm volatile("" ::: "memory");
    }
}
constexpr int W8_NIT = NE * (2 * (D / 64) * (DFE / 64) + (DFE / 64) * (D / 64)), W8_EARLY = 2048, W8_LATE = 2048;
__device__ __forceinline__ void moe_weight_items(Frame& F, const Inputs& I, unsigned char* ws, int gw, int NGW, int lo, int NIT) {
    LAS unsigned* scr = (LAS unsigned*)(F.lds + RING_OFF + F.wave * 16384);
#define W8_IDX(j) (lo + 2 * (gw + ((j) >> 1) * NGW) + ((j) & 1))
    f32x4 a0[4][4], a1[4][4], g0[4], g1[4]; W8Item d0, d1;
    int j = 0;
    if (W8_IDX(0) >= NIT) return;
    w8_desc(I, ws, W8_IDX(0), F.lane, d0); w8_load(d0, a0, g0, F.lane);
    for (;;) {
        const bool h1 = W8_IDX(j + 1) < NIT;
        if (h1) { w8_desc(I, ws, W8_IDX(j + 1), F.lane, d1); w8_load(d1, a1, g1, F.lane); }
        w8_finish(d0, a0, g0, scr, F.lane, 0);
        if (!h1) break;
        const bool h2 = W8_IDX(j + 2) < NIT;
        if (h2) { w8_desc(I, ws, W8_IDX(j + 2), F.lane, d0); w8_load(d0, a0, g0, F.lane); }
        w8_finish(d1, a1, g1, scr, F.lane, 1);
        if (!h2) break;
        j += 2;
    }
#undef W8_IDX
}
template <bool SHIFT> __device__ __forceinline__ void attn_phase_loop(Frame& F, const Inputs& I, unsigned char* ws, const bf16* R1, bf16* GO, float lam, float negmb, char* lds, bool early_done) {
    bool conv_done = false; int ui = 0;
    for (int u = F.vcu; u < 2 * NH * (SEQ / 128); u += F.G, ++ui) { const int bh = u >> 6, qb = u & 63;
        dattn::attn_unit<SHIFT>(bh >> 3, bh & 7, qb, (const unsigned char*)R1, (const unsigned char*)(R1 + (size_t)M * D), (const unsigned char*)(R1 + (size_t)2 * M * D), GO, lam, negmb, 1.0f - LAMBDA_INIT, I.subln, lds);
        if (!conv_done && ui == (F.vcu & 3)) { moe_weight_items(F, I, ws, F.vcu * NWAVES + F.wave, F.G * NWAVES, early_done ? W8_EARLY : 0, W8_NIT - W8_LATE); conv_done = true; __syncthreads(); }
    }
    if (!conv_done) { moe_weight_items(F, I, ws, F.vcu * NWAVES + F.wave, F.G * NWAVES, early_done ? W8_EARLY : 0, W8_NIT - W8_LATE); __syncthreads(); }
}

__device__ __forceinline__ void conv_gate_phase(Frame& F, const Inputs& I, unsigned char* ws) {
    const bf16* Bg = (const bf16*)(ws + WS_R1); const bf16* U = Bg + (size_t)M * D; bf16* Gb = (bf16*)(ws + WS_GO);
    const int rsub = F.tid >> 7, ch = (F.tid & 127) * 8;
    f32x4 w[3][2];
#pragma unroll
    for (int j = 0; j < 3; ++j) { w[j][0] = *(const f32x4*)(I.conv_w + j * D + ch); w[j][1] = *(const f32x4*)(I.conv_w + j * D + ch + 4); }
    for (int rb = F.vcu; rb < M / 64; rb += F.G) {
        const int r0 = rb * 64 + rsub * 16;
        float up[8], uc[8], un[8];
#define LOADU(dst, row) do { const v4u uv = *(const v4u*)(U + (size_t)(row) * D + ch); \
        _Pragma("unroll") for (int q = 0; q < 4; ++q) { const unsigned uw_ = uv[q]; dst[2 * q] = __uint_as_float(uw_ << 16); dst[2 * q + 1] = __uint_as_float(uw_ & 0xffff0000u); } } while (0)
        if ((r0 & (SEQ - 1)) == 0) {
#pragma unroll
            for (int q = 0; q < 8; ++q) up[q] = 0.f; } else LOADU(up, r0 - 1);
        LOADU(uc, r0);
        for (int i = 0; i < 16; ++i) {
            const int r = r0 + i;
            if ((r & (SEQ - 1)) == SEQ - 1) {
#pragma unroll
                for (int q = 0; q < 8; ++q) un[q] = 0.f; } else LOADU(un, r + 1);
            const v4u bv = *(const v4u*)(Bg + (size_t)r * D + ch);
            float g[8];
#pragma unroll
            for (int q = 0; q < 8; ++q) { const float cv = w[0][q >> 2][q & 3] * up[q] + w[1][q >> 2][q & 3] * uc[q] + w[2][q >> 2][q & 3] * un[q];
                const unsigned bw = bv[q >> 1]; const float bg = (q & 1) ? __uint_as_float(bw & 0xffff0000u) : __uint_as_float(bw << 16); g[q] = bg * cv; }
            v4u o; o.x = pk2(g[0], g[1]); o.y = pk2(g[2], g[3]); o.z = pk2(g[4], g[5]); o.w = pk2(g[6], g[7]);
            *(v4u*)(Gb + (size_t)r * D + ch) = o;
#pragma unroll
            for (int q = 0; q < 8; ++q) { up[q] = uc[q]; uc[q] = un[q]; }
        }
#undef LOADU
    }
}

__device__ __forceinline__ void router_phase(Frame& F, const bf16* XBs, unsigned char* ws) {
    LAS float* Rt = (LAS float*)(F.lds + RING_OFF);
    LAS int* hist = (LAS int*)(F.lds + RING_OFF + 32768);
    const f32x4* RG = (const f32x4*)(ws + WS_RG);
    for (int i = F.tid; i < 2 * D; i += NWAVES * 64) ((LAS f32x4*)Rt)[i] = RG[i];
    if (F.tid < 8) hist[F.tid] = 0;
    __syncthreads();
    int* TOK_E = (int*)(ws + WS_TOKE); float* TOK_G = (float*)(ws + WS_TOKG); float* TOK_RS = (float*)(ws + WS_TOKRS); int* HIST = (int*)(ws + WS_HIST);
    for (int tb = F.vcu; tb < M / 64; tb += F.G) {
        for (int i4 = 0; i4 < 8; i4 += 4) {
            v4u xa[4], xb_[4];
#pragma unroll
            for (int q = 0; q < 4; ++q) { const v4u* xr = (const v4u*)(XBs + (size_t)(tb * 64 + F.wave * 8 + i4 + q) * D); xa[q] = xr[F.lane]; xb_[q] = xr[64 + F.lane]; }
#pragma unroll
            for (int q = 0; q < 4; ++q) { const int token = tb * 64 + F.wave * 8 + i4 + q;
                float x[16];
#pragma unroll
                for (int j = 0; j < 4; ++j) { x[2 * j] = __uint_as_float(xa[q][j] << 16); x[2 * j + 1] = __uint_as_float(xa[q][j] & 0xffff0000u); x[8 + 2 * j] = __uint_as_float(xb_[q][j] << 16); x[9 + 2 * j] = __uint_as_float(xb_[q][j] & 0xffff0000u); }
                float ss = 0.f;
#pragma unroll
                for (int j = 0; j < 16; ++j) ss += x[j] * x[j];
                float acc[8];
#pragma unroll
                for (int e = 0; e < 8; ++e) { const LAS f32x4* r = (const LAS f32x4*)(Rt + e * D + 8 * F.lane); const f32x4 r0 = r[0], r1 = r[1], r2 = r[128], r3 = r[129];
                    acc[e] = ((x[0] * r0[0] + x[1] * r0[1]) + (x[2] * r0[2] + x[3] * r0[3])) + ((x[4] * r1[0] + x[5] * r1[1]) + (x[6] * r1[2] + x[7] * r1[3]))
                           + (((x[8] * r2[0] + x[9] * r2[1]) + (x[10] * r2[2] + x[11] * r2[3])) + ((x[12] * r3[0] + x[13] * r3[1]) + (x[14] * r3[2] + x[15] * r3[3]))); }
                ss = wave_sum(ss); const float rs = __builtin_amdgcn_rsqf(ss * (1.0f / D) + 1e-6f);
#pragma unroll
                for (int e = 0; e < 8; ++e) acc[e] = wave_sum(acc[e]) * rs;
                int i1 = 0; float v1 = acc[0];
#pragma unroll
                for (int e = 1; e < 8; ++e) if (acc[e] > v1) { v1 = acc[e]; i1 = e; }
                int i2 = -1; float v2 = -3.0e38f;
#pragma unroll
                for (int e = 0; e < 8; ++e) if (e != i1 && acc[e] > v2) { v2 = acc[e]; i2 = e; }
                const float g1 = 1.0f / (1.0f + __expf(v2 - v1)), g2 = 1.0f - g1;
                if (F.lane == 0) { TOK_E[token] = i1 | (i2 << 8); TOK_G[2 * token] = g1; TOK_G[2 * token + 1] = g2; TOK_RS[token] = rs;
                    atomicAdd((int*)&hist[i1], 1); atomicAdd((int*)&hist[i2], 1); }
            }
        }
        __syncthreads();
        if (F.tid < 8) { HIST[tb * 8 + F.tid] = hist[F.tid]; hist[F.tid] = 0; }
        __syncthreads();
    }
}

__device__ __forceinline__ void dispatch_phase(Frame& F, unsigned char* ws) {
    LAS int* pre = (LAS int*)(F.lds + RING_OFF);
    LAS int* tot = pre + 2048; LAS int* off = tot + 8;
    LAS int* lpos = off + 16;
    const int* HIST = (const int*)(ws + WS_HIST); const int* TOK_E = (const int*)(ws + WS_TOKE); const float* TOK_G = (const float*)(ws + WS_TOKG); const float* TOK_RS = (const float*)(ws + WS_TOKRS);
    int* TOK_SLOT = (int*)(ws + WS_TOKSLOT); float* SLOT_RS = (float*)(ws + WS_SLOTRS); float* SLOT_G = (float*)(ws + WS_SLOTG); int* META = (int*)(ws + WS_META);
    const bf16* XB = (const bf16*)(ws + WS_XB); unsigned char* HG = ws + WS_HG;
    {
      const int e = F.wave; int h[4];
#pragma unroll
      for (int k = 0; k < 4; ++k) h[k] = HIST[(4 * F.lane + k) * 8 + e];
      const int T = (h[0] + h[1]) + (h[2] + h[3]); int inc = T;
#pragma unroll
      for (int d = 1; d < 64; d <<= 1) { const int o = __shfl_up(inc, d); if (F.lane >= d) inc += o; }
      int run = inc - T;
#pragma unroll
      for (int k = 0; k < 4; ++k) { pre[(4 * F.lane + k) * 8 + e] = run; run += h[k]; }
      if (F.lane == 63) tot[e] = inc; }
    __syncthreads();
    if (F.tid == 0) { int o = 0; for (int e = 0; e < 8; ++e) { off[e] = o; o += (tot[e] + 255) & ~255; } off[8] = o; }
    __syncthreads();
    if (F.vcu == 0 && F.tid < 160) {
        if (F.tid == 0) META[0] = off[8] >> 8;
        const int t = F.tid; int e = 0;
#pragma unroll
        for (int q = 1; q < 8; ++q) if (t * 256 >= off[q]) e = q;
        META[16 + t] = e;
    }
    for (int tb = F.vcu; tb < M / 64; tb += F.G) {
        if (F.wave == 0) {
            const int token = tb * 64 + F.lane; const int te = TOK_E[token]; const int e1 = te & 255, e2 = te >> 8; const float g1 = TOK_G[2 * token], g2 = TOK_G[2 * token + 1], rs = TOK_RS[token];
#pragma unroll
            for (int e = 0; e < 8; ++e) { const bool has = (e1 == e) || (e2 == e); const unsigned long long mask = __ballot(has);
                const int rank = __popcll(mask & ((1ull << F.lane) - 1ull));
                if (has) { const int which = (e1 == e) ? 0 : 1; const int pos = off[e] + pre[tb * 8 + e] + rank;
                    SLOT_RS[pos] = rs * (1.0f / W8_SCALE); SLOT_G[pos] = (which ? g2 : g1) * (1.0f / (W8_SCALE * H8_SCALE));   TOK_SLOT[2 * token + which] = pos; lpos[2 * F.lane + which] = pos; } }
        }
        __syncthreads();
        for (int p4 = F.wave * 16; p4 < F.wave * 16 + 16; p4 += 4) {
            v4u s0[4], s1[4]; int pos[4];
#pragma unroll
            for (int q = 0; q < 4; ++q) { const int p = p4 + q; const v4u* src = (const v4u*)(XB + (size_t)(tb * 64 + (p >> 1)) * D); pos[q] = lpos[p]; s0[q] = src[2 * F.lane]; s1[q] = src[2 * F.lane + 1]; }
#pragma unroll
            for (int q = 0; q < 4; ++q) { v4u o;
#pragma unroll
                for (int j = 0; j < 2; ++j) { int w0 = 0, w1 = 0;
                    w0 = __builtin_amdgcn_cvt_pk_fp8_f32(__uint_as_float(s0[q][2 * j] << 16), __uint_as_float(s0[q][2 * j] & 0xffff0000u), w0, false); w0 = __builtin_amdgcn_cvt_pk_fp8_f32(__uint_as_float(s0[q][2 * j + 1] << 16), __uint_as_float(s0[q][2 * j + 1] & 0xffff0000u), w0, true);
                    w1 = __builtin_amdgcn_cvt_pk_fp8_f32(__uint_as_float(s1[q][2 * j] << 16), __uint_as_float(s1[q][2 * j] & 0xffff0000u), w1, false); w1 = __builtin_amdgcn_cvt_pk_fp8_f32(__uint_as_float(s1[q][2 * j + 1] << 16), __uint_as_float(s1[q][2 * j + 1] & 0xffff0000u), w1, true);
                    o[j] = (unsigned)w0; o[2 + j] = (unsigned)w1; }
                ((v4u*)(HG + (size_t)pos[q] * D))[F.lane] = o; } }
        __syncthreads();
    }
    if (F.vcu < 8) {
        const int e = F.vcu, p0 = off[e] + tot[e], p1 = off[e + 1];
        for (int p = p0 + F.wave; p < p1; p += NWAVES) { v4u* dst = (v4u*)(HG + (size_t)p * D); const v4u z = {0u, 0u, 0u, 0u}; dst[F.lane] = z;
            if (F.lane == 0) { SLOT_RS[p] = 0.f; SLOT_G[p] = 0.f; } }
    }
}

__device__ __forceinline__ void bf8_to_f(const v4u a, float (&f)[8]) {
#pragma unroll
    for (int j = 0; j < 4; ++j) { f[2 * j] = __uint_as_float(a[j] << 16); f[2 * j + 1] = __uint_as_float(a[j] & 0xffff0000u); }
}
__device__ __forceinline__ void y_row8(const bf16* Y, const bf16* YP, int s, int c8, float (&r)[8]) {
    if (s < MOE_T1 * 256) bf8_to_f(*((const v4u*)(Y + (size_t)s * D) + c8), r);
    else {
#pragma unroll
        for (int j = 0; j < 8; ++j) r[j] = 0.f;
        for (int p = 0; p < MOE_NSPLIT; ++p) { float t[8]; bf8_to_f(*((const v4u*)(YP + ((size_t)p * MOE_LMAX * 256 + (s - MOE_T1 * 256)) * D) + c8), t);
#pragma unroll
            for (int j = 0; j < 8; ++j) r[j] += t[j]; } }
}
__device__ __forceinline__ void combine_phase(Frame& F, float* X, const bf16* XBs, unsigned char* ws) {
    const int gw = F.vcu * NWAVES + F.wave, NGW = F.G * NWAVES;
    const int* TOK_SLOT = (const int*)(ws + WS_TOKSLOT); const bf16* Y = (const bf16*)(ws + WS_Y); const bf16* YP = (const bf16*)(ws + WS_YP);
    for (int m = gw; m < M; m += NGW) {
        const int s0 = TOK_SLOT[2 * m], s1 = TOK_SLOT[2 * m + 1];
#pragma unroll
        for (int hcol = 0; hcol < 2; ++hcol) { const int c8 = F.lane + 64 * hcol;
            float xv[8], a[8], b[8]; bf8_to_f(*((const v4u*)(XBs + (size_t)m * D) + c8), xv); y_row8(Y, YP, s0, c8, a); y_row8(Y, YP, s1, c8, b);
            f32x4 o0, o1;
#pragma unroll
            for (int j = 0; j < 4; ++j) { o0[j] = xv[j] + (a[j] + b[j]); o1[j] = xv[4 + j] + (a[4 + j] + b[4 + j]); }
            f32x4* dst = (f32x4*)(X + (size_t)m * D + 8 * c8); __builtin_nontemporal_store(o0, dst); __builtin_nontemporal_store(o1, dst + 1); }
    }
}

struct Args { Inputs in; float* out; unsigned char* ws; };
__global__ void __launch_bounds__(NWAVES * 64, 2) mk_fwd(Args args) {
    extern __shared__ __attribute__((aligned(16))) unsigned char lds[];
    Frame F;
    F.lds = (LAS unsigned char*)lds;
    F.MISC = (volatile LAS unsigned*)(F.lds + MISC_OFF);
    F.tid = threadIdx.x; F.lane = F.tid & 63; F.wave = __builtin_amdgcn_readfirstlane(F.tid >> 6);
    F.G = gridDim.x; { const int bx = blockIdx.x; F.vcu = (F.G % 8 == 0) ? (bx % 8) * (F.G / 8) + bx / 8 : bx; }
    unsigned char* ws = args.ws; const Inputs& I = args.in;
    F.ctl = (gu32*)(ws + WS_CTL);
    for (int u = F.tid; u < (LDS_BYTES - LDSCTL_OFF) / 4; u += NWAVES * 64) ((LAS unsigned*)(F.lds + LDSCTL_OFF))[u] = 0u;
    __syncthreads();
    XcdBarrier bar = xcd_barrier_post((unsigned*)(F.ctl + CW_BAR), F.MISC + 8);
#define GRID_BAR() xcd_barrier(bar)
    float* X = args.out;
    bf16* XB = (bf16*)(ws + WS_XB); bf16* R1 = (bf16*)(ws + WS_R1); bf16* GO = (bf16*)(ws + WS_GO);
    float* SSQ0 = (float*)(ws + WS_SSQ0); float* SSQP1 = (float*)(ws + WS_SSQP1); float* SSQP2 = (float*)(ws + WS_SSQP2);

    p0_prologue(F, I, ws);
    GRID_BAR();
    { pg8::Gemm g{XB, (const bf16*)(ws + WS_WCI), M, NQKV, D, 0}; pg8::StaticOrder S; S.init(M, NQKV, F.G, (int)blockIdx.x);
      pg8::EpiConvIn E{R1, R1 + (size_t)M * D, SSQ0};
      pg8::gemm_phase<pg8::EpiConvIn, pg8::StaticOrder, true, true>(F.lds + RING_OFF, g, S, E); }
    GRID_BAR();
    conv_gate_phase(F, I, ws);
    GRID_BAR();
    { pg8::Gemm g{GO, (const bf16*)(ws + WS_WCO), M, D, D, 0}; pg8::StaticOrder S; S.init(M, D, F.G, (int)blockIdx.x);
      pg8::EpiResid E{XB, SSQP1};
      pg8::gemm_phase<pg8::EpiResid, pg8::StaticOrder, true, true>(F.lds + RING_OFF, g, S, E); }
    GRID_BAR();
    { pg8::Gemm g{XB, (const bf16*)(ws + WS_W13), M, 2 * DFF, D, 0}; pg8::StaticOrder S; S.init(M, 2 * DFF, F.G, (int)blockIdx.x);
      pg8::EpiSwiGLU<0> E{R1, DFF, SSQP1, 0};
      pg8::gemm_phase<pg8::EpiSwiGLU<0>, pg8::StaticOrder, true, true>(F.lds + RING_OFF, g, S, E);
      const int ntile = (M / 256) * (2 * DFF / 256), nlast = ntile % F.G;
      if (nlast == 0) late_weight_items(F, I, ws, (int)blockIdx.x * NWAVES + F.wave, F.G * NWAVES);
      else if ((int)blockIdx.x >= nlast) { late_weight_items(F, I, ws, ((int)blockIdx.x - nlast) * NWAVES + F.wave, (F.G - nlast) * NWAVES);
        __syncthreads();
        moe_weight_items(F, I, ws, ((int)blockIdx.x - nlast) * NWAVES + F.wave, (F.G - nlast) * NWAVES, 0, W8_EARLY); } }
    GRID_BAR();
    { pg8::Gemm g{R1, (const bf16*)(ws + WS_W2), M, D, DFF, 0}; pg8::StaticOrder S; S.init(M, D, F.G, (int)blockIdx.x);
      pg8::EpiResid E{XB, SSQP2};
      pg8::gemm_phase<pg8::EpiResid, pg8::StaticOrder, true, true>(F.lds + RING_OFF, g, S, E); }
    GRID_BAR();
    { pg8::Gemm g{XB, (const bf16*)(ws + WS_WAI), M, NQKV, D, 0}; pg8::StaticOrder S; S.init(M, NQKV, F.G, (int)blockIdx.x);
      LAS float* gtab = (LAS float*)(F.lds + LDSCTL_OFF + 2048);
      if (F.tid < 128) gtab[F.tid] = F.tid < 64 ? I.q_norm[F.tid] * (pg8::QSCALE * 16.0f) : I.k_norm[F.tid - 64];
      __syncthreads();
      pg8::EpiQKV E{R1, R1 + (size_t)M * D, R1 + (size_t)2 * M * D, SSQP2, gtab, (const float*)(ws + WS_ROPE)};
      pg8::gemm_phase<pg8::EpiQKV, pg8::StaticOrder, true, true>(F.lds + RING_OFF, g, S, E); }
    GRID_BAR();
    { const float* C = (const float*)(ws + WS_CONST); const float lam = __uint_as_float(__builtin_amdgcn_readfirstlane(__float_as_uint(C[0]))), negmb = __uint_as_float(__builtin_amdgcn_readfirstlane(__float_as_uint(C[1])));
      const bool early_done = ((M / 256) * (2 * DFF / 256)) % F.G != 0;
      if (negmb > -96.0f) attn_phase_loop<false>(F, I, ws, R1, GO, lam, negmb, (char*)lds + RING_OFF, early_done);
      else attn_phase_loop<true>(F, I, ws, R1, GO, lam, negmb, (char*)lds + RING_OFF, early_done); }
    GRID_BAR();
    { pg8::Gemm g{GO, (const bf16*)(ws + WS_WAO), M, D, D, 0}; pg8::StaticOrder S; S.init(M, D, F.G, (int)blockIdx.x);
      pg8::EpiResid E{XB, nullptr};
      pg8::gemm_phase<pg8::EpiResid, pg8::StaticOrder, true, true>(F.lds + RING_OFF, g, S, E); }
    GRID_BAR();
    router_phase(F, XB, ws);
    GRID_BAR();
    dispatch_phase(F, ws);
    GRID_BAR();
    { const int* META = (const int*)(ws + WS_META); LAS int* texp = (LAS int*)(F.lds + TEXP_OFF);
      const int ntiles = META[0];
      if (F.tid < 160) texp[F.tid] = META[16 + F.tid];
      __syncthreads();
      const bf16* HG = (const bf16*)(ws + WS_HG); bf16* HIDM = (bf16*)(ws + WS_HIDM); bf16* Y = (bf16*)(ws + WS_Y);
      const float* SLOT_RS = (const float*)(ws + WS_SLOTRS); const float* SLOT_G = (const float*)(ws + WS_SLOTG);
      { pg8::Gemm g{HG, (const bf16*)(ws + WS_WM13), 0, 0, D / 2, 0}; pg8::MoeOrder S; S.init(ntiles, 2 * DFE / 256, F.G, (int)blockIdx.x, 0, 0, texp);
        pg8::EpiSwiGLU<1, true> E{HIDM, DFE, SLOT_RS, 0, H8_SCALE};
        pg8::gemm_phase<pg8::EpiSwiGLU<1, true>, pg8::MoeOrder, true, true, true>(F.lds + RING_OFF, g, S, E);
        const int nlast = (ntiles * (2 * DFE / 256)) % F.G;
        if (nlast == 0) moe_weight_items(F, I, ws, (int)blockIdx.x * NWAVES + F.wave, F.G * NWAVES, W8_NIT - W8_LATE, W8_NIT);
        else if ((int)blockIdx.x >= nlast) moe_weight_items(F, I, ws, ((int)blockIdx.x - nlast) * NWAVES + F.wave, (F.G - nlast) * NWAVES, W8_NIT - W8_LATE, W8_NIT); }
      GRID_BAR();
      { const int nfull = ntiles < MOE_T1 ? ntiles : MOE_T1;
        pg8::Gemm g{HIDM, (const bf16*)(ws + WS_WM2), 0, 0, DFE / 2, 0}; pg8::MoeOrder S; S.init(nfull, D / 256, F.G, (int)blockIdx.x, 0, 0, texp);
        pg8::EpiRowBf16<1> E{Y, D, SLOT_G, 0, 0, 0};
        pg8::gemm_phase<pg8::EpiRowBf16<1>, pg8::MoeOrder, true, true, true>(F.lds + RING_OFF, g, S, E); }
      if (ntiles > MOE_T1) {
        pg8::Gemm g{HIDM, (const bf16*)(ws + WS_WM2), 0, 0, MOE_KS / 2, DFE / 2}; pg8::SplitOrder S; S.init(ntiles - MOE_T1, D / 256, MOE_NSPLIT, MOE_KS / 2, F.G, (int)blockIdx.x, MOE_T1, MOE_T1, texp);
        pg8::EpiRowBf16<1> E{(bf16*)(ws + WS_YP), D, SLOT_G, MOE_KS / 2, (size_t)MOE_LMAX * 256 * D, MOE_T1 * 256};
        pg8::gemm_phase<pg8::EpiRowBf16<1>, pg8::SplitOrder, true, true, true>(F.lds + RING_OFF, g, S, E); }
      GRID_BAR();
    }
    combine_phase(F, X, XB, ws);
}

extern "C" void kernel_launch(void* const* d_in, const int* in_sizes, int n_in, void* d_out, int out_size, void* d_ws, size_t ws_size, hipStream_t stream) {
    static int grid = 0;
    if (grid == 0) {
        if (n_in != 23 || in_sizes[0] != M * D || out_size != M * D || ws_size < WS_END) { fprintf(stderr, "kernel_launch: shape/workspace mismatch: n_in %d in0 %d out %d ws %zu (need %zu)\n", n_in, n_in > 0 ? in_sizes[0] : -1, out_size, ws_size, (size_t)WS_END); grid = -1; return; }
        int dev = 0, cus = 0, per_cu = 0;
        if (hipGetDevice(&dev) != hipSuccess || hipDeviceGetAttribute(&cus, hipDeviceAttributeMultiprocessorCount, dev) != hipSuccess) { grid = -1; return; }
        if (hipFuncSetAttribute((const void*)mk_fwd, hipFuncAttributeMaxDynamicSharedMemorySize, LDS_BYTES) != hipSuccess) { fprintf(stderr, "kernel_launch: hipFuncSetAttribute failed\n"); grid = -1; return; }
        if (hipOccupancyMaxActiveBlocksPerMultiprocessor(&per_cu, (const void*)mk_fwd, NWAVES * 64, LDS_BYTES) != hipSuccess || per_cu < 1) fprintf(stderr, "kernel_launch: occupancy query reports %d\n", per_cu);
        (void)hipGetLastError();
        grid = cus;
    }
    if (grid < 0) return;
    if (hipMemsetAsync((char*)d_ws + WS_CTL, 0, CTL_ZERO_BYTES, stream) != hipSuccess) return;
    Args a{};
    a.in.x = (const float*)d_in[0]; a.in.positions = (const int*)d_in[1]; a.in.norm_mix = (const float*)d_in[2]; a.in.norm_ffn = (const float*)d_in[3];
    a.in.conv_in = (const float*)d_in[4]; a.in.conv_w = (const float*)d_in[5]; a.in.conv_out = (const float*)d_in[6]; a.in.attn_in = (const float*)d_in[7];
    a.in.q_norm = (const float*)d_in[8]; a.in.k_norm = (const float*)d_in[9]; a.in.lam_q1 = (const float*)d_in[10]; a.in.lam_k1 = (const float*)d_in[11];
    a.in.lam_q2 = (const float*)d_in[12]; a.in.lam_k2 = (const float*)d_in[13]; a.in.subln = (const float*)d_in[14]; a.in.attn_out = (const float*)d_in[15];
    a.in.ffn_w1 = (const float*)d_in[16]; a.in.ffn_w3 = (const float*)d_in[17]; a.in.ffn_w2 = (const float*)d_in[18]; a.in.router = (const float*)d_in[19];
    a.in.moe_w1 = (const float*)d_in[20]; a.in.moe_w3 = (const float*)d_in[21]; a.in.moe_w2 = (const float*)d_in[22];
    a.out = (float*)d_out; a.ws = (unsigned char*)d_ws;
    hipLaunchKernelGGL(mk_fwd, dim3(grid), dim3(NWAVES * 64), LDS_BYTES, stream, a);
    const hipError_t le = hipPeekAtLastError();
    if (le != hipSuccess) fprintf(stderr, "kernel_launch: launch failed: %s\n", hipGetErrorName(le));
}
```

```cpp
#include <hip/hip_runtime.h>
#include <hip/hip_bf16.h>
#include <cstdio>
#include <cstdint>
namespace pg8 {
#define PG8_LAS __attribute__((address_space(3)))
typedef unsigned short bf16_t;
typedef short bf16x8 __attribute__((ext_vector_type(8)));
typedef float f32x4 __attribute__((ext_vector_type(4)));
typedef unsigned u32x4 __attribute__((ext_vector_type(4)));
typedef unsigned u32x2 __attribute__((ext_vector_type(2)));
typedef int v8i_t __attribute__((ext_vector_type(8)));
typedef int v4i_t __attribute__((ext_vector_type(4)));
__device__ __forceinline__ v8i_t cat8(bf16x8 a, bf16x8 b) { const v4i_t x = __builtin_bit_cast(v4i_t, a), y = __builtin_bit_cast(v4i_t, b); return (v8i_t){x[0], x[1], x[2], x[3], y[0], y[1], y[2], y[3]}; }
constexpr int BM = 256, BK = 64, HALF = 128, HTB = HALF * BK * 2  , STAGE_BYTES = 8 * HTB, NXCD = 8, WGM = 8;
constexpr float RMS_EPS = 1e-6f;

__host__ __device__ __forceinline__ int lds_byte(int r, int c) { const int st = (r >> 4) * 2 + (c >> 5), rr = r & 15, cc = c & 31, ob = rr * 64 + cc * 2; return st * 1024 + (ob ^ (((ob >> 9) & 1) << 5)); }
__host__ __device__ __forceinline__ void stage_rc(int b, int& R, int& C) { const int st = b / 1024, sb = b % 1024, swz = sb ^ (((sb >> 9) & 1) << 5); R = (st >> 1) * 16 + swz / 64; C = (st & 1) * 32 + (swz % 64) / 2; }
__host__ __device__ __forceinline__ int perm32(int rho) { const int n = rho >> 4, i = rho & 15; return 8 * (i >> 2) + 4 * n + (i & 3); }

struct Unit { int pm, pn, t, j, k0; };
struct Gemm { const bf16_t* A; const bf16_t* Bt; int M, N, K, ld; };

struct StaticOrder {
    int nM, nN, nwg, G, c;
    __host__ __device__ void init(int M, int N, int G_, int c_) { nM = M / BM; nN = N / BM; nwg = nM * nN; G = G_; c = c_; }
    __host__ __device__ bool next(int i, Unit& u) const {
        const long L = (long)i * G + c; if (L >= nwg) return false;
        int wgid = (int)L; { const int q = nwg / NXCD, r = nwg % NXCD, xcd = wgid % NXCD, off = wgid / NXCD; wgid = (xcd < r ? xcd * (q + 1) : r * (q + 1) + (xcd - r) * q) + off; }
        const int nig = WGM * nN, gid = wgid / nig, fm = gid * WGM, gsz = (nM - fm) < WGM ? (nM - fm) : WGM;
        u.pm = fm + ((wgid % nig) % gsz); u.pn = (wgid % nig) / gsz; u.t = u.pm; u.j = u.pn; u.k0 = 0; return true;
    }
    __device__ __forceinline__ void a_ready(const Unit&) const {}
    __device__ __forceinline__ void done(const Unit&) const {}
};
struct MoeOrder {
    StaticOrder so; int t0, nN, a_local; const PG8_LAS int* texp;
    __device__ void init(int ntc, int nN_, int G_, int c_, int t0_, int a_local_, const PG8_LAS int* texp_) { so.init(ntc * BM, nN_ * BM, G_, c_); t0 = t0_; nN = nN_; a_local = a_local_; texp = texp_; }
    __device__ __forceinline__ bool next(int i, Unit& u) const {
        if (!so.next(i, u)) return false;
        const int tl = u.pm; u.t = t0 + tl; u.j = u.pn; u.pm = a_local ? tl : u.t; u.pn = texp[u.t] * nN + u.j; u.k0 = 0; return true;
    }
    __device__ __forceinline__ void a_ready(const Unit&) const {}
    __device__ __forceinline__ void done(const Unit&) const {}
};

struct SplitOrder {
    int n, G, c, nsplit, ks, nN, t_first, a_first; const PG8_LAS int* texp;
    __device__ void init(int ntl, int nN_, int nsplit_, int ks_, int G_, int c_, int t_first_, int a_first_, const PG8_LAS int* texp_) { n = ntl * nN_ * nsplit_; G = G_; c = c_; nsplit = nsplit_; ks = ks_; nN = nN_; t_first = t_first_; a_first = a_first_; texp = texp_; }
    __device__ __forceinline__ bool next(int i, Unit& u) const {
        const int L = i * G + c; if (L >= n) return false;
        const int piece = L % nsplit, rest = L / nsplit, pn = rest % nN, tl = rest / nN;
        u.t = t_first + tl; u.j = pn; u.pm = a_first + tl; u.pn = texp[u.t] * nN + pn; u.k0 = piece * ks; return true;
    }
    __device__ __forceinline__ void a_ready(const Unit&) const {}
    __device__ __forceinline__ void done(const Unit&) const {}
};

__device__ __forceinline__ unsigned cvt_pk_bf16(float lo, float hi) { unsigned r; asm volatile("v_cvt_pk_bf16_f32 %0, %1, %2" : "=v"(r) : "v"(lo), "v"(hi)); return r; }
__device__ __forceinline__ float sum16(const float* p) {
    const f32x4 a = *(const f32x4*)p, b = *(const f32x4*)(p + 4), c = *(const f32x4*)(p + 8), d = *(const f32x4*)(p + 12);
    return (((a[0] + a[1]) + (a[2] + a[3])) + ((b[0] + b[1]) + (b[2] + b[3]))) + (((c[0] + c[1]) + (c[2] + c[3])) + ((d[0] + d[1]) + (d[2] + d[3])));
}
__device__ __forceinline__ float sum16x(const float* p, int fq) {
    const f32x4 a = *(const f32x4*)(p + 4 * fq); float s = (a[0] + a[1]) + (a[2] + a[3]);
    s += __shfl_xor(s, 32); s += __shfl_xor(s, 16); return s;
}
__device__ __forceinline__ float rstd_of(float ssq) { return __builtin_amdgcn_rsqf(ssq * (1.0f / 1024.0f) + RMS_EPS); }

template <int MODE> struct EpiRowBf16 {
    static constexpr bool PERM = true, AFTER_DRAIN = false;
    bf16_t* O; int ldc; const float* rowv; int ks; size_t piece_stride; int row_sub;
    __device__ __forceinline__ void operator()(const f32x4 (&acc)[2][2][4][2], const Unit& u, int wr, int wc, int fr, int fq) const {
        const int r0 = u.t * BM + wr * 64 + fr, col0 = u.j * BM + wc * 32 + 8 * fq;
        bf16_t* Ob = O; int rsub = 0; if (ks) { Ob += (size_t)(u.k0 / ks) * piece_stride; rsub = row_sub; }
        float sv[2][4];
#pragma unroll
        for (int ai = 0; ai < 2; ++ai)
#pragma unroll
            for (int m = 0; m < 4; ++m) sv[ai][m] = rowv[r0 + ai * HALF + m * 16];
        asm volatile("" ::: "memory");
#pragma unroll
        for (int ai = 0; ai < 2; ++ai)
#pragma unroll
            for (int m = 0; m < 4; ++m) { const int row = r0 + ai * HALF + m * 16; float s = sv[ai][m]; if (MODE == 0) s = rstd_of(s);
                bf16_t* rowp = Ob + (size_t)(row - rsub) * ldc + col0;
#pragma unroll
                for (int bj = 0; bj < 2; ++bj) { const f32x4 v0 = acc[ai][bj][m][0] * s, v1 = acc[ai][bj][m][1] * s;
                    u32x4 w; w.x = cvt_pk_bf16(v0[0], v0[1]); w.y = cvt_pk_bf16(v0[2], v0[3]); w.z = cvt_pk_bf16(v1[0], v1[1]); w.w = cvt_pk_bf16(v1[2], v1[3]);
                    *(u32x4*)(rowp + bj * HALF) = w; } }
    }
};
struct EpiResid {
    static constexpr bool PERM = true, AFTER_DRAIN = false;
    bf16_t* xb; float* ssqp;
    __device__ __forceinline__ void operator()(const f32x4 (&acc)[2][2][4][2], const Unit& u, int wr, int wc, int fr, int fq) const {
        const int r0 = u.pm * BM + wr * 64 + fr, col0 = u.pn * BM + wc * 32 + 8 * fq;
#pragma unroll
        for (int ai = 0; ai < 2; ++ai) {
            u32x4 pre[4][2];
#pragma unroll
            for (int m = 0; m < 4; ++m) { const size_t off = (size_t)(r0 + ai * HALF + m * 16) * 1024 + col0;
#pragma unroll
                for (int bj = 0; bj < 2; ++bj) pre[m][bj] = *(const u32x4*)(xb + off + bj * HALF); }
            asm volatile("" ::: "memory");
#pragma unroll
            for (int m = 0; m < 4; ++m) { const int row = r0 + ai * HALF + m * 16; const size_t off = (size_t)row * 1024 + col0; float ss = 0.f;
#pragma unroll
                for (int bj = 0; bj < 2; ++bj) { const u32x4 p = pre[m][bj]; float v[8];
#pragma unroll
                    for (int q = 0; q < 4; ++q) { v[2 * q] = __uint_as_float(p[q] << 16) + acc[ai][bj][m][q >> 1][(2 * q) & 3]; v[2 * q + 1] = __uint_as_float(p[q] & 0xffff0000u) + acc[ai][bj][m][q >> 1][(2 * q + 1) & 3]; }
                    u32x4 w; w.x = cvt_pk_bf16(v[0], v[1]); w.y = cvt_pk_bf16(v[2], v[3]); w.z = cvt_pk_bf16(v[4], v[5]); w.w = cvt_pk_bf16(v[6], v[7]);
                    *(u32x4*)(xb + off + bj * HALF) = w;
#pragma unroll
                    for (int q = 0; q < 8; ++q) ss += v[q] * v[q]; }
                if (ssqp) { ss += __shfl_xor(ss, 16); ss += __shfl_xor(ss, 32); if (fq == 0) ssqp[(size_t)row * 16 + u.pn * 4 + wc] = ss; } }
            asm volatile("" ::: "memory");
        }
    }
};
struct EpiConvIn {
    static constexpr bool PERM = true, AFTER_DRAIN = false;
    bf16_t* Bg; bf16_t* U; const float* ssq;
    __device__ __forceinline__ void operator()(const f32x4 (&acc)[2][2][4][2], const Unit& u, int wr, int wc, int fr, int fq) const {
        const int r0 = u.pm * BM + wr * 64 + fr;
        float sv[2][4];
#pragma unroll
        for (int ai = 0; ai < 2; ++ai)
#pragma unroll
            for (int m = 0; m < 4; ++m) sv[ai][m] = ssq[r0 + ai * HALF + m * 16];
        asm volatile("" ::: "memory");
        if (u.pn < 4) { const int col0 = u.pn * BM + wc * 32 + 8 * fq;
#pragma unroll
            for (int ai = 0; ai < 2; ++ai)
#pragma unroll
                for (int m = 0; m < 4; ++m) { const int row = r0 + ai * HALF + m * 16; const float s = rstd_of(sv[ai][m]);
                    bf16_t* rowp = Bg + (size_t)row * 1024 + col0;
#pragma unroll
                    for (int bj = 0; bj < 2; ++bj) { const f32x4 v0 = acc[ai][bj][m][0] * s, v1 = acc[ai][bj][m][1] * s;
                        u32x4 w; w.x = cvt_pk_bf16(v0[0], v0[1]); w.y = cvt_pk_bf16(v0[2], v0[3]); w.z = cvt_pk_bf16(v1[0], v1[1]); w.w = cvt_pk_bf16(v1[2], v1[3]);
                        *(u32x4*)(rowp + bj * HALF) = w; } }
        } else { const int col0 = (u.pn - 4) * HALF + wc * 32 + 8 * fq;
#pragma unroll
            for (int ai = 0; ai < 2; ++ai)
#pragma unroll
                for (int m = 0; m < 4; ++m) { const int row = r0 + ai * HALF + m * 16; const float s = rstd_of(sv[ai][m]), s2 = s * s;
                    const f32x4 h0 = (acc[ai][0][m][0] * acc[ai][1][m][0]) * s2, h1 = (acc[ai][0][m][1] * acc[ai][1][m][1]) * s2;
                    u32x4 w; w.x = cvt_pk_bf16(h0[0], h0[1]); w.y = cvt_pk_bf16(h0[2], h0[3]); w.z = cvt_pk_bf16(h1[0], h1[1]); w.w = cvt_pk_bf16(h1[2], h1[3]);
                    *(u32x4*)(U + (size_t)row * 1024 + col0) = w; }
        }
    }
};
typedef float f32x2v __attribute__((ext_vector_type(2)));
template <int MODE, bool OUT8 = false> struct EpiSwiGLU {
    static constexpr bool PERM = true, AFTER_DRAIN = false;
    bf16_t* H; int ldh; const float* rowv; int t0; float oscale;
    __device__ __forceinline__ void operator()(const f32x4 (&acc)[2][2][4][2], const Unit& u, int wr, int wc, int fr, int fq) const {
        const int rl0 = wr * 64 + fr, col0 = u.j * HALF + wc * 32 + 8 * fq;
        float sv[2][4];
        if constexpr (MODE == 0) { f32x4 pq[2][4];
#pragma unroll
            for (int ai = 0; ai < 2; ++ai)
#pragma unroll
                for (int m = 0; m < 4; ++m) pq[ai][m] = *(const f32x4*)(rowv + (size_t)(u.t * BM + rl0 + ai * HALF + m * 16) * 16 + 4 * fq);
#pragma unroll
            for (int ai = 0; ai < 2; ++ai)
#pragma unroll
                for (int m = 0; m < 4; ++m) { const f32x4 a = pq[ai][m]; float q = (a[0] + a[1]) + (a[2] + a[3]); q += __shfl_xor(q, 32); q += __shfl_xor(q, 16); sv[ai][m] = rstd_of(q); }
        } else {
#pragma unroll
            for (int ai = 0; ai < 2; ++ai)
#pragma unroll
                for (int m = 0; m < 4; ++m) sv[ai][m] = rowv[u.t * BM + rl0 + ai * HALF + m * 16];
        }
        asm volatile("" ::: "memory");
#pragma unroll
        for (int ai = 0; ai < 2; ++ai)
#pragma unroll
            for (int m = 0; m < 4; ++m) { const int rl = rl0 + ai * HALF + m * 16;
                const float s = sv[ai][m];
                const float sn = -1.4426950408889634f * s, s2 = OUT8 ? s * s * oscale : s * s;
                const f32x2v sn2 = {sn, sn}, so2 = {s2, s2}, one2 = {1.0f, 1.0f};
                float h[8];
#pragma unroll
                for (int n = 0; n < 2; ++n)
#pragma unroll
                    for (int q = 0; q < 2; ++q) { const f32x4 A = acc[ai][0][m][n], B = acc[ai][1][m][n];
                        const f32x2v a2 = {A[2 * q], A[2 * q + 1]}, b2 = {B[2 * q], B[2 * q + 1]};
                        const f32x2v t2 = a2 * sn2; f32x2v e2; e2.x = __builtin_amdgcn_exp2f(t2.x); e2.y = __builtin_amdgcn_exp2f(t2.y);
                        const f32x2v d2 = e2 + one2; f32x2v r2; r2.x = __builtin_amdgcn_rcpf(d2.x); r2.y = __builtin_amdgcn_rcpf(d2.y);
                        const f32x2v h2 = (a2 * b2) * (r2 * so2); h[n * 4 + 2 * q] = h2.x; h[n * 4 + 2 * q + 1] = h2.y; }
                if constexpr (OUT8) { int p0 = 0, p1 = 0;
                    p0 = __builtin_amdgcn_cvt_pk_fp8_f32(h[0], h[1], p0, false); p0 = __builtin_amdgcn_cvt_pk_fp8_f32(h[2], h[3], p0, true);
                    p1 = __builtin_amdgcn_cvt_pk_fp8_f32(h[4], h[5], p1, false); p1 = __builtin_amdgcn_cvt_pk_fp8_f32(h[6], h[7], p1, true);
                    u32x2 w; w.x = (unsigned)p0; w.y = (unsigned)p1; *(u32x2*)((unsigned char*)H + (size_t)((u.t - t0) * BM + rl) * ldh + col0) = w; }
                else { u32x4 w; w.x = cvt_pk_bf16(h[0], h[1]); w.y = cvt_pk_bf16(h[2], h[3]); w.z = cvt_pk_bf16(h[4], h[5]); w.w = cvt_pk_bf16(h[6], h[7]);
                    *(u32x4*)(H + (size_t)((u.t - t0) * BM + rl) * ldh + col0) = w; } }
    }
};
constexpr float QSCALE = 0.125f * 1.4426950408889634f;
struct EpiQKV {
    static constexpr bool PERM = true, AFTER_DRAIN = false;
    bf16_t* O; bf16_t* KH; bf16_t* VH; const float* ssqp; const PG8_LAS float* gtab; const float* rope;
    __device__ __forceinline__ void operator()(const f32x4 (&acc)[2][2][4][2], const Unit& u, int wr, int wc, int fr, int fq) const {
        const int type = u.pn >> 2;
        const PG8_LAS float* gn = gtab + (type == 0 ? 0 : 64) + 8 * fq;
        const int r0 = u.pm * BM + wr * 64 + fr, col0 = u.pn * BM + 64 * wc + 8 * fq;
        const float sg = fq == 0 ? -1.f : 1.f;
        float rsv[2][4];
        { f32x4 pq[2][4];
#pragma unroll
          for (int ai = 0; ai < 2; ++ai)
#pragma unroll
              for (int m = 0; m < 4; ++m) { const size_t row = (size_t)(r0 + ai * HALF + m * 16); pq[ai][m] = *(const f32x4*)(ssqp + row * 16 + 4 * fq); }
#pragma unroll
          for (int ai = 0; ai < 2; ++ai)
#pragma unroll
              for (int m = 0; m < 4; ++m) { const f32x4 a = pq[ai][m]; float q = (a[0] + a[1]) + (a[2] + a[3]); q += __shfl_xor(q, 32); q += __shfl_xor(q, 16); rsv[ai][m] = rstd_of(q); } }
        asm volatile("" ::: "memory");
        const int lfr = fr;
#pragma unroll
        for (int ai = 0; ai < 2; ++ai) {
            f32x4 rq[4];
            if (type < 2) {
#pragma unroll
                for (int m = 0; m < 4; ++m) rq[m] = *(const f32x4*)(rope + (size_t)(r0 + ai * HALF + m * 16) * 16 + 4 * fq); }
            asm volatile("" ::: "memory");
#pragma unroll
            for (int m = 0; m < 4; ++m) { const int row = r0 + ai * HALF + m * 16; const float rs = rsv[ai][m];
                f32x4 v[2][2];
                if (type < 2) {
                    float ss = 0.f;
#pragma unroll
                    for (int bj = 0; bj < 2; ++bj)
#pragma unroll
                        for (int n = 0; n < 2; ++n) { const f32x4 a = acc[ai][bj][m][n]; ss += (a[0] * a[0] + a[1] * a[1]) + (a[2] * a[2] + a[3] * a[3]); }
                    ss += __shfl_xor(ss, 16); ss += __shfl_xor(ss, 32);
                    const float sc = rs * __builtin_amdgcn_rsqf(ss * (rs * rs * (1.0f / 64.0f)) + RMS_EPS);
#pragma unroll
                    for (int bj = 0; bj < 2; ++bj)
#pragma unroll
                        for (int n = 0; n < 2; ++n) v[bj][n] = acc[ai][bj][m][n] * (*(const PG8_LAS f32x4*)(gn + 32 * bj + 4 * n) * sc);
                    f32x4 p[2];
#pragma unroll
                    for (int n = 0; n < 2; ++n)
#pragma unroll
                        for (int e = 0; e < 4; ++e) p[n][e] = __shfl_xor(v[0][n][e], 16);
                    { const f32x4 mine = rq[m];
#pragma unroll
                      for (int n = 0; n < 2; ++n) { f32x4 c_, s_;
#pragma unroll
                          for (int e = 0; e < 4; ++e) { c_[e] = __shfl(mine[e], 16 * n + lfr); s_[e] = __shfl(mine[e], 32 + 16 * n + lfr); }
                          if (fq < 2) v[0][n] = v[0][n] * c_ + (p[n] * s_) * sg; } }
                } else {
#pragma unroll
                    for (int bj = 0; bj < 2; ++bj)
#pragma unroll
                        for (int n = 0; n < 2; ++n) v[bj][n] = acc[ai][bj][m][n] * rs;
                }
                if (type < 2) {
                    unsigned char* rowp8; if (type == 0) rowp8 = (unsigned char*)O + (size_t)row * 1024 + col0;
                    else { const int hh = 2 * (u.pn & 3) + (wc >> 1), bb = row >> 13, ss_ = row & 8191; rowp8 = (unsigned char*)KH + ((size_t)(bb * 8 + hh) * 8192 + ss_) * 128 + (wc & 1) * 64 + 8 * fq; }
#pragma unroll
                    for (int bj = 0; bj < 2; ++bj) { int p0 = 0, p1 = 0;
                        p0 = __builtin_amdgcn_cvt_pk_fp8_f32(v[bj][0][0], v[bj][0][1], p0, false); p0 = __builtin_amdgcn_cvt_pk_fp8_f32(v[bj][0][2], v[bj][0][3], p0, true);
                        p1 = __builtin_amdgcn_cvt_pk_fp8_f32(v[bj][1][0], v[bj][1][1], p1, false); p1 = __builtin_amdgcn_cvt_pk_fp8_f32(v[bj][1][2], v[bj][1][3], p1, true);
                        u32x2 w; w.x = (unsigned)p0; w.y = (unsigned)p1; *(u32x2*)(rowp8 + 32 * bj) = w; }
                } else {
                    const int hh = 2 * (u.pn & 3) + (wc >> 1), bb = row >> 13, ss_ = row & 8191, tt = ss_ >> 6;
                    const int kk = 16 * (m & 1) + fr, pos = 32 * ((kk >> 2) & 1) + (kk & 3) + 4 * (kk >> 3) + 16 * (m >> 1);
                    unsigned char* tb = (unsigned char*)VH + (((size_t)(bb * 8 + hh) * 128 + tt) * 128 + (wc & 1) * 64 + 8 * fq) * 64 + pos;
#pragma unroll
                    for (int bj = 0; bj < 2; ++bj)
#pragma unroll
                        for (int n = 0; n < 2; ++n) { int pk = 0; pk = __builtin_amdgcn_cvt_pk_fp8_f32(v[bj][n][0], v[bj][n][1], pk, false); pk = __builtin_amdgcn_cvt_pk_fp8_f32(v[bj][n][2], v[bj][n][3], pk, true);
#pragma unroll
                            for (int e = 0; e < 4; ++e) tb[(32 * bj + 4 * n + e) * 64] = (unsigned char)((unsigned)pk >> (8 * e)); }
                } }
        }
    }
};

template <class Epi, class Sched, bool ALIGN_EPI = false, bool SP2 = false, bool F8 = false>
__device__ __forceinline__ void gemm_phase(PG8_LAS unsigned char* lds, const Gemm g, const Sched& S, const Epi& E) {
    int tid = threadIdx.x; asm volatile("" : "+v"(tid));
    const int wid = __builtin_amdgcn_readfirstlane(tid >> 6), lane = tid & 63, wr = wid >> 2, wc = wid & 3, fr = lane & 15, fq = lane >> 4;
    const int K = g.K, nt = K / BK, LD = g.ld ? g.ld : g.K;
    unsigned voffA[2], voffB[2];
#pragma unroll
    for (int i = 0; i < 2; ++i) { int R, C; stage_rc(tid * 16 + i * 8192, R, C); const int Rb = Epi::PERM ? ((R & ~31) + perm32(R & 31)) : R;
        voffA[i] = (unsigned)(R * LD + C) * 2u; voffB[i] = (unsigned)(Rb * LD + C) * 2u; }
    const size_t kstep = (size_t)(BK * 2);
    const size_t hstep = (size_t)HALF * LD * 2;
    const size_t tstep = 2 * hstep;
    const unsigned ldsw = (unsigned)wid * 1024u;
    const int aoff = lds_byte(wr * 64 + fr, fq * 8), boff = lds_byte(wc * 32 + fr, fq * 8);
#define PG8_SA(b, h) (((b) * 2 + (h)) * HTB)
#define PG8_SB(b, h) ((4 + (b) * 2 + (h)) * HTB)
#define PG8_STAGE(bufoff, gbase, voff) do { _Pragma("unroll") for (int _i = 0; _i < 2; ++_i) \
        __builtin_amdgcn_global_load_lds((const unsigned*)((const char*)(gbase) + (voff)[_i]), (PG8_LAS unsigned*)(lds + (bufoff) + ldsw + _i * 8192), 16, 0, 0); } while (0)
#define PG8_LDA(dst, b, h) do { if constexpr (F8) { _Pragma("unroll") for (int m = 0; m < 4; ++m) { const v4i_t x_ = *(const PG8_LAS v4i_t*)(lds + PG8_SA(b, h) + aoff + m * 2048), y_ = *(const PG8_LAS v4i_t*)(lds + PG8_SA(b, h) + aoff + m * 2048 + 1024); \
        dst##8[m] = (v8i_t){x_[0], x_[1], x_[2], x_[3], y_[0], y_[1], y_[2], y_[3]}; } } \
    else { _Pragma("unroll") for (int m = 0; m < 4; ++m) _Pragma("unroll") for (int k = 0; k < 2; ++k) dst[m][k] = *(const PG8_LAS bf16x8*)(lds + PG8_SA(b, h) + aoff + m * 2048 + k * 1024); } } while (0)
#define PG8_LDB(dst, b, h) do { if constexpr (F8) { _Pragma("unroll") for (int n = 0; n < 2; ++n) { const v4i_t x_ = *(const PG8_LAS v4i_t*)(lds + PG8_SB(b, h) + boff + n * 2048), y_ = *(const PG8_LAS v4i_t*)(lds + PG8_SB(b, h) + boff + n * 2048 + 1024); \
        dst##8[n] = (v8i_t){x_[0], x_[1], x_[2], x_[3], y_[0], y_[1], y_[2], y_[3]}; } } \
    else { _Pragma("unroll") for (int n = 0; n < 2; ++n) _Pragma("unroll") for (int k = 0; k < 2; ++k) dst[n][k] = *(const PG8_LAS bf16x8*)(lds + PG8_SB(b, h) + boff + n * 2048 + k * 1024); } } while (0)
#define PG8_MMA(ai, bj, At, Bt) do { if constexpr (F8) __builtin_amdgcn_sched_barrier(0); __builtin_amdgcn_s_setprio(1); \
    if constexpr (F8) { _Pragma("unroll") for (int m = 0; m < 4; ++m) _Pragma("unroll") for (int n = 0; n < 2; ++n) \
        asm volatile("v_mfma_f32_16x16x128_f8f6f4 %0, %1, %2, %0" : "+v"(acc[ai][bj][m][n]) : "v"(Bt##8[n]), "v"(At##8[m])); } \
    else { _Pragma("unroll") for (int m = 0; m < 4; ++m) _Pragma("unroll") for (int n = 0; n < 2; ++n) _Pragma("unroll") for (int k = 0; k < 2; ++k) \
        acc[ai][bj][m][n] = __builtin_amdgcn_mfma_f32_16x16x32_bf16(Bt[n][k], At[m][k], acc[ai][bj][m][n], 0, 0, 0); } \
    __builtin_amdgcn_s_setprio(0); if constexpr (F8) __builtin_amdgcn_sched_barrier(0); } while (0)
#define PG8_WAIT_V(n) asm volatile("s_waitcnt vmcnt(" #n ")" ::: "memory")
#define PG8_WAIT_L(n) asm volatile("s_waitcnt lgkmcnt(" #n ")" ::: "memory")
#define PG8_BAR __builtin_amdgcn_s_barrier()
#define PG8_SCHED __builtin_amdgcn_sched_barrier(0)
    Unit cur, nxt; int ui = 0;
    if (!S.next(0, cur)) return;
    f32x4 acc[2][2][4][2];
#pragma unroll
    for (int a = 0; a < 2; ++a)
#pragma unroll
        for (int b = 0; b < 2; ++b)
#pragma unroll
            for (int m = 0; m < 4; ++m)
#pragma unroll
                for (int n = 0; n < 2; ++n) acc[a][b][m][n] = (f32x4){0.f, 0.f, 0.f, 0.f};
    bf16x8 At[4][2], B0[2][2], B1[2][2]; v8i_t At8[4], B08[2], B18[2];
    const char* cA = (const char*)g.A + (size_t)cur.pm * tstep + (size_t)cur.k0 * 2; const char* cB = (const char*)g.Bt + (size_t)cur.pn * tstep + (size_t)cur.k0 * 2;
    S.a_ready(cur);
    if constexpr (SP2) {
        PG8_STAGE(PG8_SB(0, 0), cB, voffB); PG8_STAGE(PG8_SB(0, 1), cB + hstep, voffB); PG8_STAGE(PG8_SA(0, 0), cA, voffA); PG8_STAGE(PG8_SA(0, 1), cA + hstep, voffA);
        if (wr == 1) PG8_BAR;
        PG8_WAIT_V(2); PG8_BAR;
        PG8_STAGE(PG8_SB(1, 0), cB + kstep, voffB); PG8_STAGE(PG8_SA(1, 0), cA + kstep, voffA); PG8_STAGE(PG8_SB(1, 1), cB + hstep + kstep, voffB);
        PG8_WAIT_V(6); PG8_BAR;
    } else {
        PG8_STAGE(PG8_SB(0, 0), cB, voffB); PG8_STAGE(PG8_SA(0, 0), cA, voffA); PG8_STAGE(PG8_SB(0, 1), cB + hstep, voffB); PG8_STAGE(PG8_SA(0, 1), cA + hstep, voffA);
        if (wr == 1) PG8_BAR;
        PG8_WAIT_V(4); PG8_BAR;
        PG8_STAGE(PG8_SB(1, 0), cB + kstep, voffB); PG8_STAGE(PG8_SA(1, 0), cA + kstep, voffA); PG8_STAGE(PG8_SB(1, 1), cB + hstep + kstep, voffB);
        PG8_WAIT_V(6); PG8_BAR;
    }
    for (;;) {
        const bool has_next = S.next(ui + 1, nxt);
        const char* nA = has_next ? (const char*)g.A + (size_t)nxt.pm * tstep + (size_t)nxt.k0 * 2 : cA; const char* nB = has_next ? (const char*)g.Bt + (size_t)nxt.pn * tstep + (size_t)nxt.k0 * 2 : cB;
#pragma clang loop unroll(disable)
        for (int t = 0; t < nt; t += 2) {
            const bool last = (t == nt - 2);
            const char* a1 = cA + (size_t)(t + 1) * kstep;
            const char* a2 = last ? nA : cA + (size_t)(t + 2) * kstep; const char* b2 = last ? nB : cB + (size_t)(t + 2) * kstep;
            const char* a3 = a2 + kstep; const char* b3 = b2 + kstep;
            if (last && has_next) S.a_ready(nxt);
            if constexpr (SP2) {
            PG8_LDB(B0, 0, 0); PG8_LDB(B1, 0, 1); PG8_SCHED; PG8_LDA(At, 0, 0); PG8_STAGE(PG8_SA(1, 1), a1 + hstep, voffA);
            PG8_WAIT_V(8); PG8_WAIT_L(0); PG8_BAR; PG8_MMA(0, 0, At, B0); PG8_MMA(0, 1, At, B1); PG8_BAR; PG8_SCHED;
            PG8_LDA(At, 0, 1); PG8_STAGE(PG8_SB(0, 0), b2, voffB); PG8_STAGE(PG8_SB(0, 1), b2 + hstep, voffB); PG8_STAGE(PG8_SA(0, 0), a2, voffA);
            PG8_WAIT_V(8); PG8_WAIT_L(0); PG8_BAR; PG8_MMA(1, 0, At, B0); PG8_MMA(1, 1, At, B1); PG8_BAR; PG8_SCHED;
            PG8_LDB(B0, 1, 0); PG8_LDB(B1, 1, 1); PG8_SCHED; PG8_LDA(At, 1, 0); PG8_STAGE(PG8_SA(0, 1), a2 + hstep, voffA);
            PG8_WAIT_V(8); PG8_WAIT_L(0); PG8_BAR; PG8_MMA(0, 0, At, B0); PG8_MMA(0, 1, At, B1); PG8_BAR; PG8_SCHED;
            PG8_LDA(At, 1, 1); PG8_STAGE(PG8_SB(1, 0), b3, voffB); PG8_STAGE(PG8_SB(1, 1), b3 + hstep, voffB); PG8_STAGE(PG8_SA(1, 0), a3, voffA);
            PG8_WAIT_V(8); PG8_WAIT_L(0); PG8_BAR; PG8_MMA(1, 0, At, B0); PG8_MMA(1, 1, At, B1); PG8_BAR; PG8_SCHED;
            } else {
            PG8_LDB(B0, 0, 0); PG8_SCHED; PG8_LDA(At, 0, 0); PG8_STAGE(PG8_SA(1, 1), a1 + hstep, voffA);
            PG8_WAIT_L(8); PG8_BAR; PG8_WAIT_L(0); PG8_MMA(0, 0, At, B0); PG8_BAR; PG8_SCHED;
            PG8_LDB(B1, 0, 1); PG8_STAGE(PG8_SB(0, 0), b2, voffB);
            PG8_BAR; PG8_WAIT_L(0); PG8_MMA(0, 1, At, B1); PG8_BAR;
            PG8_LDA(At, 0, 1); PG8_STAGE(PG8_SA(0, 0), a2, voffA);
            PG8_BAR; PG8_WAIT_L(0); PG8_MMA(1, 0, At, B0); PG8_BAR; PG8_SCHED;
            PG8_STAGE(PG8_SB(0, 1), b2 + hstep, voffB);
            PG8_WAIT_V(6); PG8_BAR; PG8_MMA(1, 1, At, B1); PG8_BAR;
            PG8_LDB(B0, 1, 0); PG8_SCHED; PG8_LDA(At, 1, 0); PG8_STAGE(PG8_SA(0, 1), a2 + hstep, voffA);
            PG8_WAIT_L(8); PG8_BAR; PG8_WAIT_L(0); PG8_MMA(0, 0, At, B0); PG8_BAR; PG8_SCHED;
            PG8_LDB(B1, 1, 1); PG8_STAGE(PG8_SB(1, 0), b3, voffB);
            PG8_BAR; PG8_WAIT_L(0); PG8_MMA(0, 1, At, B1); PG8_BAR;
            PG8_LDA(At, 1, 1); PG8_STAGE(PG8_SA(1, 0), a3, voffA);
            PG8_BAR; PG8_WAIT_L(0); PG8_MMA(1, 0, At, B0); PG8_BAR; PG8_SCHED;
            PG8_STAGE(PG8_SB(1, 1), b3 + hstep, voffB);
            PG8_WAIT_V(6); PG8_BAR; PG8_MMA(1, 1, At, B1); PG8_BAR;
            }
        }
        if constexpr (F8) asm volatile("s_nop 15\n\ts_nop 15" ::: "memory");
        if constexpr (ALIGN_EPI) { if (wr == 0) PG8_BAR; }
        if constexpr (!Epi::AFTER_DRAIN) { E(acc, cur, wr, wc, fr, fq); S.done(cur); }
        if (!has_next) break;
#pragma unroll
        for (int a = 0; a < 2; ++a)
#pragma unroll
            for (int b = 0; b < 2; ++b)
#pragma unroll
                for (int m = 0; m < 4; ++m)
#pragma unroll
                    for (int n = 0; n < 2; ++n) acc[a][b][m][n] = (f32x4){0.f, 0.f, 0.f, 0.f};
        cur = nxt; cA = nA; cB = nB; ++ui;
        if constexpr (ALIGN_EPI) { if (wr == 1) PG8_BAR; }
    }
    PG8_WAIT_V(0);
    if constexpr (!ALIGN_EPI) { if (wr == 0) PG8_BAR; }
    PG8_BAR;
    if constexpr (Epi::AFTER_DRAIN) { E.fused(acc, cur, wr, wc, fr, fq, lds, wid, lane); S.done(cur); }
#undef PG8_SA
#undef PG8_SB
#undef PG8_STAGE
#undef PG8_LDA
#undef PG8_LDB
#undef PG8_MMA
#undef PG8_WAIT_V
#undef PG8_WAIT_L
#undef PG8_BAR
#undef PG8_SCHED
}
}

namespace dattn {
using bf16x8 = __attribute__((ext_vector_type(8))) short;
using s16x4  = __attribute__((ext_vector_type(4))) short;
using f32x16 = __attribute__((ext_vector_type(16))) float;
using u32x4  = __attribute__((ext_vector_type(4))) unsigned;
typedef unsigned short bf16_t;
typedef __attribute__((address_space(3))) const char* lds_cptr;
typedef short v4i16_t __attribute__((ext_vector_type(4)));
typedef int v8i_t __attribute__((ext_vector_type(8)));
typedef int v4i_t __attribute__((ext_vector_type(4)));
constexpr int SEQ = 8192, LDQ = 1024, LDR = 128, KVBLK = 64, NT = SEQ / KVBLK;
constexpr int SLOT_B = 16384, NSLOT = 4, V_IN_SLOT = 8192;
constexpr int OFF_COMB = 0, OFF_STG = 65536, OFF_WS = 131072, ATTN_LDS_BYTES = OFF_WS + 8 * 64 * 4;
#define KSWZ(row, colB) ((row) * 256 + ((colB) ^ (((row) & 7) << 4)))
#define SBAR() __builtin_amdgcn_sched_barrier(0)
__device__ __forceinline__ int crow(int r, int hi) { return (r & 3) + 8 * (r >> 2) + 4 * hi; }
__device__ __forceinline__ unsigned cvtpk(float lo, float hi) { unsigned r; asm volatile("v_cvt_pk_bf16_f32 %0, %1, %2" : "=v"(r) : "v"(lo), "v"(hi)); return r; }
__device__ __forceinline__ void glds16(const void* gsrc, unsigned lds_dst) { unsigned keep;
  asm volatile("s_mov_b32 %0, m0\n\ts_mov_b32 m0, %2\n\ts_nop 0\n\tglobal_load_lds_dwordx4 %1, off\n\ts_mov_b32 m0, %0" : "=&s"(keep) : "v"(gsrc), "s"(lds_dst) : "memory"); }
__device__ __forceinline__ s16x4 vtr(lds_cptr p) { return __builtin_bit_cast(s16x4, __builtin_amdgcn_ds_read_tr16_b64_v4i16((__attribute__((address_space(3))) v4i16_t*)p)); }
__device__ __forceinline__ v8i_t kfrag32(lds_cptr p0, lds_cptr p1) { const v4i_t x_ = *(const __attribute__((address_space(3))) v4i_t*)p0, y_ = *(const __attribute__((address_space(3))) v4i_t*)p1; return (v8i_t){x_[0], x_[1], x_[2], x_[3], y_[0], y_[1], y_[2], y_[3]}; }
__device__ __forceinline__ int v_rd_base(int lane) { return ((lane & 3) << 3) | (((lane >> 2) & 3) << 6) | (((lane >> 4) & 1) << 5) | (((lane >> 5) & 1) << 8); }
constexpr int v_rd_off(int d0, int ks, int half) { return d0 * 512 + ks * 4096 + half * 2048; }
#define WAIT_BAR(N) asm volatile("s_waitcnt vmcnt(" #N ") lgkmcnt(0)\n\ts_barrier" ::: "memory")
#define MF(A, B, C) __builtin_amdgcn_mfma_f32_32x32x16_bf16(A, B, C, 0, 0, 0)
typedef short v2s_t __attribute__((ext_vector_type(2)));
typedef float v4f_t __attribute__((ext_vector_type(4)));
__device__ __forceinline__ void glds_kv(const void* kbase, const void* vbase, unsigned koff, unsigned voff, unsigned lds_k, unsigned lds_v) { unsigned keep;
  asm volatile("s_mov_b32 %0, m0\n\ts_mov_b32 m0, %5\n\ts_nop 0\n\tglobal_load_lds_dwordx4 %1, %3\n\ts_mov_b32 m0, %6\n\ts_nop 0\n\tglobal_load_lds_dwordx4 %2, %4\n\ts_mov_b32 m0, %0"
               : "=&s"(keep) : "v"(koff), "v"(voff), "s"(kbase), "s"(vbase), "s"(lds_k), "s"(lds_v) : "memory"); }
__device__ __forceinline__ int pk4_bf8(float a, float b, float c, float d) { int r;
  asm("v_cvt_scalef32_pk_bf8_f32 %0, %1, %2, %3" : "=v"(r) : "v"(a), "v"(b), "s"(16.0f));
  asm("v_cvt_scalef32_pk_bf8_f32 %0, %1, %2, %3 op_sel:[0,0,0,1]" : "+v"(r) : "v"(c), "v"(d), "s"(16.0f)); return r; }
#define PK8(P, B, W0, W1) do { W0 = pk4_bf8(P[B], P[B + 1], P[B + 2], P[B + 3]); W1 = pk4_bf8(P[B + 4], P[B + 5], P[B + 6], P[B + 7]); } while (0)
__device__ __forceinline__ float fadd_s(float a, float b) { float r; asm("v_add_f32_e32 %0, %1, %2" : "=v"(r) : "v"(a), "v"(b)); return r; }
#define SUM8(P, B) fadd_s(fadd_s(fadd_s(P[B], P[B + 1]), fadd_s(P[B + 2], P[B + 3])), fadd_s(fadd_s(P[B + 4], P[B + 5]), fadd_s(P[B + 6], P[B + 7])))
__device__ __forceinline__ bf16x8 vfrag(lds_cptr vp, int off0, int off1) { const s16x4 l_ = vtr(vp + off0), h_ = vtr(vp + off1); return (bf16x8){l_[0], l_[1], l_[2], l_[3], h_[0], h_[1], h_[2], h_[3]}; }
#define VFRAG(d0, ks) vfrag(vp_, v_rd_off(d0, ks, 0), v_rd_off(d0, ks, 1))

template <bool SHIFT> __device__ __forceinline__ void attn_unit(int b, int h, int qb, const unsigned char* __restrict__ Q8, const unsigned char* __restrict__ KH8, const unsigned char* __restrict__ VT8, bf16_t* __restrict__ O, float lam, float negmb, float osc, const float* __restrict__ subg, char* lds) {
  int tid = threadIdx.x; asm volatile("" : "+v"(tid));
  const int lane = tid & 63, r32 = lane & 31, hi = lane >> 5; const int wid = __builtin_amdgcn_readfirstlane(tid >> 6);
  const int comp = wid >> 2, qs = wid & 3;
  const unsigned lds0 = (unsigned)(uintptr_t)lds; const lds_cptr lds3 = (lds_cptr)lds;
  float* wsf = (float*)(lds + OFF_WS) + wid * 64;
  const long rowbase = (long)b * SEQ; const int q0 = qb * 128;
  const unsigned char* Kh = KH8 + (long)(b * 8 + h) * SEQ * 128; const unsigned char* Vh = VT8 + (long)(b * 8 + h) * SEQ * 128;
  int kso, vso;
  { const int row = 8 * wid + (lane >> 3), ch = (lane & 7) ^ ((row >> 1) & 7); kso = row * 128 + ch * 16; }
  { const int d = 16 * wid + (lane >> 2), ch = (lane & 3) ^ ((d >> 2) & 3); vso = d * 64 + ch * 16; }
  const unsigned ldsw = (unsigned)__builtin_amdgcn_readfirstlane(lds0 + wid * 1024);
#define DMA_TILE(t, slotoff) do { const long tb_ = (long)(t) * (KVBLK * 128); glds_kv(Kh + tb_, Vh + tb_, kso, vso, ldsw + (slotoff), ldsw + (slotoff) + V_IN_SLOT); } while (0)
  v8i_t qf;
  { const v4i_t* Qw = (const v4i_t*)(Q8 + (rowbase + q0 + qs * 32 + r32) * 1024 + h * 128 + comp * 64 + hi * 32); const v4i_t x_ = Qw[0], y_ = Qw[1];
    qf = (v8i_t){x_[0], x_[1], x_[2], x_[3], y_[0], y_[1], y_[2], y_[3]}; }
  asm volatile("" ::: "memory");
  DMA_TILE(0, 0); DMA_TILE(1, SLOT_B); DMA_TILE(2, 2 * SLOT_B);
  const int ob_ = ((lane & 15) == ((lane >> 4) & 1)) ? 0x22222222 : 0; const v4i_t onesB = {ob_, ob_, ob_, ob_};
  v4f_t Lacc = {0.f, 0.f, 0.f, 0.f};
#define MFL(PF) asm volatile("v_mfma_f32_16x16x128_f8f6f4 %0, %1, %2, %0 cbsz:1 blgp:4" : "+v"(Lacc) : "v"(PF), "v"(onesB))
  const int ka0 = r32 * 128 + (((comp * 4 + 2 * hi) ^ ((r32 >> 1) & 7)) << 4), ka1 = r32 * 128 + (((comp * 4 + 2 * hi + 1) ^ ((r32 >> 1) & 7)) << 4);
#define KFRAG(kp, hb) kfrag32((kp) + ka0 + (hb) * 4096, (kp) + ka1 + (hb) * 4096)
#define VFRAG8(vp, d0) kfrag32((vp) + va0_ + (d0) * 2048, (vp) + va1_ + (d0) * 2048)
#define MFPV(OD, PF, VF) asm volatile("v_mfma_f32_32x32x64_f8f6f4 %0, %1, %2, %0 cbsz:1" : "+v"(OD) : "v"(PF), "v"(VF))
#define MFQK(C, KF) asm volatile("v_mfma_f32_32x32x64_f8f6f4 %0, %1, %2, 0" : "=&v"(C) : "v"(KF), "v"(qf))
  const int va0_ = V_IN_SLOT + r32 * 64 + (((2 * hi) ^ ((r32 >> 2) & 3)) << 4), va1_ = V_IN_SLOT + r32 * 64 + (((2 * hi + 1) ^ ((r32 >> 2) & 3)) << 4);
  f32x16 o[4];
#pragma unroll
  for (int d0 = 0; d0 < 4; ++d0) o[d0] = f32x16{};
  f32x16 pA0, pA1, pB0, pB1;
#define EX(v) __builtin_amdgcn_exp2f(SHIFT ? (v) + negmb : (v))
#define PIN(x) asm volatile("" : "+v"(x))
#define STEP(CX0, CX1, PY0, PY1, ks_, vs_) do { \
    const lds_cptr kp_ = lds3 + (ks_); const lds_cptr vp_ = lds3 + (vs_); \
    const v8i_t kf0 = KFRAG(kp_, 0), kf1 = KFRAG(kp_, 1); \
    int w0_, w1_, w2_, w3_, w4_, w5_, w6_, w7_; SBAR(); \
    MFQK(CX0, kf0); \
    PK8(PY0, 0, w0_, w1_); PK8(PY0, 8, w2_, w3_); SBAR(); \
    MFQK(CX1, kf1); \
    v8i_t vf0 = VFRAG8(vp_, 0), vf1 = VFRAG8(vp_, 1); \
    PK8(PY1, 0, w4_, w5_); PK8(PY1, 8, w6_, w7_); \
    const v8i_t pf_ = {w0_, w1_, w2_, w3_, w4_, w5_, w6_, w7_}; SBAR(); \
      \
    asm volatile("s_nop 1" ::: "memory"); \
    MFPV(o[0], pf_, vf0); v8i_t vf2 = VFRAG8(vp_, 2); \
    _Pragma("unroll") for (int r_ = 0; r_ < 8; ++r_) CX0[r_] = EX(CX0[r_]); SBAR(); \
    MFPV(o[1], pf_, vf1); v8i_t vf3 = VFRAG8(vp_, 3); \
    _Pragma("unroll") for (int r_ = 8; r_ < 16; ++r_) CX0[r_] = EX(CX0[r_]); PIN(CX0); SBAR(); \
    MFPV(o[2], pf_, vf2); \
    _Pragma("unroll") for (int r_ = 0; r_ < 8; ++r_) CX1[r_] = EX(CX1[r_]); SBAR(); \
    MFPV(o[3], pf_, vf3); MFL(pf_); \
    _Pragma("unroll") for (int r_ = 8; r_ < 16; ++r_) CX1[r_] = EX(CX1[r_]); PIN(CX1); SBAR(); \
  } while (0)
  if (wid >= 4) __builtin_amdgcn_s_setprio(1);
  WAIT_BAR(4);
  { const lds_cptr kp_ = lds3; const v8i_t kf0 = KFRAG(kp_, 0), kf1 = KFRAG(kp_, 1);
    MFQK(pA0, kf0); MFQK(pA1, kf1);
    asm volatile("s_nop 15\n\ts_nop 15\n\ts_nop 15\n\ts_nop 15" ::: "memory");
#pragma unroll
    for (int r = 0; r < 16; ++r) { pA0[r] = EX(pA0[r]); pA1[r] = EX(pA1[r]); } }
  WAIT_BAR(2);
#define SLOT(t) ((((t)) & 3) * SLOT_B)
  int j = 1;
  for (; j + 6 < NT; j += 4) {
    DMA_TILE(j + 2, SLOT(3));
    STEP(pB0, pB1, pA0, pA1, SLOT(1), SLOT(0)); WAIT_BAR(2);
    DMA_TILE(j + 3, SLOT(0));
    STEP(pA0, pA1, pB0, pB1, SLOT(2), SLOT(1)); WAIT_BAR(2);
    DMA_TILE(j + 4, SLOT(1));
    STEP(pB0, pB1, pA0, pA1, SLOT(3), SLOT(2)); WAIT_BAR(2);
    DMA_TILE(j + 5, SLOT(2));
    STEP(pA0, pA1, pB0, pB1, SLOT(0), SLOT(3)); WAIT_BAR(2);
  }
  DMA_TILE(j + 2, SLOT(3));
  STEP(pB0, pB1, pA0, pA1, SLOT(1), SLOT(0)); WAIT_BAR(2);
  STEP(pA0, pA1, pB0, pB1, SLOT(2), SLOT(1)); WAIT_BAR(0);
  STEP(pB0, pB1, pA0, pA1, SLOT(3), SLOT(2));
  { int w0_, w1_, w2_, w3_, w4_, w5_, w6_, w7_;
    PK8(pB0, 0, w0_, w1_); PK8(pB0, 8, w2_, w3_); PK8(pB1, 0, w4_, w5_); PK8(pB1, 8, w6_, w7_);
    const v8i_t pf_ = {w0_, w1_, w2_, w3_, w4_, w5_, w6_, w7_};
    const lds_cptr vp_ = lds3 + SLOT(3);
    const v8i_t vf0 = VFRAG8(vp_, 0), vf1 = VFRAG8(vp_, 1), vf2 = VFRAG8(vp_, 2), vf3 = VFRAG8(vp_, 3);
    asm volatile("s_nop 1" ::: "memory");
    MFPV(o[0], pf_, vf0); MFPV(o[1], pf_, vf1); MFPV(o[2], pf_, vf2); MFPV(o[3], pf_, vf3); MFL(pf_);
    asm volatile("s_nop 15\n\ts_nop 15\n\ts_nop 15\n\ts_nop 15\n\ts_nop 15\n\ts_nop 15" ::: "memory");
  }
#undef STEP
#undef VFRAG8
#undef MFPV
#undef MFL
#undef PK8
#undef KFRAG
#undef MFQK
#undef SLOT
#undef DMA_TILE
#undef EX
#undef PIN
  __builtin_amdgcn_s_setprio(0);
  if ((lane & 15) < 2) { const float cf_ = (comp == 0 ? 1.0f : -lam);
    const v4f_t c4 = {cf_ * __builtin_amdgcn_rcpf(Lacc[0]), cf_ * __builtin_amdgcn_rcpf(Lacc[1]), cf_ * __builtin_amdgcn_rcpf(Lacc[2]), cf_ * __builtin_amdgcn_rcpf(Lacc[3])};
    *(v4f_t*)(wsf + 16 * (lane & 15) + 4 * (lane >> 4)) = c4; }
  asm volatile("s_waitcnt lgkmcnt(0)" ::: "memory");
  float rli[16];
#pragma unroll
  for (int r = 0; r < 16; ++r) rli[r] = wsf[crow(r, hi)];
#pragma unroll
  for (int d0 = 0; d0 < 4; ++d0)
#pragma unroll
    for (int r = 0; r < 16; ++r) o[d0][r] *= rli[r];
  __syncthreads();
  float* comb = (float*)(lds + OFF_COMB) + qs * 4096 + lane;
  if (comp == 1) {
#pragma unroll
    for (int d0 = 0; d0 < 4; ++d0)
#pragma unroll
      for (int r = 0; r < 16; ++r) comb[(d0 * 16 + r) * 64] = o[d0][r];
  }
  __syncthreads();
  if (comp == 0) {
#pragma unroll
    for (int d0 = 0; d0 < 4; ++d0)
#pragma unroll
      for (int r = 0; r < 16; ++r) o[d0][r] += comb[(d0 * 16 + r) * 64];
    float gcol[4];
#pragma unroll
    for (int d0 = 0; d0 < 4; ++d0) gcol[d0] = subg[d0 * 32 + r32] * osc;
    bf16_t* stg = (bf16_t*)(lds + OFF_STG) + qs * 4096;
#pragma unroll
    for (int r = 0; r < 16; ++r) {
      float ss = (o[0][r] * o[0][r] + o[1][r] * o[1][r]) + (o[2][r] * o[2][r] + o[3][r] * o[3][r]);
      ss += __shfl_xor(ss, 1); ss += __shfl_xor(ss, 2); ss += __shfl_xor(ss, 4); ss += __shfl_xor(ss, 8); ss += __shfl_xor(ss, 16);
      const float rn = __builtin_amdgcn_rsqf(ss * (1.0f / 128.0f) + 1e-6f);
      const int orow = crow(r, hi);
#pragma unroll
      for (int d0 = 0; d0 < 4; ++d0) { const float v = o[d0][r] * rn * gcol[d0]; stg[orow * 128 + d0 * 32 + r32] = (bf16_t)(cvtpk(v, v) & 0xffffu); }
    }
    asm volatile("s_waitcnt lgkmcnt(0)" ::: "memory");
    bf16_t* Ow = O + (rowbase + q0 + qs * 32) * 1024 + h * 128;
#pragma unroll
    for (int i = 0; i < 8; ++i) { const int row = i * 4 + (lane >> 4), ch = lane & 15; const u32x4 v = *(const u32x4*)(stg + row * 128 + ch * 8); *(u32x4*)(Ow + (long)row * 1024 + ch * 8) = v; }
  }
  __syncthreads();
}
#undef KSWZ
#undef SBAR
#undef WAIT_BAR
#undef MF
#undef PK4
#undef SUM8
#undef VFRAG
}

constexpr int NWAVES = 8;
constexpr int BATCH = 2, SEQ = 8192, D = 1024, M = BATCH * SEQ, NQKV = 3072, DFF = 2816, NE = 8, DFE = 3584, NH = 8;
constexpr float LAMBDA_INIT = 0.35550906759096934f;
constexpr size_t MiB = 1u << 20, KiB = 1u << 10;
constexpr size_t WS_CTL = 0, CTL_ZERO_BYTES = 1 * MiB;
constexpr size_t WS_ROPE = 1 * MiB, WS_SSQP1 = 2 * MiB, WS_SSQP2 = 3 * MiB;
constexpr size_t WS_SSQ0 = 4 * MiB, WS_TOKE = WS_SSQ0 + 64 * KiB, WS_TOKG = WS_TOKE + 64 * KiB, WS_TOKRS = WS_TOKG + 128 * KiB, WS_TOKSLOT = WS_TOKRS + 64 * KiB,
                 WS_HIST = WS_TOKSLOT + 128 * KiB, WS_SLOTRS = WS_HIST + 64 * KiB, WS_SLOTG = WS_SLOTRS + 192 * KiB, WS_META = WS_SLOTG + 192 * KiB, WS_CONST = WS_META + 4 * KiB, WS_RG = WS_CONST + 4 * KiB;
static_assert(WS_RG + 32 * KiB <= 5 * MiB, "small tables");
constexpr size_t WS_WM13 = 8 * MiB, WS_WM2 = 64 * MiB, WS_WCI = 92 * MiB, WS_WCO = 98 * MiB, WS_WAI = 100 * MiB, WS_WAO = 106 * MiB, WS_W13 = 108 * MiB, WS_W2 = 119 * MiB;
constexpr size_t WS_XB = 126 * MiB, WS_R1 = 158 * MiB, WS_GO = 254 * MiB;
constexpr size_t WS_HG = 158 * MiB, WS_Y = 192 * MiB, WS_HIDM = 260 * MiB, WS_YP = 379 * MiB, WS_END = 407 * MiB;
constexpr int MOE_T1 = 128, MOE_LMAX = 8, MOE_NSPLIT = 7, MOE_KS = 512, MOE_TMAX = 136;
constexpr float W8_SCALE = 64.0f, H8_SCALE = 4.0f;
static_assert(WS_WM13 + (size_t)NE * 2 * DFE * D <= WS_WM2 && WS_WM2 + (size_t)NE * D * DFE <= WS_WCI && WS_W13 + (size_t)2 * DFF * D * 2 <= WS_W2 && WS_W2 + (size_t)D * DFF * 2 <= WS_XB, "weights");
static_assert(WS_XB + (size_t)M * D * 2 <= WS_R1 && WS_R1 + (size_t)M * NQKV * 2 <= WS_GO && WS_HG + (size_t)MOE_TMAX * 256 * D <= WS_Y && WS_Y + (size_t)MOE_TMAX * 256 * D * 2 <= WS_HIDM && WS_HIDM + (size_t)MOE_TMAX * 256 * DFE <= WS_YP
              && WS_YP + (size_t)MOE_NSPLIT * MOE_LMAX * 256 * D * 2 <= WS_END && MOE_NSPLIT * MOE_KS == DFE, "activations");
constexpr int CW_BAR = 4096;
constexpr int RING_OFF = 0, RING_BYTES = 135168;
constexpr int LDSCTL_OFF = RING_BYTES, MISC_OFF = LDSCTL_OFF + 320, TEXP_OFF = LDSCTL_OFF + 1024;
constexpr int LDS_BYTES = 147456;
static_assert(dattn::ATTN_LDS_BYTES <= RING_BYTES, "attention scratch");
#define GAS __attribute__((address_space(1)))
#define LAS __attribute__((address_space(3)))
typedef unsigned short bf16;
typedef unsigned v4u __attribute__((ext_vector_type(4)));
typedef float f32x4 __attribute__((ext_vector_type(4)));
typedef GAS unsigned gu32;
#define LDS_WAIT() asm volatile("s_waitcnt lgkmcnt(0)" ::: "memory")
__device__ __forceinline__ unsigned f2bf(float f) { unsigned u = __builtin_bit_cast(unsigned, f); return (u + 0x7fffu + ((u >> 16) & 1u)) >> 16; }
__device__ __forceinline__ unsigned pk2(float lo, float hi) { return f2bf(lo) | (f2bf(hi) << 16); }
struct Inputs { const float* x; const int* positions; const float *norm_mix, *norm_ffn, *conv_in, *conv_w, *conv_out, *attn_in, *q_norm, *k_norm, *lam_q1, *lam_k1, *lam_q2, *lam_k2, *subln, *attn_out,
                *ffn_w1, *ffn_w3, *ffn_w2, *router, *moe_w1, *moe_w3, *moe_w2; };

#define XB_TMO      128
#define XB_XCNT(j)  (256  + 64 * (j))
#define XB_XSUB(j)  (1280 + 64 * (j))
#define XB_XGEN(j)  (2304 + 64 * (j))
#define XB_TOP      3328
#define XB_TOPGEN   3392
#define XCD_BAR_WORDS 3456
#define XB_SPIN_CAP (1u << 18)

__device__ __forceinline__ unsigned xb_ld(unsigned* p)              { return __hip_atomic_load(p, __ATOMIC_RELAXED, __HIP_MEMORY_SCOPE_AGENT); }
__device__ __forceinline__ unsigned xb_add(unsigned* p, unsigned v) { return __hip_atomic_fetch_add(p, v, __ATOMIC_RELAXED, __HIP_MEMORY_SCOPE_AGENT); }
__device__ __forceinline__ unsigned xb_xcc_id() { return (unsigned)__builtin_amdgcn_s_getreg((3 << 11) | 20) & 0xFu; }
#define XB_SPIN(cond, bar) do { unsigned _sp = 0; while (cond) { __builtin_amdgcn_s_sleep(1); \
    if ((++_sp & 255u) == 0u) { if (xb_ld(&(bar)[XB_TMO])) break; if (_sp > XB_SPIN_CAP) { atomicAdd(&(bar)[XB_TMO], 1u); break; } } } } while (0)

struct XcdBarrier {
    unsigned* bar; unsigned x;
    volatile LAS unsigned* st;
};

__device__ __forceinline__ XcdBarrier xcd_barrier_post(unsigned* bar, volatile LAS unsigned* st) {
    XcdBarrier b; b.bar = bar; b.x = xb_xcc_id(); b.st = st;
    if (threadIdx.x == 0) (void)xb_add(&bar[XB_XCNT(b.x)], 1u);
    return b;
}
__device__ __forceinline__ void xcd_barrier_complete(unsigned* bar, unsigned x, unsigned& nloc, unsigned& nx) {
    const unsigned G = gridDim.x * gridDim.y * gridDim.z;
    unsigned sum, cnt, mine, sp = 0u;
    for (;;) {
        sum = 0u; cnt = 0u; mine = 0u;
#pragma unroll
        for (unsigned j = 0; j < 16; ++j) { const unsigned c = xb_ld(&bar[XB_XCNT(j)]); sum += c; cnt += (c > 0u) ? 1u : 0u; mine = (j == x) ? c : mine; }
        if (sum == G) break;
        __builtin_amdgcn_s_sleep(1);
        if ((++sp & 255u) == 0u) { if (xb_ld(&bar[XB_TMO])) break; if (sp > XB_SPIN_CAP) { atomicAdd(&bar[XB_TMO], 1u); break; } }
    }
    nloc = mine > 0u ? mine : 1u; nx = cnt > 0u ? cnt : 1u;
}

__device__ __forceinline__ void xcd_barrier(const XcdBarrier& b) {
    asm volatile("s_waitcnt vmcnt(0)" ::: "memory");
    __syncthreads();
    if (threadIdx.x == 0) {
        unsigned* bar = b.bar;
        __builtin_amdgcn_s_waitcnt(0);
        unsigned nloc = b.st[0], nx = b.st[1];
        if (nloc == 0u) { xcd_barrier_complete(bar, b.x, nloc, nx); b.st[0] = nloc; b.st[1] = nx; }
        const unsigned old = xb_add(&bar[XB_XSUB(b.x)], 1u);
        const unsigned gen = old / nloc;
        if (old + 1u == (gen + 1u) * nloc) {
            __builtin_amdgcn_fence(__ATOMIC_RELEASE, "agent");
            asm volatile("s_waitcnt vmcnt(0)" ::: "memory");
            const unsigned og = xb_add(&bar[XB_TOP], 1u);
            const unsigned tg = og / nx;
            if (og + 1u == (tg + 1u) * nx) xb_add(&bar[XB_TOPGEN], 1u);
            else XB_SPIN(xb_ld(&bar[XB_TOPGEN]) == tg, bar);
            __builtin_amdgcn_fence(__ATOMIC_ACQUIRE, "agent");
            xb_add(&bar[XB_XGEN(b.x)], 1u);
            asm volatile("s_waitcnt vmcnt(0)" ::: "memory");
        } else {
            XB_SPIN(xb_ld(&bar[XB_XGEN(b.x)]) == gen, bar);
            __builtin_amdgcn_fence(__ATOMIC_ACQUIRE, "agent");
            asm volatile("s_waitcnt vmcnt(0)" ::: "memory");
        }
    }
    __syncthreads();
}

struct Frame {
    LAS unsigned char* lds;
    volatile LAS unsigned* MISC;
    gu32* ctl;
    int tid, lane, wave;
    int vcu, G;
};

__device__ __forceinline__ float wave_sum(float v) {
#pragma unroll
    for (int o = 1; o < 64; o <<= 1) v += __shfl_xor(v, o);
    return v;
}
__device__ __forceinline__ float wave_max(float v) {
#pragma unroll
    for (int o = 1; o < 64; o <<= 1) v = fmaxf(v, __shfl_xor(v, o));
    return v;
}
__device__ __forceinline__ float bf2f(unsigned short h) { return __uint_as_float((unsigned)h << 16); }
template <int MAP> __device__ __forceinline__ int rowmap(int n0) {
    if (MAP == 1) return (n0 >> 7) * 256 + (n0 & 127);
    if (MAP == 2) return (n0 >> 7) * 256 + 128 + (n0 & 127);
    if (MAP == 3) return (n0 & ~255) + ((n0 >> 5) & 1) * 128 + ((n0 >> 6) & 3) * 32;
    if (MAP == 4) { if (n0 < D) return n0; const int c = (n0 - D) & (D - 1); return D + (c >> 7) * 256 + (n0 >= 2 * D ? 128 : 0) + (c & 127); }
    return n0;
}
template <int MAP> __device__ __forceinline__ void transpose_item(const float* W, int K, int N, const float* gain, bf16* WT, LAS unsigned* T, int item, int lane) {
    const int nblk = N / 64, kb = item / nblk, nb = item % nblk, k0 = 64 * kb, n0 = 64 * nb;
    const int kk = lane >> 4, nn = (lane & 15) * 4;
    f32x4 a[8], b[8];
    const float* Wp = W + (size_t)(k0 + 2 * kk) * N + n0 + nn;
    float ga[8], gb[8];
#pragma unroll
    for (int i = 0; i < 8; ++i) { ga[i] = gain ? gain[k0 + 8 * i + 2 * kk] : 1.0f; gb[i] = gain ? gain[k0 + 8 * i + 2 * kk + 1] : 1.0f; }
#pragma unroll
    for (int i = 0; i < 8; ++i) { a[i] = __builtin_nontemporal_load((const f32x4*)(Wp + (size_t)(8 * i) * N)); b[i] = __builtin_nontemporal_load((const f32x4*)(Wp + (size_t)(8 * i + 1) * N)); }
    asm volatile("" ::: "memory");
#pragma unroll
    for (int i = 0; i < 8; ++i) {
        if (gain) { a[i] = a[i] * ga[i]; b[i] = b[i] * gb[i]; }
#pragma unroll
        for (int e = 0; e < 4; ++e) T[(nn + e) * 36 + 4 * i + kk] = pg8::cvt_pk_bf16(a[i][e], b[i][e]); }
    LDS_WAIT(); asm volatile("" ::: "memory");
    const int c = lane & 7;
#pragma unroll
    for (int j = 0; j < 8; ++j) { const int n = (lane >> 3) + 8 * j; const v4u o = *(const LAS v4u*)(T + n * 36 + 4 * c);
        const int drow = rowmap<MAP>(n0 + (n & 32)) + (n & 31);
        *(GAS v4u*)(WT + (size_t)drow * K + k0 + 8 * c) = o; }
    LDS_WAIT(); asm volatile("" ::: "memory");
}

template <int MAP> __device__ __forceinline__ void transpose_item8(const float* W, int K, int N, const float* gain, unsigned char* WT, LAS unsigned* T, int item, int lane) {
    const int nblk = N / 64, kb = item / nblk, nb = item % nblk, k0 = 64 * kb, n0 = 64 * nb;
    const int kk = lane >> 4, nn = (lane & 15) * 4;
    f32x4 a[4][4];
    const float* Wp = W + (size_t)(k0 + 4 * kk) * N + n0 + nn;
#pragma unroll
    for (int i = 0; i < 4; ++i)
#pragma unroll
        for (int q = 0; q < 4; ++q) a[i][q] = __builtin_nontemporal_load((const f32x4*)(Wp + (size_t)(16 * i + q) * N));
    asm volatile("" ::: "memory");
#pragma unroll
    for (int i = 0; i < 4; ++i) { const int r = 16 * i + 4 * kk;
        float g[4];
#pragma unroll
        for (int q = 0; q < 4; ++q) g[q] = (gain ? gain[k0 + r + q] : 1.0f) * W8_SCALE;
#pragma unroll
        for (int e = 0; e < 4; ++e) { int p = 0; p = __builtin_amdgcn_cvt_pk_fp8_f32(a[i][0][e] * g[0], a[i][1][e] * g[1], p, false); p = __builtin_amdgcn_cvt_pk_fp8_f32(a[i][2][e] * g[2], a[i][3][e] * g[3], p, true);
            T[(nn + e) * 20 + 4 * i + kk] = (unsigned)p; } }
    LDS_WAIT(); asm volatile("" ::: "memory");
    const int c = lane & 3;
#pragma unroll
    for (int j = 0; j < 4; ++j) { const int n = (lane >> 2) + 16 * j; const v4u o = *(const LAS v4u*)(T + n * 20 + 4 * c);
        const int drow = rowmap<MAP>(n0 + (n & 32)) + (n & 31);
        __builtin_nontemporal_store(o, (GAS v4u*)(WT + (size_t)drow * K + k0 + 16 * c)); }
    LDS_WAIT(); asm volatile("" ::: "memory");
}

__device__ __constant__ double ROPE_TURNS[8] = {
    0.15915494309189535, 0.03086376340470123, 0.005985185712713705, 0.001160663641240061,
    0.00022507907903927653, 4.364795279280289e-05, 8.464330808241401e-06, 1.6414262627950345e-06 };

__device__ __forceinline__ void p0_prologue(Frame& F, const Inputs& I, unsigned char* ws) {
    LAS unsigned* scr = (LAS unsigned*)(F.lds + RING_OFF + F.wave * 16384);
    const int gw = F.vcu * NWAVES + F.wave, NGW = F.G * NWAVES;
    constexpr int I_CI = (D / 64) * (NQKV / 64), I_CO = (D / 64) * (D / 64), I_F13 = (D / 64) * (DFF / 64), I_F2 = (DFF / 64) * (D / 64);
    constexpr int I_M13 = (D / 64) * (DFE / 64), I_M2 = (DFE / 64) * (D / 64);
    constexpr int NITEMS = I_CI + I_CO + 2 * I_F13;
    bf16* WCI = (bf16*)(ws + WS_WCI); bf16* WCO = (bf16*)(ws + WS_WCO); bf16* W13 = (bf16*)(ws + WS_W13);
    for (int it = gw; it < NITEMS; it += NGW) {
        int r = it;
        if (r < I_CI) { transpose_item<4>(I.conv_in, D, NQKV, I.norm_mix, WCI, scr, r, F.lane); continue; } r -= I_CI;
        if (r < I_CO) { transpose_item<0>(I.conv_out, D, D, nullptr, WCO, scr, r, F.lane); continue; } r -= I_CO;
        if (r < I_F13) { transpose_item<1>(I.ffn_w1, D, DFF, I.norm_ffn, W13, scr, r, F.lane); continue; } r -= I_F13;
        transpose_item<2>(I.ffn_w3, D, DFF, I.norm_ffn, W13, scr, r, F.lane);
    }
    bf16* XB = (bf16*)(ws + WS_XB); float* SSQ0 = (float*)(ws + WS_SSQ0); float* ROPE = (float*)(ws + WS_ROPE);
    for (int m0 = gw; m0 < M; m0 += 2 * NGW) {
        f32x4 v[2][4];
#pragma unroll
        for (int h = 0; h < 2; ++h) { const int m = m0 + h * NGW; if (m < M) { const GAS f32x4* xr = (const GAS f32x4*)(I.x + (size_t)m * D) + F.lane;
#pragma unroll
            for (int j = 0; j < 4; ++j) v[h][j] = __builtin_nontemporal_load(xr + 64 * j); } }
#pragma unroll
        for (int h = 0; h < 2; ++h) { const int m = m0 + h * NGW; if (m < M) { GAS unsigned long long* o8 = (GAS unsigned long long*)(XB + (size_t)m * D) + F.lane;
            float s = 0.f;
#pragma unroll
            for (int j = 0; j < 4; ++j) { const f32x4 w = v[h][j]; s += (w.x * w.x + w.y * w.y) + (w.z * w.z + w.w * w.w);
                o8[64 * j] = (unsigned long long)pk2(w.x, w.y) | ((unsigned long long)pk2(w.z, w.w) << 32); }
            s = wave_sum(s);
            if (F.lane == 0) SSQ0[m] = s;
            if (F.lane < 8) { const double t = (double)I.positions[m] * ROPE_TURNS[F.lane]; const float fr = (float)(t - __builtin_floor(t));
                ROPE[(size_t)m * 16 + F.lane] = __builtin_amdgcn_cosf(fr); ROPE[(size_t)m * 16 + 8 + F.lane] = __builtin_amdgcn_sinf(fr); } } }
    }
    { float* RG = (float*)(ws + WS_RG);
      for (int k = gw * 64 + F.lane; k < D; k += NGW * 64) { const float g = I.norm_ffn[D + k];
#pragma unroll
          for (int e = 0; e < 8; ++e) RG[e * D + k] = g * I.router[k * 8 + e]; } }
    if (gw == 0) {
        const float a = wave_sum(I.lam_q1[F.lane] * I.lam_k1[F.lane]), b = wave_sum(I.lam_q2[F.lane] * I.lam_k2[F.lane]);
        const float gq = wave_max(fabsf(I.q_norm[F.lane])), gk = wave_max(fabsf(I.k_norm[F.lane]));
        if (F.lane == 0) { float* C = (float*)(ws + WS_CONST); C[0] = __expf(a) - __expf(b) + LAMBDA_INIT; C[1] = -(8.0f * gq * gk * 1.4426950408889634f * 1.03f + 0.5f); }
    }
}

__device__ __forceinline__ void late_weight_items(Frame& F, const Inputs& I, unsigned char* ws, int gw, int NGW) {
    LAS unsigned* scr = (LAS unsigned*)(F.lds + RING_OFF + F.wave * 16384);
    constexpr int I_CI = (D / 64) * (NQKV / 64), I_CO = (D / 64) * (D / 64), I_F2 = (DFF / 64) * (D / 64);
    constexpr int NITEMS = I_F2 + I_CI + I_CO;
    bf16* WAI = (bf16*)(ws + WS_WAI); bf16* WAO = (bf16*)(ws + WS_WAO); bf16* W2 = (bf16*)(ws + WS_W2);
    for (int it = gw; it < NITEMS; it += NGW) {
        int r = it;
        if (r < I_F2) { transpose_item<0>(I.ffn_w2, DFF, D, nullptr, W2, scr, r, F.lane); continue; } r -= I_F2;
        if (r < I_CI) { transpose_item<3>(I.attn_in, D, NQKV, I.norm_mix + D, WAI, scr, r, F.lane); continue; } r -= I_CI;
        transpose_item<0>(I.attn_out, D, D, nullptr, WAO, scr, r, F.lane);
    }
}

struct W8Item { const float* Wp; const float* gain; unsigned char* WT; int N, K, map, k0, n0; };
__device__ __forceinline__ void w8_desc(const Inputs& I, unsigned char* ws, int it, int lane, W8Item& d) {
    constexpr int I_M13 = (D / 64) * (DFE / 64), I_M2 = (DFE / 64) * (D / 64), PER_E = 2 * I_M13 + I_M2;
    const int e = it / PER_E; int r = it - e * PER_E; const float* W;
    if (r < 2 * I_M13) { const bool second = r >= I_M13; r -= second ? I_M13 : 0; W = (second ? I.moe_w3 : I.moe_w1) + (size_t)e * D * DFE; d.N = DFE; d.K = D; d.gain = I.norm_ffn + D; d.WT = ws + WS_WM13 + (size_t)e * 2 * DFE * D; d.map = second ? 2 : 1; }
    else { r -= 2 * I_M13; W = I.moe_w2 + (size_t)e * DFE * D; d.N = D; d.K = DFE; d.gain = nullptr; d.WT = ws + WS_WM2 + (size_t)e * D * DFE; d.map = 0; }
    const int nblk = d.N / 64, pr = r >> 1, kp = pr / nblk, nb = pr - kp * nblk, kb = 2 * kp + (r & 1); d.k0 = 64 * kb; d.n0 = 64 * nb;
    d.Wp = W + (size_t)(d.k0 + 4 * (lane >> 4)) * d.N + d.n0 + (lane & 15) * 4;
}
__device__ __forceinline__ void w8_load(const W8Item& d, f32x4 (&a)[4][4], f32x4 (&gq)[4], int lane) {
    const int kk = lane >> 4;
#pragma unroll
    for (int i = 0; i < 4; ++i) { const f32x4 one = {1.0f, 1.0f, 1.0f, 1.0f}; gq[i] = d.gain ? *(const f32x4*)(d.gain + d.k0 + 16 * i + 4 * kk) : one; }
#pragma unroll
    for (int i = 0; i < 4; ++i)
#pragma unroll
        for (int q = 0; q < 4; ++q) a[i][q] = __builtin_nontemporal_load((const f32x4*)(d.Wp + (size_t)(16 * i + q) * d.N));
}
__device__ __forceinline__ void w8_finish(const W8Item& d, const f32x4 (&a)[4][4], const f32x4 (&gq)[4], LAS unsigned* T, int lane, int half) {
    const int kk = lane >> 4, nn = (lane & 15) * 4;
#pragma unroll
    for (int i = 0; i < 4; ++i) {
        float g[4];
#pragma unroll
        for (int q = 0; q < 4; ++q) g[q] = gq[i][q] * W8_SCALE;
#pragma unroll
        for (int e = 0; e < 4; ++e) { int p = 0; p = __builtin_amdgcn_cvt_pk_fp8_f32(a[i][0][e] * g[0], a[i][1][e] * g[1], p, false); p = __builtin_amdgcn_cvt_pk_fp8_f32(a[i][2][e] * g[2], a[i][3][e] * g[3], p, true);
            T[(nn + e) * 36 + 16 * half + 4 * i + kk] = (unsigned)p; } }
    if (half) {
        LDS_WAIT(); asm volatile("" ::: "memory");
        const int c = lane & 7;
#pragma unroll
        for (int j = 0; j < 8; ++j) { const int n = (lane >> 3) + 8 * j; const v4u o = *(const LAS v4u*)(T + n * 36 + 4 * c);
            const int nb32 = d.n0 + (n & 32); const int drow = (d.map == 0 ? nb32 : (nb32 >> 7) * 256 + (d.map == 2 ? 128 : 0) + (nb32 & 127)) + (n & 31);
            __builtin_nontemporal_store(o, (GAS v4u*)(d.WT + (size_t)drow * d.K + (d.k0 - 64) + 16 * c)); }
        LDS_WAIT(); asm volatile("" ::: "memory");
    }
}
constexpr int W8_NIT = NE * (2 * (D / 64) * (DFE / 64) + (DFE / 64) * (D / 64)), W8_EARLY = 2048;
__device__ __forceinline__ void moe_weight_items(Frame& F, const Inputs& I, unsigned char* ws, int gw, int NGW, int lo, int NIT) {
    LAS unsigned* scr = (LAS unsigned*)(F.lds + RING_OFF + F.wave * 16384);
#define W8_IDX(j) (lo + 2 * (gw + ((j) >> 1) * NGW) + ((j) & 1))
    f32x4 a0[4][4], a1[4][4], g0[4], g1[4]; W8Item d0, d1;
    int j = 0;
    if (W8_IDX(0) >= NIT) return;
    w8_desc(I, ws, W8_IDX(0), F.lane, d0); w8_load(d0, a0, g0, F.lane);
    for (;;) {
        const bool h1 = W8_IDX(j + 1) < NIT;
        if (h1) { w8_desc(I, ws, W8_IDX(j + 1), F.lane, d1); w8_load(d1, a1, g1, F.lane); }
        w8_finish(d0, a0, g0, scr, F.lane, 0);
        if (!h1) break;
        const bool h2 = W8_IDX(j + 2) < NIT;
        if (h2) { w8_desc(I, ws, W8_IDX(j + 2), F.lane, d0); w8_load(d0, a0, g0, F.lane); }
        w8_finish(d1, a1, g1, scr, F.lane, 1);
        if (!h2) break;
        j += 2;
    }
#undef W8_IDX
}
template <bool SHIFT> __device__ __forceinline__ void attn_phase_loop(Frame& F, const Inputs& I, unsigned char* ws, const bf16* R1, bf16* GO, float lam, float negmb, char* lds, bool early_done) {
    bool conv_done = false; int ui = 0;
    for (int u = F.vcu; u < 2 * NH * (SEQ / 128); u += F.G, ++ui) { const int bh = u >> 6, qb = u & 63;
        dattn::attn_unit<SHIFT>(bh >> 3, bh & 7, qb, (const unsigned char*)R1, (const unsigned char*)(R1 + (size_t)M * D), (const unsigned char*)(R1 + (size_t)2 * M * D), GO, lam, negmb, 1.0f - LAMBDA_INIT, I.subln, lds);
        if (!conv_done && ui == (F.vcu & 3)) { moe_weight_items(F, I, ws, F.vcu * NWAVES + F.wave, F.G * NWAVES, early_done ? W8_EARLY : 0, W8_NIT); conv_done = true; __syncthreads(); }
    }
    if (!conv_done) { moe_weight_items(F, I, ws, F.vcu * NWAVES + F.wave, F.G * NWAVES, early_done ? W8_EARLY : 0, W8_NIT); __syncthreads(); }
}

__device__ __forceinline__ void conv_gate_phase(Frame& F, const Inputs& I, unsigned char* ws) {
    const bf16* Bg = (const bf16*)(ws + WS_R1); const bf16* U = Bg + (size_t)M * D; bf16* Gb = (bf16*)(ws + WS_GO);
    const int rsub = F.tid >> 7, ch = (F.tid & 127) * 8;
    f32x4 w[3][2];
#pragma unroll
    for (int j = 0; j < 3; ++j) { w[j][0] = *(const f32x4*)(I.conv_w + j * D + ch); w[j][1] = *(const f32x4*)(I.conv_w + j * D + ch + 4); }
    for (int rb = F.vcu; rb < M / 64; rb += F.G) {
        const int r0 = rb * 64 + rsub * 16;
        float up[8], uc[8], un[8];
#define LOADU(dst, row) do { const v4u uv = *(const v4u*)(U + (size_t)(row) * D + ch); \
        _Pragma("unroll") for (int q = 0; q < 4; ++q) { const unsigned uw_ = uv[q]; dst[2 * q] = __uint_as_float(uw_ << 16); dst[2 * q + 1] = __uint_as_float(uw_ & 0xffff0000u); } } while (0)
        if ((r0 & (SEQ - 1)) == 0) {
#pragma unroll
            for (int q = 0; q < 8; ++q) up[q] = 0.f; } else LOADU(up, r0 - 1);
        LOADU(uc, r0);
        for (int i = 0; i < 16; ++i) {
            const int r = r0 + i;
            if ((r & (SEQ - 1)) == SEQ - 1) {
#pragma unroll
                for (int q = 0; q < 8; ++q) un[q] = 0.f; } else LOADU(un, r + 1);
            const v4u bv = *(const v4u*)(Bg + (size_t)r * D + ch);
            float g[8];
#pragma unroll
            for (int q = 0; q < 8; ++q) { const float cv = w[0][q >> 2][q & 3] * up[q] + w[1][q >> 2][q & 3] * uc[q] + w[2][q >> 2][q & 3] * un[q];
                const unsigned bw = bv[q >> 1]; const float bg = (q & 1) ? __uint_as_float(bw & 0xffff0000u) : __uint_as_float(bw << 16); g[q] = bg * cv; }
            v4u o; o.x = pk2(g[0], g[1]); o.y = pk2(g[2], g[3]); o.z = pk2(g[4], g[5]); o.w = pk2(g[6], g[7]);
            *(v4u*)(Gb + (size_t)r * D + ch) = o;
#pragma unroll
            for (int q = 0; q < 8; ++q) { up[q] = uc[q]; uc[q] = un[q]; }
        }
#undef LOADU
    }
}

__device__ __forceinline__ void router_phase(Frame& F, const bf16* XBs, unsigned char* ws) {
    LAS float* Rt = (LAS float*)(F.lds + RING_OFF);
    LAS int* hist = (LAS int*)(F.lds + RING_OFF + 32768);
    const f32x4* RG = (const f32x4*)(ws + WS_RG);
    for (int i = F.tid; i < 2 * D; i += NWAVES * 64) ((LAS f32x4*)Rt)[i] = RG[i];
    if (F.tid < 8) hist[F.tid] = 0;
    __syncthreads();
    int* TOK_E = (int*)(ws + WS_TOKE); float* TOK_G = (float*)(ws + WS_TOKG); float* TOK_RS = (float*)(ws + WS_TOKRS); int* HIST = (int*)(ws + WS_HIST);
    for (int tb = F.vcu; tb < M / 64; tb += F.G) {
        for (int i4 = 0; i4 < 8; i4 += 4) {
            v4u xa[4], xb_[4];
#pragma unroll
            for (int q = 0; q < 4; ++q) { const v4u* xr = (const v4u*)(XBs + (size_t)(tb * 64 + F.wave * 8 + i4 + q) * D); xa[q] = xr[F.lane]; xb_[q] = xr[64 + F.lane]; }
#pragma unroll
            for (int q = 0; q < 4; ++q) { const int token = tb * 64 + F.wave * 8 + i4 + q;
                float x[16];
#pragma unroll
                for (int j = 0; j < 4; ++j) { x[2 * j] = __uint_as_float(xa[q][j] << 16); x[2 * j + 1] = __uint_as_float(xa[q][j] & 0xffff0000u); x[8 + 2 * j] = __uint_as_float(xb_[q][j] << 16); x[9 + 2 * j] = __uint_as_float(xb_[q][j] & 0xffff0000u); }
                float ss = 0.f;
#pragma unroll
                for (int j = 0; j < 16; ++j) ss += x[j] * x[j];
                float acc[8];
#pragma unroll
                for (int e = 0; e < 8; ++e) { const LAS f32x4* r = (const LAS f32x4*)(Rt + e * D + 8 * F.lane); const f32x4 r0 = r[0], r1 = r[1], r2 = r[128], r3 = r[129];
                    acc[e] = ((x[0] * r0[0] + x[1] * r0[1]) + (x[2] * r0[2] + x[3] * r0[3])) + ((x[4] * r1[0] + x[5] * r1[1]) + (x[6] * r1[2] + x[7] * r1[3]))
                           + (((x[8] * r2[0] + x[9] * r2[1]) + (x[10] * r2[2] + x[11] * r2[3])) + ((x[12] * r3[0] + x[13] * r3[1]) + (x[14] * r3[2] + x[15] * r3[3]))); }
                ss = wave_sum(ss); const float rs = __builtin_amdgcn_rsqf(ss * (1.0f / D) + 1e-6f);
#pragma unroll
                for (int e = 0; e < 8; ++e) acc[e] = wave_sum(acc[e]) * rs;
                int i1 = 0; float v1 = acc[0];
#pragma unroll
                for (int e = 1; e < 8; ++e) if (acc[e] > v1) { v1 = acc[e]; i1 = e; }
                int i2 = -1; float v2 = -3.0e38f;
#pragma unroll
                for (int e = 0; e < 8; ++e) if (e != i1 && acc[e] > v2) { v2 = acc[e]; i2 = e; }
                const float g1 = 1.0f / (1.0f + __expf(v2 - v1)), g2 = 1.0f - g1;
                if (F.lane == 0) { TOK_E[token] = i1 | (i2 << 8); TOK_G[2 * token] = g1; TOK_G[2 * token + 1] = g2; TOK_RS[token] = rs;
                    atomicAdd((int*)&hist[i1], 1); atomicAdd((int*)&hist[i2], 1); }
            }
        }
        __syncthreads();
        if (F.tid < 8) { HIST[tb * 8 + F.tid] = hist[F.tid]; hist[F.tid] = 0; }
        __syncthreads();
    }
}

__device__ __forceinline__ void dispatch_phase(Frame& F, unsigned char* ws) {
    LAS int* pre = (LAS int*)(F.lds + RING_OFF);
    LAS int* tot = pre + 2048; LAS int* off = tot + 8;
    LAS int* lpos = off + 16;
    const int* HIST = (const int*)(ws + WS_HIST); const int* TOK_E = (const int*)(ws + WS_TOKE); const float* TOK_G = (const float*)(ws + WS_TOKG); const float* TOK_RS = (const float*)(ws + WS_TOKRS);
    int* TOK_SLOT = (int*)(ws + WS_TOKSLOT); float* SLOT_RS = (float*)(ws + WS_SLOTRS); float* SLOT_G = (float*)(ws + WS_SLOTG); int* META = (int*)(ws + WS_META);
    const bf16* XB = (const bf16*)(ws + WS_XB); unsigned char* HG = ws + WS_HG;
    {
      const int e = F.wave; int h[4];
#pragma unroll
      for (int k = 0; k < 4; ++k) h[k] = HIST[(4 * F.lane + k) * 8 + e];
      const int T = (h[0] + h[1]) + (h[2] + h[3]); int inc = T;
#pragma unroll
      for (int d = 1; d < 64; d <<= 1) { const int o = __shfl_up(inc, d); if (F.lane >= d) inc += o; }
      int run = inc - T;
#pragma unroll
      for (int k = 0; k < 4; ++k) { pre[(4 * F.lane + k) * 8 + e] = run; run += h[k]; }
      if (F.lane == 63) tot[e] = inc; }
    __syncthreads();
    if (F.tid == 0) { int o = 0; for (int e = 0; e < 8; ++e) { off[e] = o; o += (tot[e] + 255) & ~255; } off[8] = o; }
    __syncthreads();
    if (F.vcu == 0 && F.tid < 160) {
        if (F.tid == 0) META[0] = off[8] >> 8;
        const int t = F.tid; int e = 0;
#pragma unroll
        for (int q = 1; q < 8; ++q) if (t * 256 >= off[q]) e = q;
        META[16 + t] = e;
    }
    for (int tb = F.vcu; tb < M / 64; tb += F.G) {
        if (F.wave == 0) {
            const int token = tb * 64 + F.lane; const int te = TOK_E[token]; const int e1 = te & 255, e2 = te >> 8; const float g1 = TOK_G[2 * token], g2 = TOK_G[2 * token + 1], rs = TOK_RS[token];
#pragma unroll
            for (int e = 0; e < 8; ++e) { const bool has = (e1 == e) || (e2 == e); const unsigned long long mask = __ballot(has);
                const int rank = __popcll(mask & ((1ull << F.lane) - 1ull));
                if (has) { const int which = (e1 == e) ? 0 : 1; const int pos = off[e] + pre[tb * 8 + e] + rank;
                    SLOT_RS[pos] = rs * (1.0f / W8_SCALE); SLOT_G[pos] = (which ? g2 : g1) * (1.0f / (W8_SCALE * H8_SCALE));   TOK_SLOT[2 * token + which] = pos; lpos[2 * F.lane + which] = pos; } }
        }
        __syncthreads();
        for (int p4 = F.wave * 16; p4 < F.wave * 16 + 16; p4 += 4) {
            v4u s0[4], s1[4]; int pos[4];
#pragma unroll
            for (int q = 0; q < 4; ++q) { const int p = p4 + q; const v4u* src = (const v4u*)(XB + (size_t)(tb * 64 + (p >> 1)) * D); pos[q] = lpos[p]; s0[q] = src[2 * F.lane]; s1[q] = src[2 * F.lane + 1]; }
#pragma unroll
            for (int q = 0; q < 4; ++q) { v4u o;
#pragma unroll
                for (int j = 0; j < 2; ++j) { int w0 = 0, w1 = 0;
                    w0 = __builtin_amdgcn_cvt_pk_fp8_f32(__uint_as_float(s0[q][2 * j] << 16), __uint_as_float(s0[q][2 * j] & 0xffff0000u), w0, false); w0 = __builtin_amdgcn_cvt_pk_fp8_f32(__uint_as_float(s0[q][2 * j + 1] << 16), __uint_as_float(s0[q][2 * j + 1] & 0xffff0000u), w0, true);
                    w1 = __builtin_amdgcn_cvt_pk_fp8_f32(__uint_as_float(s1[q][2 * j] << 16), __uint_as_float(s1[q][2 * j] & 0xffff0000u), w1, false); w1 = __builtin_amdgcn_cvt_pk_fp8_f32(__uint_as_float(s1[q][2 * j + 1] << 16), __uint_as_float(s1[q][2 * j + 1] & 0xffff0000u), w1, true);
                    o[j] = (unsigned)w0; o[2 + j] = (unsigned)w1; }
                ((v4u*)(HG + (size_t)pos[q] * D))[F.lane] = o; } }
        __syncthreads();
    }
    if (F.vcu < 8) {
        const int e = F.vcu, p0 = off[e] + tot[e], p1 = off[e + 1];
        for (int p = p0 + F.wave; p < p1; p += NWAVES) { v4u* dst = (v4u*)(HG + (size_t)p * D); const v4u z = {0u, 0u, 0u, 0u}; dst[F.lane] = z;
            if (F.lane == 0) { SLOT_RS[p] = 0.f; SLOT_G[p] = 0.f; } }
    }
}

__device__ __forceinline__ void bf8_to_f(const v4u a, float (&f)[8]) {
#pragma unroll
    for (int j = 0; j < 4; ++j) { f[2 * j] = __uint_as_float(a[j] << 16); f[2 * j + 1] = __uint_as_float(a[j] & 0xffff0000u); }
}
__device__ __forceinline__ void y_row8(const bf16* Y, const bf16* YP, int s, int c8, float (&r)[8]) {
    if (s < MOE_T1 * 256) bf8_to_f(*((const v4u*)(Y + (size_t)s * D) + c8), r);
    else {
#pragma unroll
        for (int j = 0; j < 8; ++j) r[j] = 0.f;
        for (int p = 0; p < MOE_NSPLIT; ++p) { float t[8]; bf8_to_f(*((const v4u*)(YP + ((size_t)p * MOE_LMAX * 256 + (s - MOE_T1 * 256)) * D) + c8), t);
#pragma unroll
            for (int j = 0; j < 8; ++j) r[j] += t[j]; } }
}
__device__ __forceinline__ void combine_phase(Frame& F, float* X, const bf16* XBs, unsigned char* ws) {
    const int gw = F.vcu * NWAVES + F.wave, NGW = F.G * NWAVES;
    const int* TOK_SLOT = (const int*)(ws + WS_TOKSLOT); const bf16* Y = (const bf16*)(ws + WS_Y); const bf16* YP = (const bf16*)(ws + WS_YP);
    for (int m = gw; m < M; m += NGW) {
        const int s0 = TOK_SLOT[2 * m], s1 = TOK_SLOT[2 * m + 1];
#pragma unroll
        for (int hcol = 0; hcol < 2; ++hcol) { const int c8 = F.lane + 64 * hcol;
            float xv[8], a[8], b[8]; bf8_to_f(*((const v4u*)(XBs + (size_t)m * D) + c8), xv); y_row8(Y, YP, s0, c8, a); y_row8(Y, YP, s1, c8, b);
            f32x4 o0, o1;
#pragma unroll
            for (int j = 0; j < 4; ++j) { o0[j] = xv[j] + (a[j] + b[j]); o1[j] = xv[4 + j] + (a[4 + j] + b[4 + j]); }
            f32x4* dst = (f32x4*)(X + (size_t)m * D + 8 * c8); __builtin_nontemporal_store(o0, dst); __builtin_nontemporal_store(o1, dst + 1); }
    }
}

struct Args { Inputs in; float* out; unsigned char* ws; };
__global__ void __launch_bounds__(NWAVES * 64, 2) mk_fwd(Args args) {
    extern __shared__ __attribute__((aligned(16))) unsigned char lds[];
    Frame F;
    F.lds = (LAS unsigned char*)lds;
    F.MISC = (volatile LAS unsigned*)(F.lds + MISC_OFF);
    F.tid = threadIdx.x; F.lane = F.tid & 63; F.wave = __builtin_amdgcn_readfirstlane(F.tid >> 6);
    F.G = gridDim.x; { const int bx = blockIdx.x; F.vcu = (F.G % 8 == 0) ? (bx % 8) * (F.G / 8) + bx / 8 : bx; }
    unsigned char* ws = args.ws; const Inputs& I = args.in;
    F.ctl = (gu32*)(ws + WS_CTL);
    for (int u = F.tid; u < (LDS_BYTES - LDSCTL_OFF) / 4; u += NWAVES * 64) ((LAS unsigned*)(F.lds + LDSCTL_OFF))[u] = 0u;
    __syncthreads();
    XcdBarrier bar = xcd_barrier_post((unsigned*)(F.ctl + CW_BAR), F.MISC + 8);
#define GRID_BAR() xcd_barrier(bar)
    float* X = args.out;
    bf16* XB = (bf16*)(ws + WS_XB); bf16* R1 = (bf16*)(ws + WS_R1); bf16* GO = (bf16*)(ws + WS_GO);
    float* SSQ0 = (float*)(ws + WS_SSQ0); float* SSQP1 = (float*)(ws + WS_SSQP1); float* SSQP2 = (float*)(ws + WS_SSQP2);

    p0_prologue(F, I, ws);
    GRID_BAR();
    { pg8::Gemm g{XB, (const bf16*)(ws + WS_WCI), M, NQKV, D, 0}; pg8::StaticOrder S; S.init(M, NQKV, F.G, (int)blockIdx.x);
      pg8::EpiConvIn E{R1, R1 + (size_t)M * D, SSQ0};
      pg8::gemm_phase<pg8::EpiConvIn, pg8::StaticOrder, true, true>(F.lds + RING_OFF, g, S, E); }
    GRID_BAR();
    conv_gate_phase(F, I, ws);
    GRID_BAR();
    { pg8::Gemm g{GO, (const bf16*)(ws + WS_WCO), M, D, D, 0}; pg8::StaticOrder S; S.init(M, D, F.G, (int)blockIdx.x);
      pg8::EpiResid E{XB, SSQP1};
      pg8::gemm_phase<pg8::EpiResid, pg8::StaticOrder, true, true>(F.lds + RING_OFF, g, S, E); }
    GRID_BAR();
    { pg8::Gemm g{XB, (const bf16*)(ws + WS_W13), M, 2 * DFF, D, 0}; pg8::StaticOrder S; S.init(M, 2 * DFF, F.G, (int)blockIdx.x);
      pg8::EpiSwiGLU<0> E{R1, DFF, SSQP1, 0};
      pg8::gemm_phase<pg8::EpiSwiGLU<0>, pg8::StaticOrder, true, true>(F.lds + RING_OFF, g, S, E);
      const int ntile = (M / 256) * (2 * DFF / 256), nlast = ntile % F.G;
      if (nlast == 0) late_weight_items(F, I, ws, (int)blockIdx.x * NWAVES + F.wave, F.G * NWAVES);
      else if ((int)blockIdx.x >= nlast) { late_weight_items(F, I, ws, ((int)blockIdx.x - nlast) * NWAVES + F.wave, (F.G - nlast) * NWAVES);
        __syncthreads();
        moe_weight_items(F, I, ws, ((int)blockIdx.x - nlast) * NWAVES + F.wave, (F.G - nlast) * NWAVES, 0, W8_EARLY); } }
    GRID_BAR();
    { pg8::Gemm g{R1, (const bf16*)(ws + WS_W2), M, D, DFF, 0}; pg8::StaticOrder S; S.init(M, D, F.G, (int)blockIdx.x);
      pg8::EpiResid E{XB, SSQP2};
      pg8::gemm_phase<pg8::EpiResid, pg8::StaticOrder, true, true>(F.lds + RING_OFF, g, S, E); }
    GRID_BAR();
    { pg8::Gemm g{XB, (const bf16*)(ws + WS_WAI), M, NQKV, D, 0}; pg8::StaticOrder S; S.init(M, NQKV, F.G, (int)blockIdx.x);
      LAS float* gtab = (LAS float*)(F.lds + LDSCTL_OFF + 2048);
      if (F.tid < 128) gtab[F.tid] = F.tid < 64 ? I.q_norm[F.tid] * pg8::QSCALE : I.k_norm[F.tid - 64];
      __syncthreads();
      pg8::EpiQKV E{R1, R1 + (size_t)M * D, R1 + (size_t)2 * M * D, SSQP2, gtab, (const float*)(ws + WS_ROPE)};
      pg8::gemm_phase<pg8::EpiQKV, pg8::StaticOrder, true, true>(F.lds + RING_OFF, g, S, E); }
    GRID_BAR();
    { const float* C = (const float*)(ws + WS_CONST); const float lam = __uint_as_float(__builtin_amdgcn_readfirstlane(__float_as_uint(C[0]))), negmb = __uint_as_float(__builtin_amdgcn_readfirstlane(__float_as_uint(C[1])));
      const bool early_done = ((M / 256) * (2 * DFF / 256)) % F.G != 0;
      if (negmb > -96.0f) attn_phase_loop<false>(F, I, ws, R1, GO, lam, negmb, (char*)lds + RING_OFF, early_done);
      else attn_phase_loop<true>(F, I, ws, R1, GO, lam, negmb, (char*)lds + RING_OFF, early_done); }
    GRID_BAR();
    { pg8::Gemm g{GO, (const bf16*)(ws + WS_WAO), M, D, D, 0}; pg8::StaticOrder S; S.init(M, D, F.G, (int)blockIdx.x);
      pg8::EpiResid E{XB, nullptr};
      pg8::gemm_phase<pg8::EpiResid, pg8::StaticOrder, true, true>(F.lds + RING_OFF, g, S, E); }
    GRID_BAR();
    router_phase(F, XB, ws);
    GRID_BAR();
    dispatch_phase(F, ws);
    GRID_BAR();
    { const int* META = (const int*)(ws + WS_META); LAS int* texp = (LAS int*)(F.lds + TEXP_OFF);
      const int ntiles = META[0];
      if (F.tid < 160) texp[F.tid] = META[16 + F.tid];
      __syncthreads();
      const bf16* HG = (const bf16*)(ws + WS_HG); bf16* HIDM = (bf16*)(ws + WS_HIDM); bf16* Y = (bf16*)(ws + WS_Y);
      const float* SLOT_RS = (const float*)(ws + WS_SLOTRS); const float* SLOT_G = (const float*)(ws + WS_SLOTG);
      { pg8::Gemm g{HG, (const bf16*)(ws + WS_WM13), 0, 0, D / 2, 0}; pg8::MoeOrder S; S.init(ntiles, 2 * DFE / 256, F.G, (int)blockIdx.x, 0, 0, texp);
        pg8::EpiSwiGLU<1, true> E{HIDM, DFE, SLOT_RS, 0, H8_SCALE};
        pg8::gemm_phase<pg8::EpiSwiGLU<1, true>, pg8::MoeOrder, true, true, true>(F.lds + RING_OFF, g, S, E); }
      GRID_BAR();
      { const int nfull = ntiles < MOE_T1 ? ntiles : MOE_T1;
        pg8::Gemm g{HIDM, (const bf16*)(ws + WS_WM2), 0, 0, DFE / 2, 0}; pg8::MoeOrder S; S.init(nfull, D / 256, F.G, (int)blockIdx.x, 0, 0, texp);
        pg8::EpiRowBf16<1> E{Y, D, SLOT_G, 0, 0, 0};
        pg8::gemm_phase<pg8::EpiRowBf16<1>, pg8::MoeOrder, true, true, true>(F.lds + RING_OFF, g, S, E); }
      if (ntiles > MOE_T1) {
        pg8::Gemm g{HIDM, (const bf16*)(ws + WS_WM2), 0, 0, MOE_KS / 2, DFE / 2}; pg8::SplitOrder S; S.init(ntiles - MOE_T1, D / 256, MOE_NSPLIT, MOE_KS / 2, F.G, (int)blockIdx.x, MOE_T1, MOE_T1, texp);
        pg8::EpiRowBf16<1> E{(bf16*)(ws + WS_YP), D, SLOT_G, MOE_KS / 2, (size_t)MOE_LMAX * 256 * D, MOE_T1 * 256};
        pg8::gemm_phase<pg8::EpiRowBf16<1>, pg8::SplitOrder, true, true, true>(F.lds + RING_OFF, g, S, E); }
      GRID_BAR();
    }
    combine_phase(F, X, XB, ws);
}

extern "C" void kernel_launch(void* const* d_in, const int* in_sizes, int n_in, void* d_out, int out_size, void* d_ws, size_t ws_size, hipStream_t stream) {
    static int grid = 0;
    if (grid == 0) {
        if (n_in != 23 || in_sizes[0] != M * D || out_size != M * D || ws_size < WS_END) { fprintf(stderr, "kernel_launch: shape/workspace mismatch: n_in %d in0 %d out %d ws %zu (need %zu)\n", n_in, n_in > 0 ? in_sizes[0] : -1, out_size, ws_size, (size_t)WS_END); grid = -1; return; }
        int dev = 0, cus = 0, per_cu = 0;
        if (hipGetDevice(&dev) != hipSuccess || hipDeviceGetAttribute(&cus, hipDeviceAttributeMultiprocessorCount, dev) != hipSuccess) { grid = -1; return; }
        if (hipFuncSetAttribute((const void*)mk_fwd, hipFuncAttributeMaxDynamicSharedMemorySize, LDS_BYTES) != hipSuccess) { fprintf(stderr, "kernel_launch: hipFuncSetAttribute failed\n"); grid = -1; return; }
        if (hipOccupancyMaxActiveBlocksPerMultiprocessor(&per_cu, (const void*)mk_fwd, NWAVES * 64, LDS_BYTES) != hipSuccess || per_cu < 1) fprintf(stderr, "kernel_launch: occupancy query reports %d\n", per_cu);
        (void)hipGetLastError();
        grid = cus;
    }
    if (grid < 0) return;
    if (hipMemsetAsync((char*)d_ws + WS_CTL, 0, CTL_ZERO_BYTES, stream) != hipSuccess) return;
    Args a{};
    a.in.x = (const float*)d_in[0]; a.in.positions = (const int*)d_in[1]; a.in.norm_mix = (const float*)d_in[2]; a.in.norm_ffn = (const float*)d_in[3];
    a.in.conv_in = (const float*)d_in[4]; a.in.conv_w = (const float*)d_in[5]; a.in.conv_out = (const float*)d_in[6]; a.in.attn_in = (const float*)d_in[7];
    a.in.q_norm = (const float*)d_in[8]; a.in.k_norm = (const float*)d_in[9]; a.in.lam_q1 = (const float*)d_in[10]; a.in.lam_k1 = (const float*)d_in[11];
    a.in.lam_q2 = (const float*)d_in[12]; a.in.lam_k2 = (const float*)d_in[13]; a.in.subln = (const float*)d_in[14]; a.in.attn_out = (const float*)d_in[15];
    a.in.ffn_w1 = (const float*)d_in[16]; a.in.ffn_w3 = (const float*)d_in[17]; a.in.ffn_w2 = (const float*)d_in[18]; a.in.router = (const float*)d_in[19];
    a.in.moe_w1 = (const float*)d_in[20]; a.in.moe_w3 = (const float*)d_in[21]; a.in.moe_w2 = (const float*)d_in[22];
    a.out = (float*)d_out; a.ws = (unsigned char*)d_ws;
    hipLaunchKernelGGL(mk_fwd, dim3(grid), dim3(NWAVES * 64), LDS_BYTES, stream, a);
    const hipError_t le = hipPeekAtLastError();
    if (le != hipSuccess) fprintf(stderr, "kernel_launch: launch failed: %s\n", hipGetErrorName(le));
}
```

```cpp
#include <hip/hip_runtime.h>
#include <hip/hip_bf16.h>
#include <cstdio>
#include <cstdint>
namespace pg8 {
#define PG8_LAS __attribute__((address_space(3)))
typedef unsigned short bf16_t;
typedef short bf16x8 __attribute__((ext_vector_type(8)));
typedef float f32x4 __attribute__((ext_vector_type(4)));
typedef unsigned u32x4 __attribute__((ext_vector_type(4)));
typedef unsigned u32x2 __attribute__((ext_vector_type(2)));
typedef int v8i_t __attribute__((ext_vector_type(8)));
typedef int v4i_t __attribute__((ext_vector_type(4)));
__device__ __forceinline__ v8i_t cat8(bf16x8 a, bf16x8 b) { const v4i_t x = __builtin_bit_cast(v4i_t, a), y = __builtin_bit_cast(v4i_t, b); return (v8i_t){x[0], x[1], x[2], x[3], y[0], y[1], y[2], y[3]}; }
constexpr int BM = 256, BK = 64, HALF = 128, HTB = HALF * BK * 2  , STAGE_BYTES = 8 * HTB, NXCD = 8, WGM = 8;
constexpr float RMS_EPS = 1e-6f;

__host__ __device__ __forceinline__ int lds_byte(int r, int c) { const int st = (r >> 4) * 2 + (c >> 5), rr = r & 15, cc = c & 31, ob = rr * 64 + cc * 2; return st * 1024 + (ob ^ (((ob >> 9) & 1) << 5)); }
__host__ __device__ __forceinline__ void stage_rc(int b, int& R, int& C) { const int st = b / 1024, sb = b % 1024, swz = sb ^ (((sb >> 9) & 1) << 5); R = (st >> 1) * 16 + swz / 64; C = (st & 1) * 32 + (swz % 64) / 2; }
__host__ __device__ __forceinline__ int perm32(int rho) { const int n = rho >> 4, i = rho & 15; return 8 * (i >> 2) + 4 * n + (i & 3); }

struct Unit { int pm, pn, t, j, k0; };
struct Gemm { const bf16_t* A; const bf16_t* Bt; int M, N, K, ld; };

struct StaticOrder {
    int nM, nN, nwg, G, c;
    __host__ __device__ void init(int M, int N, int G_, int c_) { nM = M / BM; nN = N / BM; nwg = nM * nN; G = G_; c = c_; }
    __host__ __device__ bool next(int i, Unit& u) const {
        const long L = (long)i * G + c; if (L >= nwg) return false;
        int wgid = (int)L; { const int q = nwg / NXCD, r = nwg % NXCD, xcd = wgid % NXCD, off = wgid / NXCD; wgid = (xcd < r ? xcd * (q + 1) : r * (q + 1) + (xcd - r) * q) + off; }
        const int nig = WGM * nN, gid = wgid / nig, fm = gid * WGM, gsz = (nM - fm) < WGM ? (nM - fm) : WGM;
        u.pm = fm + ((wgid % nig) % gsz); u.pn = (wgid % nig) / gsz; u.t = u.pm; u.j = u.pn; u.k0 = 0; return true;
    }
    __device__ __forceinline__ void a_ready(const Unit&) const {}
    __device__ __forceinline__ void done(const Unit&) const {}
};
struct MoeOrder {
    StaticOrder so; int t0, nN, a_local; const PG8_LAS int* texp;
    __device__ void init(int ntc, int nN_, int G_, int c_, int t0_, int a_local_, const PG8_LAS int* texp_) { so.init(ntc * BM, nN_ * BM, G_, c_); t0 = t0_; nN = nN_; a_local = a_local_; texp = texp_; }
    __device__ __forceinline__ bool next(int i, Unit& u) const {
        if (!so.next(i, u)) return false;
        const int tl = u.pm; u.t = t0 + tl; u.j = u.pn; u.pm = a_local ? tl : u.t; u.pn = texp[u.t] * nN + u.j; u.k0 = 0; return true;
    }
    __device__ __forceinline__ void a_ready(const Unit&) const {}
    __device__ __forceinline__ void done(const Unit&) const {}
};

struct SplitOrder {
    int n, G, c, nsplit, ks, nN, t_first, a_first; const PG8_LAS int* texp;
    __device__ void init(int ntl, int nN_, int nsplit_, int ks_, int G_, int c_, int t_first_, int a_first_, const PG8_LAS int* texp_) { n = ntl * nN_ * nsplit_; G = G_; c = c_; nsplit = nsplit_; ks = ks_; nN = nN_; t_first = t_first_; a_first = a_first_; texp = texp_; }
    __device__ __forceinline__ bool next(int i, Unit& u) const {
        const int L = i * G + c; if (L >= n) return false;
        const int piece = L % nsplit, rest = L / nsplit, pn = rest % nN, tl = rest / nN;
        u.t = t_first + tl; u.j = pn; u.pm = a_first + tl; u.pn = texp[u.t] * nN + pn; u.k0 = piece * ks; return true;
    }
    __device__ __forceinline__ void a_ready(const Unit&) const {}
    __device__ __forceinline__ void done(const Unit&) const {}
};

__device__ __forceinline__ unsigned cvt_pk_bf16(float lo, float hi) { unsigned r; asm volatile("v_cvt_pk_bf16_f32 %0, %1, %2" : "=v"(r) : "v"(lo), "v"(hi)); return r; }
__device__ __forceinline__ float sum16(const float* p) {
    const f32x4 a = *(const f32x4*)p, b = *(const f32x4*)(p + 4), c = *(const f32x4*)(p + 8), d = *(const f32x4*)(p + 12);
    return (((a[0] + a[1]) + (a[2] + a[3])) + ((b[0] + b[1]) + (b[2] + b[3]))) + (((c[0] + c[1]) + (c[2] + c[3])) + ((d[0] + d[1]) + (d[2] + d[3])));
}
__device__ __forceinline__ float sum16x(const float* p, int fq) {
    const f32x4 a = *(const f32x4*)(p + 4 * fq); float s = (a[0] + a[1]) + (a[2] + a[3]);
    s += __shfl_xor(s, 32); s += __shfl_xor(s, 16); return s;
}
__device__ __forceinline__ float rstd_of(float ssq) { return __builtin_amdgcn_rsqf(ssq * (1.0f / 1024.0f) + RMS_EPS); }

template <int MODE> struct EpiRowBf16 {
    static constexpr bool PERM = true, AFTER_DRAIN = false;
    bf16_t* O; int ldc; const float* rowv; int ks; size_t piece_stride; int row_sub;
    __device__ __forceinline__ void operator()(const f32x4 (&acc)[2][2][4][2], const Unit& u, int wr, int wc, int fr, int fq) const {
        const int r0 = u.t * BM + wr * 64 + fr, col0 = u.j * BM + wc * 32 + 8 * fq;
        bf16_t* Ob = O; int rsub = 0; if (ks) { Ob += (size_t)(u.k0 / ks) * piece_stride; rsub = row_sub; }
        float sv[2][4];
#pragma unroll
        for (int ai = 0; ai < 2; ++ai)
#pragma unroll
            for (int m = 0; m < 4; ++m) sv[ai][m] = rowv[r0 + ai * HALF + m * 16];
        asm volatile("" ::: "memory");
#pragma unroll
        for (int ai = 0; ai < 2; ++ai)
#pragma unroll
            for (int m = 0; m < 4; ++m) { const int row = r0 + ai * HALF + m * 16; float s = sv[ai][m]; if (MODE == 0) s = rstd_of(s);
                bf16_t* rowp = Ob + (size_t)(row - rsub) * ldc + col0;
#pragma unroll
                for (int bj = 0; bj < 2; ++bj) { const f32x4 v0 = acc[ai][bj][m][0] * s, v1 = acc[ai][bj][m][1] * s;
                    u32x4 w; w.x = cvt_pk_bf16(v0[0], v0[1]); w.y = cvt_pk_bf16(v0[2], v0[3]); w.z = cvt_pk_bf16(v1[0], v1[1]); w.w = cvt_pk_bf16(v1[2], v1[3]);
                    *(u32x4*)(rowp + bj * HALF) = w; } }
    }
};
struct EpiResid {
    static constexpr bool PERM = true, AFTER_DRAIN = false;
    bf16_t* xb; float* ssqp; unsigned char* x8;
    __device__ __forceinline__ void operator()(const f32x4 (&acc)[2][2][4][2], const Unit& u, int wr, int wc, int fr, int fq) const {
        const int r0 = u.pm * BM + wr * 64 + fr, col0 = u.pn * BM + wc * 32 + 8 * fq;
#pragma unroll
        for (int ai = 0; ai < 2; ++ai) {
            u32x4 pre[4][2];
#pragma unroll
            for (int m = 0; m < 4; ++m) { const size_t off = (size_t)(r0 + ai * HALF + m * 16) * 1024 + col0;
#pragma unroll
                for (int bj = 0; bj < 2; ++bj) pre[m][bj] = *(const u32x4*)(xb + off + bj * HALF); }
            asm volatile("" ::: "memory");
#pragma unroll
            for (int m = 0; m < 4; ++m) { const int row = r0 + ai * HALF + m * 16; const size_t off = (size_t)row * 1024 + col0; float ss = 0.f;
#pragma unroll
                for (int bj = 0; bj < 2; ++bj) { const u32x4 p = pre[m][bj]; float v[8];
#pragma unroll
                    for (int q = 0; q < 4; ++q) { v[2 * q] = __uint_as_float(p[q] << 16) + acc[ai][bj][m][q >> 1][(2 * q) & 3]; v[2 * q + 1] = __uint_as_float(p[q] & 0xffff0000u) + acc[ai][bj][m][q >> 1][(2 * q + 1) & 3]; }
                    u32x4 w; w.x = cvt_pk_bf16(v[0], v[1]); w.y = cvt_pk_bf16(v[2], v[3]); w.z = cvt_pk_bf16(v[4], v[5]); w.w = cvt_pk_bf16(v[6], v[7]);
                    *(u32x4*)(xb + off + bj * HALF) = w;
                    if (x8) { int p0 = 0, p1 = 0;
                        p0 = __builtin_amdgcn_cvt_pk_fp8_f32(v[0], v[1], p0, false); p0 = __builtin_amdgcn_cvt_pk_fp8_f32(v[2], v[3], p0, true);
                        p1 = __builtin_amdgcn_cvt_pk_fp8_f32(v[4], v[5], p1, false); p1 = __builtin_amdgcn_cvt_pk_fp8_f32(v[6], v[7], p1, true);
                        u32x2 w8; w8.x = (unsigned)p0; w8.y = (unsigned)p1; *(u32x2*)(x8 + off + bj * HALF) = w8; }
#pragma unroll
                    for (int q = 0; q < 8; ++q) ss += v[q] * v[q]; }
                if (ssqp) { ss += __shfl_xor(ss, 16); ss += __shfl_xor(ss, 32); if (fq == 0) ssqp[(size_t)row * 16 + u.pn * 4 + wc] = ss; } }
            asm volatile("" ::: "memory");
        }
    }
};
struct EpiConvIn {
    static constexpr bool PERM = true, AFTER_DRAIN = false;
    bf16_t* Bg; bf16_t* U; const float* ssq;
    __device__ __forceinline__ void operator()(const f32x4 (&acc)[2][2][4][2], const Unit& u, int wr, int wc, int fr, int fq) const {
        const int r0 = u.pm * BM + wr * 64 + fr;
        float sv[2][4];
#pragma unroll
        for (int ai = 0; ai < 2; ++ai)
#pragma unroll
            for (int m = 0; m < 4; ++m) sv[ai][m] = ssq[r0 + ai * HALF + m * 16];
        asm volatile("" ::: "memory");
        if (u.pn < 4) { const int col0 = u.pn * BM + wc * 32 + 8 * fq;
#pragma unroll
            for (int ai = 0; ai < 2; ++ai)
#pragma unroll
                for (int m = 0; m < 4; ++m) { const int row = r0 + ai * HALF + m * 16; const float s = rstd_of(sv[ai][m]);
                    bf16_t* rowp = Bg + (size_t)row * 1024 + col0;
#pragma unroll
                    for (int bj = 0; bj < 2; ++bj) { const f32x4 v0 = acc[ai][bj][m][0] * s, v1 = acc[ai][bj][m][1] * s;
                        u32x4 w; w.x = cvt_pk_bf16(v0[0], v0[1]); w.y = cvt_pk_bf16(v0[2], v0[3]); w.z = cvt_pk_bf16(v1[0], v1[1]); w.w = cvt_pk_bf16(v1[2], v1[3]);
                        *(u32x4*)(rowp + bj * HALF) = w; } }
        } else { const int col0 = (u.pn - 4) * HALF + wc * 32 + 8 * fq;
#pragma unroll
            for (int ai = 0; ai < 2; ++ai)
#pragma unroll
                for (int m = 0; m < 4; ++m) { const int row = r0 + ai * HALF + m * 16; const float s = rstd_of(sv[ai][m]), s2 = s * s;
                    const f32x4 h0 = (acc[ai][0][m][0] * acc[ai][1][m][0]) * s2, h1 = (acc[ai][0][m][1] * acc[ai][1][m][1]) * s2;
                    u32x4 w; w.x = cvt_pk_bf16(h0[0], h0[1]); w.y = cvt_pk_bf16(h0[2], h0[3]); w.z = cvt_pk_bf16(h1[0], h1[1]); w.w = cvt_pk_bf16(h1[2], h1[3]);
                    *(u32x4*)(U + (size_t)row * 1024 + col0) = w; }
        }
    }
};
typedef float f32x2v __attribute__((ext_vector_type(2)));
template <int MODE, bool OUT8 = false> struct EpiSwiGLU {
    static constexpr bool PERM = true, AFTER_DRAIN = false;
    bf16_t* H; int ldh; const float* rowv; int t0; float oscale; float pscale;
    __device__ __forceinline__ void operator()(const f32x4 (&acc)[2][2][4][2], const Unit& u, int wr, int wc, int fr, int fq) const {
        const int rl0 = wr * 64 + fr, col0 = u.j * HALF + wc * 32 + 8 * fq;
        float sv[2][4];
        if constexpr (MODE == 0) { f32x4 pq[2][4];
#pragma unroll
            for (int ai = 0; ai < 2; ++ai)
#pragma unroll
                for (int m = 0; m < 4; ++m) pq[ai][m] = *(const f32x4*)(rowv + (size_t)(u.t * BM + rl0 + ai * HALF + m * 16) * 16 + 4 * fq);
#pragma unroll
            for (int ai = 0; ai < 2; ++ai)
#pragma unroll
                for (int m = 0; m < 4; ++m) { const f32x4 a = pq[ai][m]; float q = (a[0] + a[1]) + (a[2] + a[3]); q += __shfl_xor(q, 32); q += __shfl_xor(q, 16); sv[ai][m] = rstd_of(q) * pscale; }
        } else {
#pragma unroll
            for (int ai = 0; ai < 2; ++ai)
#pragma unroll
                for (int m = 0; m < 4; ++m) sv[ai][m] = rowv[u.t * BM + rl0 + ai * HALF + m * 16];
        }
        asm volatile("" ::: "memory");
#pragma unroll
        for (int ai = 0; ai < 2; ++ai)
#pragma unroll
            for (int m = 0; m < 4; ++m) { const int rl = rl0 + ai * HALF + m * 16;
                const float s = sv[ai][m];
                const float sn = -1.4426950408889634f * s, s2 = OUT8 ? s * s * oscale : s * s;
                const f32x2v sn2 = {sn, sn}, so2 = {s2, s2}, one2 = {1.0f, 1.0f};
                float h[8];
#pragma unroll
                for (int n = 0; n < 2; ++n)
#pragma unroll
                    for (int q = 0; q < 2; ++q) { const f32x4 A = acc[ai][0][m][n], B = acc[ai][1][m][n];
                        const f32x2v a2 = {A[2 * q], A[2 * q + 1]}, b2 = {B[2 * q], B[2 * q + 1]};
                        const f32x2v t2 = a2 * sn2; f32x2v e2; e2.x = __builtin_amdgcn_exp2f(t2.x); e2.y = __builtin_amdgcn_exp2f(t2.y);
                        const f32x2v d2 = e2 + one2; f32x2v r2; r2.x = __builtin_amdgcn_rcpf(d2.x); r2.y = __builtin_amdgcn_rcpf(d2.y);
                        const f32x2v h2 = (a2 * b2) * (r2 * so2); h[n * 4 + 2 * q] = h2.x; h[n * 4 + 2 * q + 1] = h2.y; }
                if constexpr (OUT8) { int p0 = 0, p1 = 0;
                    p0 = __builtin_amdgcn_cvt_pk_fp8_f32(h[0], h[1], p0, false); p0 = __builtin_amdgcn_cvt_pk_fp8_f32(h[2], h[3], p0, true);
                    p1 = __builtin_amdgcn_cvt_pk_fp8_f32(h[4], h[5], p1, false); p1 = __builtin_amdgcn_cvt_pk_fp8_f32(h[6], h[7], p1, true);
                    u32x2 w; w.x = (unsigned)p0; w.y = (unsigned)p1; *(u32x2*)((unsigned char*)H + (size_t)((u.t - t0) * BM + rl) * ldh + col0) = w; }
                else { u32x4 w; w.x = cvt_pk_bf16(h[0], h[1]); w.y = cvt_pk_bf16(h[2], h[3]); w.z = cvt_pk_bf16(h[4], h[5]); w.w = cvt_pk_bf16(h[6], h[7]);
                    *(u32x4*)(H + (size_t)((u.t - t0) * BM + rl) * ldh + col0) = w; } }
    }
};
constexpr float QSCALE = 0.125f * 1.4426950408889634f;
struct EpiQKV {
    static constexpr bool PERM = true, AFTER_DRAIN = false;
    bf16_t* O; bf16_t* KH; bf16_t* VH; const float* ssqp; const PG8_LAS float* gtab; const float* rope;
    __device__ __forceinline__ void operator()(const f32x4 (&acc)[2][2][4][2], const Unit& u, int wr, int wc, int fr, int fq) const {
        const int type = u.pn >> 2;
        const PG8_LAS float* gn = gtab + (type == 0 ? 0 : 64) + 8 * fq;
        const int r0 = u.pm * BM + wr * 64 + fr, col0 = u.pn * BM + 64 * wc + 8 * fq;
        const float sg = fq == 0 ? -1.f : 1.f;
        float rsv[2][4];
        { f32x4 pq[2][4];
#pragma unroll
          for (int ai = 0; ai < 2; ++ai)
#pragma unroll
              for (int m = 0; m < 4; ++m) { const size_t row = (size_t)(r0 + ai * HALF + m * 16); pq[ai][m] = *(const f32x4*)(ssqp + row * 16 + 4 * fq); }
#pragma unroll
          for (int ai = 0; ai < 2; ++ai)
#pragma unroll
              for (int m = 0; m < 4; ++m) { const f32x4 a = pq[ai][m]; float q = (a[0] + a[1]) + (a[2] + a[3]); q += __shfl_xor(q, 32); q += __shfl_xor(q, 16); rsv[ai][m] = rstd_of(q); } }
        asm volatile("" ::: "memory");
        const int lfr = fr;
#pragma unroll
        for (int ai = 0; ai < 2; ++ai) {
            f32x4 rq[4];
            if (type < 2) {
#pragma unroll
                for (int m = 0; m < 4; ++m) rq[m] = *(const f32x4*)(rope + (size_t)(r0 + ai * HALF + m * 16) * 16 + 4 * fq); }
            asm volatile("" ::: "memory");
#pragma unroll
            for (int m = 0; m < 4; ++m) { const int row = r0 + ai * HALF + m * 16; const float rs = rsv[ai][m];
                f32x4 v[2][2];
                if (type < 2) {
                    float ss = 0.f;
#pragma unroll
                    for (int bj = 0; bj < 2; ++bj)
#pragma unroll
                        for (int n = 0; n < 2; ++n) { const f32x4 a = acc[ai][bj][m][n]; ss += (a[0] * a[0] + a[1] * a[1]) + (a[2] * a[2] + a[3] * a[3]); }
                    ss += __shfl_xor(ss, 16); ss += __shfl_xor(ss, 32);
                    const float sc = rs * __builtin_amdgcn_rsqf(ss * (rs * rs * (1.0f / 64.0f)) + RMS_EPS);
#pragma unroll
                    for (int bj = 0; bj < 2; ++bj)
#pragma unroll
                        for (int n = 0; n < 2; ++n) v[bj][n] = acc[ai][bj][m][n] * (*(const PG8_LAS f32x4*)(gn + 32 * bj + 4 * n) * sc);
                    f32x4 p[2];
#pragma unroll
                    for (int n = 0; n < 2; ++n)
#pragma unroll
                        for (int e = 0; e < 4; ++e) p[n][e] = __shfl_xor(v[0][n][e], 16);
                    { const f32x4 mine = rq[m];
#pragma unroll
                      for (int n = 0; n < 2; ++n) { f32x4 c_, s_;
#pragma unroll
                          for (int e = 0; e < 4; ++e) { c_[e] = __shfl(mine[e], 16 * n + lfr); s_[e] = __shfl(mine[e], 32 + 16 * n + lfr); }
                          if (fq < 2) v[0][n] = v[0][n] * c_ + (p[n] * s_) * sg; } }
                } else {
#pragma unroll
                    for (int bj = 0; bj < 2; ++bj)
#pragma unroll
                        for (int n = 0; n < 2; ++n) v[bj][n] = acc[ai][bj][m][n] * rs;
                }
                if (type < 2) {
                    unsigned char* rowp8; if (type == 0) rowp8 = (unsigned char*)O + (size_t)row * 1024 + col0;
                    else { const int hh = 2 * (u.pn & 3) + (wc >> 1), bb = row >> 13, ss_ = row & 8191; rowp8 = (unsigned char*)KH + ((size_t)(bb * 8 + hh) * 8192 + ss_) * 128 + (wc & 1) * 64 + 8 * fq; }
#pragma unroll
                    for (int bj = 0; bj < 2; ++bj) { int p0 = 0, p1 = 0;
                        p0 = __builtin_amdgcn_cvt_pk_fp8_f32(v[bj][0][0], v[bj][0][1], p0, false); p0 = __builtin_amdgcn_cvt_pk_fp8_f32(v[bj][0][2], v[bj][0][3], p0, true);
                        p1 = __builtin_amdgcn_cvt_pk_fp8_f32(v[bj][1][0], v[bj][1][1], p1, false); p1 = __builtin_amdgcn_cvt_pk_fp8_f32(v[bj][1][2], v[bj][1][3], p1, true);
                        u32x2 w; w.x = (unsigned)p0; w.y = (unsigned)p1; *(u32x2*)(rowp8 + 32 * bj) = w; }
                } else {
                    const int hh = 2 * (u.pn & 3) + (wc >> 1), bb = row >> 13, ss_ = row & 8191, tt = ss_ >> 6;
                    const int kk = 16 * (m & 1) + fr, pos = 32 * ((kk >> 2) & 1) + (kk & 3) + 4 * (kk >> 3) + 16 * (m >> 1);
                    unsigned char* tb = (unsigned char*)VH + (((size_t)(bb * 8 + hh) * 128 + tt) * 128 + (wc & 1) * 64 + 8 * fq) * 64 + pos;
#pragma unroll
                    for (int bj = 0; bj < 2; ++bj)
#pragma unroll
                        for (int n = 0; n < 2; ++n) { int pk = 0; pk = __builtin_amdgcn_cvt_pk_fp8_f32(v[bj][n][0], v[bj][n][1], pk, false); pk = __builtin_amdgcn_cvt_pk_fp8_f32(v[bj][n][2], v[bj][n][3], pk, true);
#pragma unroll
                            for (int e = 0; e < 4; ++e) tb[(32 * bj + 4 * n + e) * 64] = (unsigned char)((unsigned)pk >> (8 * e)); }
                } }
        }
    }
};

template <class Epi, class Sched, bool ALIGN_EPI = false, bool SP2 = false, bool F8 = false>
__device__ __forceinline__ void gemm_phase(PG8_LAS unsigned char* lds, const Gemm g, const Sched& S, const Epi& E) {
    int tid = threadIdx.x; asm volatile("" : "+v"(tid));
    const int wid = __builtin_amdgcn_readfirstlane(tid >> 6), lane = tid & 63, wr = wid >> 2, wc = wid & 3, fr = lane & 15, fq = lane >> 4;
    const int K = g.K, nt = K / BK, LD = g.ld ? g.ld : g.K;
    unsigned voffA[2], voffB[2];
#pragma unroll
    for (int i = 0; i < 2; ++i) { int R, C; stage_rc(tid * 16 + i * 8192, R, C); const int Rb = Epi::PERM ? ((R & ~31) + perm32(R & 31)) : R;
        voffA[i] = (unsigned)(R * LD + C) * 2u; voffB[i] = (unsigned)(Rb * LD + C) * 2u; }
    const size_t kstep = (size_t)(BK * 2);
    const size_t hstep = (size_t)HALF * LD * 2;
    const size_t tstep = 2 * hstep;
    const unsigned ldsw = (unsigned)wid * 1024u;
    const int aoff = lds_byte(wr * 64 + fr, fq * 8), boff = lds_byte(wc * 32 + fr, fq * 8);
#define PG8_SA(b, h) (((b) * 2 + (h)) * HTB)
#define PG8_SB(b, h) ((4 + (b) * 2 + (h)) * HTB)
#define PG8_STAGE(bufoff, gbase, voff) do { _Pragma("unroll") for (int _i = 0; _i < 2; ++_i) \
        __builtin_amdgcn_global_load_lds((const unsigned*)((const char*)(gbase) + (voff)[_i]), (PG8_LAS unsigned*)(lds + (bufoff) + ldsw + _i * 8192), 16, 0, 0); } while (0)
#define PG8_LDA(dst, b, h) do { if constexpr (F8) { _Pragma("unroll") for (int m = 0; m < 4; ++m) { const v4i_t x_ = *(const PG8_LAS v4i_t*)(lds + PG8_SA(b, h) + aoff + m * 2048), y_ = *(const PG8_LAS v4i_t*)(lds + PG8_SA(b, h) + aoff + m * 2048 + 1024); \
        dst##8[m] = (v8i_t){x_[0], x_[1], x_[2], x_[3], y_[0], y_[1], y_[2], y_[3]}; } } \
    else { _Pragma("unroll") for (int m = 0; m < 4; ++m) _Pragma("unroll") for (int k = 0; k < 2; ++k) dst[m][k] = *(const PG8_LAS bf16x8*)(lds + PG8_SA(b, h) + aoff + m * 2048 + k * 1024); } } while (0)
#define PG8_LDB(dst, b, h) do { if constexpr (F8) { _Pragma("unroll") for (int n = 0; n < 2; ++n) { const v4i_t x_ = *(const PG8_LAS v4i_t*)(lds + PG8_SB(b, h) + boff + n * 2048), y_ = *(const PG8_LAS v4i_t*)(lds + PG8_SB(b, h) + boff + n * 2048 + 1024); \
        dst##8[n] = (v8i_t){x_[0], x_[1], x_[2], x_[3], y_[0], y_[1], y_[2], y_[3]}; } } \
    else { _Pragma("unroll") for (int n = 0; n < 2; ++n) _Pragma("unroll") for (int k = 0; k < 2; ++k) dst[n][k] = *(const PG8_LAS bf16x8*)(lds + PG8_SB(b, h) + boff + n * 2048 + k * 1024); } } while (0)
#define PG8_MMA(ai, bj, At, Bt) do { if constexpr (F8) __builtin_amdgcn_sched_barrier(0); __builtin_amdgcn_s_setprio(1); \
    if constexpr (F8) { _Pragma("unroll") for (int m = 0; m < 4; ++m) _Pragma("unroll") for (int n = 0; n < 2; ++n) \
        asm volatile("v_mfma_f32_16x16x128_f8f6f4 %0, %1, %2, %0" : "+v"(acc[ai][bj][m][n]) : "v"(Bt##8[n]), "v"(At##8[m])); } \
    else { _Pragma("unroll") for (int m = 0; m < 4; ++m) _Pragma("unroll") for (int n = 0; n < 2; ++n) _Pragma("unroll") for (int k = 0; k < 2; ++k) \
        acc[ai][bj][m][n] = __builtin_amdgcn_mfma_f32_16x16x32_bf16(Bt[n][k], At[m][k], acc[ai][bj][m][n], 0, 0, 0); } \
    __builtin_amdgcn_s_setprio(0); if constexpr (F8) __builtin_amdgcn_sched_barrier(0); } while (0)
#define PG8_WAIT_V(n) asm volatile("s_waitcnt vmcnt(" #n ")" ::: "memory")
#define PG8_WAIT_L(n) asm volatile("s_waitcnt lgkmcnt(" #n ")" ::: "memory")
#define PG8_BAR __builtin_amdgcn_s_barrier()
#define PG8_SCHED __builtin_amdgcn_sched_barrier(0)
    Unit cur, nxt; int ui = 0;
    if (!S.next(0, cur)) return;
    f32x4 acc[2][2][4][2];
#pragma unroll
    for (int a = 0; a < 2; ++a)
#pragma unroll
        for (int b = 0; b < 2; ++b)
#pragma unroll
            for (int m = 0; m < 4; ++m)
#pragma unroll
                for (int n = 0; n < 2; ++n) acc[a][b][m][n] = (f32x4){0.f, 0.f, 0.f, 0.f};
    bf16x8 At[4][2], B0[2][2], B1[2][2]; v8i_t At8[4], B08[2], B18[2];
    const char* cA = (const char*)g.A + (size_t)cur.pm * tstep + (size_t)cur.k0 * 2; const char* cB = (const char*)g.Bt + (size_t)cur.pn * tstep + (size_t)cur.k0 * 2;
    S.a_ready(cur);
    if constexpr (SP2) {
        PG8_STAGE(PG8_SB(0, 0), cB, voffB); PG8_STAGE(PG8_SB(0, 1), cB + hstep, voffB); PG8_STAGE(PG8_SA(0, 0), cA, voffA); PG8_STAGE(PG8_SA(0, 1), cA + hstep, voffA);
        if (wr == 1) PG8_BAR;
        PG8_WAIT_V(2); PG8_BAR;
        PG8_STAGE(PG8_SB(1, 0), cB + kstep, voffB); PG8_STAGE(PG8_SA(1, 0), cA + kstep, voffA); PG8_STAGE(PG8_SB(1, 1), cB + hstep + kstep, voffB);
        PG8_WAIT_V(6); PG8_BAR;
    } else {
        PG8_STAGE(PG8_SB(0, 0), cB, voffB); PG8_STAGE(PG8_SA(0, 0), cA, voffA); PG8_STAGE(PG8_SB(0, 1), cB + hstep, voffB); PG8_STAGE(PG8_SA(0, 1), cA + hstep, voffA);
        if (wr == 1) PG8_BAR;
        PG8_WAIT_V(4); PG8_BAR;
        PG8_STAGE(PG8_SB(1, 0), cB + kstep, voffB); PG8_STAGE(PG8_SA(1, 0), cA + kstep, voffA); PG8_STAGE(PG8_SB(1, 1), cB + hstep + kstep, voffB);
        PG8_WAIT_V(6); PG8_BAR;
    }
    for (;;) {
        const bool has_next = S.next(ui + 1, nxt);
        const char* nA = has_next ? (const char*)g.A + (size_t)nxt.pm * tstep + (size_t)nxt.k0 * 2 : cA; const char* nB = has_next ? (const char*)g.Bt + (size_t)nxt.pn * tstep + (size_t)nxt.k0 * 2 : cB;
#pragma clang loop unroll(disable)
        for (int t = 0; t < nt; t += 2) {
            const bool last = (t == nt - 2);
            const char* a1 = cA + (size_t)(t + 1) * kstep;
            const char* a2 = last ? nA : cA + (size_t)(t + 2) * kstep; const char* b2 = last ? nB : cB + (size_t)(t + 2) * kstep;
            const char* a3 = a2 + kstep; const char* b3 = b2 + kstep;
            if (last && has_next) S.a_ready(nxt);
            if constexpr (SP2) {
            PG8_LDB(B0, 0, 0); PG8_LDB(B1, 0, 1); PG8_SCHED; PG8_LDA(At, 0, 0); PG8_STAGE(PG8_SA(1, 1), a1 + hstep, voffA);
            PG8_WAIT_V(8); PG8_WAIT_L(0); PG8_BAR; PG8_MMA(0, 0, At, B0); PG8_MMA(0, 1, At, B1); PG8_BAR; PG8_SCHED;
            PG8_LDA(At, 0, 1); PG8_STAGE(PG8_SB(0, 0), b2, voffB); PG8_STAGE(PG8_SB(0, 1), b2 + hstep, voffB); PG8_STAGE(PG8_SA(0, 0), a2, voffA);
            PG8_WAIT_V(8); PG8_WAIT_L(0); PG8_BAR; PG8_MMA(1, 0, At, B0); PG8_MMA(1, 1, At, B1); PG8_BAR; PG8_SCHED;
            PG8_LDB(B0, 1, 0); PG8_LDB(B1, 1, 1); PG8_SCHED; PG8_LDA(At, 1, 0); PG8_STAGE(PG8_SA(0, 1), a2 + hstep, voffA);
            PG8_WAIT_V(8); PG8_WAIT_L(0); PG8_BAR; PG8_MMA(0, 0, At, B0); PG8_MMA(0, 1, At, B1); PG8_BAR; PG8_SCHED;
            PG8_LDA(At, 1, 1); PG8_STAGE(PG8_SB(1, 0), b3, voffB); PG8_STAGE(PG8_SB(1, 1), b3 + hstep, voffB); PG8_STAGE(PG8_SA(1, 0), a3, voffA);
            PG8_WAIT_V(8); PG8_WAIT_L(0); PG8_BAR; PG8_MMA(1, 0, At, B0); PG8_MMA(1, 1, At, B1); PG8_BAR; PG8_SCHED;
            } else {
            PG8_LDB(B0, 0, 0); PG8_SCHED; PG8_LDA(At, 0, 0); PG8_STAGE(PG8_SA(1, 1), a1 + hstep, voffA);
            PG8_WAIT_L(8); PG8_BAR; PG8_WAIT_L(0); PG8_MMA(0, 0, At, B0); PG8_BAR; PG8_SCHED;
            PG8_LDB(B1, 0, 1); PG8_STAGE(PG8_SB(0, 0), b2, voffB);
            PG8_BAR; PG8_WAIT_L(0); PG8_MMA(0, 1, At, B1); PG8_BAR;
            PG8_LDA(At, 0, 1); PG8_STAGE(PG8_SA(0, 0), a2, voffA);
            PG8_BAR; PG8_WAIT_L(0); PG8_MMA(1, 0, At, B0); PG8_BAR; PG8_SCHED;
            PG8_STAGE(PG8_SB(0, 1), b2 + hstep, voffB);
            PG8_WAIT_V(6); PG8_BAR; PG8_MMA(1, 1, At, B1); PG8_BAR;
            PG8_LDB(B0, 1, 0); PG8_SCHED; PG8_LDA(At, 1, 0); PG8_STAGE(PG8_SA(0, 1), a2 + hstep, voffA);
            PG8_WAIT_L(8); PG8_BAR; PG8_WAIT_L(0); PG8_MMA(0, 0, At, B0); PG8_BAR; PG8_SCHED;
            PG8_LDB(B1, 1, 1); PG8_STAGE(PG8_SB(1, 0), b3, voffB);
            PG8_BAR; PG8_WAIT_L(0); PG8_MMA(0, 1, At, B1); PG8_BAR;
            PG8_LDA(At, 1, 1); PG8_STAGE(PG8_SA(1, 0), a3, voffA);
            PG8_BAR; PG8_WAIT_L(0); PG8_MMA(1, 0, At, B0); PG8_BAR; PG8_SCHED;
            PG8_STAGE(PG8_SB(1, 1), b3 + hstep, voffB);
            PG8_WAIT_V(6); PG8_BAR; PG8_MMA(1, 1, At, B1); PG8_BAR;
            }
        }
        if constexpr (F8) asm volatile("s_nop 15\n\ts_nop 15" ::: "memory");
        if constexpr (ALIGN_EPI) { if (wr == 0) PG8_BAR; }
        if constexpr (!Epi::AFTER_DRAIN) { E(acc, cur, wr, wc, fr, fq); S.done(cur); }
        if (!has_next) break;
#pragma unroll
        for (int a = 0; a < 2; ++a)
#pragma unroll
            for (int b = 0; b < 2; ++b)
#pragma unroll
                for (int m = 0; m < 4; ++m)
#pragma unroll
                    for (int n = 0; n < 2; ++n) acc[a][b][m][n] = (f32x4){0.f, 0.f, 0.f, 0.f};
        cur = nxt; cA = nA; cB = nB; ++ui;
        if constexpr (ALIGN_EPI) { if (wr == 1) PG8_BAR; }
    }
    PG8_WAIT_V(0);
    if constexpr (!ALIGN_EPI) { if (wr == 0) PG8_BAR; }
    PG8_BAR;
    if constexpr (Epi::AFTER_DRAIN) { E.fused(acc, cur, wr, wc, fr, fq, lds, wid, lane); S.done(cur); }
#undef PG8_SA
#undef PG8_SB
#undef PG8_STAGE
#undef PG8_LDA
#undef PG8_LDB
#undef PG8_MMA
#undef PG8_WAIT_V
#undef PG8_WAIT_L
#undef PG8_BAR
#undef PG8_SCHED
}
}

namespace dattn {
using bf16x8 = __attribute__((ext_vector_type(8))) short;
using s16x4  = __attribute__((ext_vector_type(4))) short;
using f32x16 = __attribute__((ext_vector_type(16))) float;
using u32x4  = __attribute__((ext_vector_type(4))) unsigned;
typedef unsigned short bf16_t;
typedef __attribute__((address_space(3))) const char* lds_cptr;
typedef short v4i16_t __attribute__((ext_vector_type(4)));
typedef int v8i_t __attribute__((ext_vector_type(8)));
typedef int v4i_t __attribute__((ext_vector_type(4)));
constexpr int SEQ = 8192, LDQ = 1024, LDR = 128, KVBLK = 64, NT = SEQ / KVBLK;
constexpr int SLOT_B = 16384, NSLOT = 4, V_IN_SLOT = 8192;
constexpr int OFF_COMB = 0, OFF_STG = 65536, OFF_WS = 131072, ATTN_LDS_BYTES = OFF_WS + 8 * 64 * 4;
#define KSWZ(row, colB) ((row) * 256 + ((colB) ^ (((row) & 7) << 4)))
#define SBAR() __builtin_amdgcn_sched_barrier(0)
__device__ __forceinline__ int crow(int r, int hi) { return (r & 3) + 8 * (r >> 2) + 4 * hi; }
__device__ __forceinline__ unsigned cvtpk(float lo, float hi) { unsigned r; asm volatile("v_cvt_pk_bf16_f32 %0, %1, %2" : "=v"(r) : "v"(lo), "v"(hi)); return r; }
__device__ __forceinline__ void glds16(const void* gsrc, unsigned lds_dst) { unsigned keep;
  asm volatile("s_mov_b32 %0, m0\n\ts_mov_b32 m0, %2\n\ts_nop 0\n\tglobal_load_lds_dwordx4 %1, off\n\ts_mov_b32 m0, %0" : "=&s"(keep) : "v"(gsrc), "s"(lds_dst) : "memory"); }
__device__ __forceinline__ s16x4 vtr(lds_cptr p) { return __builtin_bit_cast(s16x4, __builtin_amdgcn_ds_read_tr16_b64_v4i16((__attribute__((address_space(3))) v4i16_t*)p)); }
__device__ __forceinline__ v8i_t kfrag32(lds_cptr p0, lds_cptr p1) { const v4i_t x_ = *(const __attribute__((address_space(3))) v4i_t*)p0, y_ = *(const __attribute__((address_space(3))) v4i_t*)p1; return (v8i_t){x_[0], x_[1], x_[2], x_[3], y_[0], y_[1], y_[2], y_[3]}; }
__device__ __forceinline__ int v_rd_base(int lane) { return ((lane & 3) << 3) | (((lane >> 2) & 3) << 6) | (((lane >> 4) & 1) << 5) | (((lane >> 5) & 1) << 8); }
constexpr int v_rd_off(int d0, int ks, int half) { return d0 * 512 + ks * 4096 + half * 2048; }
#define WAIT_BAR(N) asm volatile("s_waitcnt vmcnt(" #N ") lgkmcnt(0)\n\ts_barrier" ::: "memory")
#define MF(A, B, C) __builtin_amdgcn_mfma_f32_32x32x16_bf16(A, B, C, 0, 0, 0)
typedef short v2s_t __attribute__((ext_vector_type(2)));
typedef float v4f_t __attribute__((ext_vector_type(4)));
__device__ __forceinline__ void glds_kv(const void* kbase, const void* vbase, unsigned koff, unsigned voff, unsigned lds_k, unsigned lds_v) { unsigned keep;
  asm volatile("s_mov_b32 %0, m0\n\ts_mov_b32 m0, %5\n\ts_nop 0\n\tglobal_load_lds_dwordx4 %1, %3\n\ts_mov_b32 m0, %6\n\ts_nop 0\n\tglobal_load_lds_dwordx4 %2, %4\n\ts_mov_b32 m0, %0"
               : "=&s"(keep) : "v"(koff), "v"(voff), "s"(kbase), "s"(vbase), "s"(lds_k), "s"(lds_v) : "memory"); }
__device__ __forceinline__ int pk4_bf8(float a, float b, float c, float d) { int r;
  asm("v_cvt_scalef32_pk_bf8_f32 %0, %1, %2, %3" : "=v"(r) : "v"(a), "v"(b), "s"(16.0f));
  asm("v_cvt_scalef32_pk_bf8_f32 %0, %1, %2, %3 op_sel:[0,0,0,1]" : "+v"(r) : "v"(c), "v"(d), "s"(16.0f)); return r; }
#define PK8(P, B, W0, W1) do { W0 = pk4_bf8(P[B], P[B + 1], P[B + 2], P[B + 3]); W1 = pk4_bf8(P[B + 4], P[B + 5], P[B + 6], P[B + 7]); } while (0)
__device__ __forceinline__ float fadd_s(float a, float b) { float r; asm("v_add_f32_e32 %0, %1, %2" : "=v"(r) : "v"(a), "v"(b)); return r; }
#define SUM8(P, B) fadd_s(fadd_s(fadd_s(P[B], P[B + 1]), fadd_s(P[B + 2], P[B + 3])), fadd_s(fadd_s(P[B + 4], P[B + 5]), fadd_s(P[B + 6], P[B + 7])))
__device__ __forceinline__ bf16x8 vfrag(lds_cptr vp, int off0, int off1) { const s16x4 l_ = vtr(vp + off0), h_ = vtr(vp + off1); return (bf16x8){l_[0], l_[1], l_[2], l_[3], h_[0], h_[1], h_[2], h_[3]}; }
#define VFRAG(d0, ks) vfrag(vp_, v_rd_off(d0, ks, 0), v_rd_off(d0, ks, 1))

template <bool SHIFT> __device__ __forceinline__ void attn_unit(int b, int h, int qb, const unsigned char* __restrict__ Q8, const unsigned char* __restrict__ KH8, const unsigned char* __restrict__ VT8, bf16_t* __restrict__ O, float lam, float negmb, float osc, const float* __restrict__ subg, char* lds) {
  int tid = threadIdx.x; asm volatile("" : "+v"(tid));
  const int lane = tid & 63, r32 = lane & 31, hi = lane >> 5; const int wid = __builtin_amdgcn_readfirstlane(tid >> 6);
  const int comp = wid >> 2, qs = wid & 3;
  const unsigned lds0 = (unsigned)(uintptr_t)lds; const lds_cptr lds3 = (lds_cptr)lds;
  float* wsf = (float*)(lds + OFF_WS) + wid * 64;
  const long rowbase = (long)b * SEQ; const int q0 = qb * 128;
  const unsigned char* Kh = KH8 + (long)(b * 8 + h) * SEQ * 128; const unsigned char* Vh = VT8 + (long)(b * 8 + h) * SEQ * 128;
  int kso, vso;
  { const int row = 8 * wid + (lane >> 3), ch = (lane & 7) ^ ((row >> 1) & 7); kso = row * 128 + ch * 16; }
  { const int d = 16 * wid + (lane >> 2), ch = (lane & 3) ^ ((d >> 2) & 3); vso = d * 64 + ch * 16; }
  const unsigned ldsw = (unsigned)__builtin_amdgcn_readfirstlane(lds0 + wid * 1024);
#define DMA_TILE(t, slotoff) do { const long tb_ = (long)(t) * (KVBLK * 128); glds_kv(Kh + tb_, Vh + tb_, kso, vso, ldsw + (slotoff), ldsw + (slotoff) + V_IN_SLOT); } while (0)
  v8i_t qf;
  { const v4i_t* Qw = (const v4i_t*)(Q8 + (rowbase + q0 + qs * 32 + r32) * 1024 + h * 128 + comp * 64 + hi * 32); const v4i_t x_ = Qw[0], y_ = Qw[1];
    qf = (v8i_t){x_[0], x_[1], x_[2], x_[3], y_[0], y_[1], y_[2], y_[3]}; }
  asm volatile("" ::: "memory");
  DMA_TILE(0, 0); DMA_TILE(1, SLOT_B); DMA_TILE(2, 2 * SLOT_B);
  const int ob_ = ((lane & 15) == ((lane >> 4) & 1)) ? 0x22222222 : 0; const v4i_t onesB = {ob_, ob_, ob_, ob_};
  v4f_t Lacc = {0.f, 0.f, 0.f, 0.f};
#define MFL(PF) asm volatile("v_mfma_f32_16x16x128_f8f6f4 %0, %1, %2, %0 cbsz:1 blgp:4" : "+v"(Lacc) : "v"(PF), "v"(onesB))
  const int ka0 = r32 * 128 + (((comp * 4 + 2 * hi) ^ ((r32 >> 1) & 7)) << 4), ka1 = r32 * 128 + (((comp * 4 + 2 * hi + 1) ^ ((r32 >> 1) & 7)) << 4);
#define KFRAG(kp, hb) kfrag32((kp) + ka0 + (hb) * 4096, (kp) + ka1 + (hb) * 4096)
#define VFRAG8(vp, d0) kfrag32((vp) + va0_ + (d0) * 2048, (vp) + va1_ + (d0) * 2048)
#define MFPV(OD, PF, VF) asm volatile("v_mfma_f32_32x32x64_f8f6f4 %0, %1, %2, %0 cbsz:1" : "+v"(OD) : "v"(PF), "v"(VF))
#define MFQK(C, KF) asm volatile("v_mfma_f32_32x32x64_f8f6f4 %0, %1, %2, 0" : "=&v"(C) : "v"(KF), "v"(qf))
  const int va0_ = V_IN_SLOT + r32 * 64 + (((2 * hi) ^ ((r32 >> 2) & 3)) << 4), va1_ = V_IN_SLOT + r32 * 64 + (((2 * hi + 1) ^ ((r32 >> 2) & 3)) << 4);
  f32x16 o[4];
#pragma unroll
  for (int d0 = 0; d0 < 4; ++d0) o[d0] = f32x16{};
  f32x16 pA0, pA1, pB0, pB1;
#define EX(v) __builtin_amdgcn_exp2f(SHIFT ? (v) + negmb : (v))
#define PIN(x) asm volatile("" : "+v"(x))
#define STEP(CX0, CX1, PY0, PY1, ks_, vs_) do { \
    const lds_cptr kp_ = lds3 + (ks_); const lds_cptr vp_ = lds3 + (vs_); \
    const v8i_t kf0 = KFRAG(kp_, 0), kf1 = KFRAG(kp_, 1); \
    int w0_, w1_, w2_, w3_, w4_, w5_, w6_, w7_; SBAR(); \
    MFQK(CX0, kf0); \
    PK8(PY0, 0, w0_, w1_); PK8(PY0, 8, w2_, w3_); SBAR(); \
    MFQK(CX1, kf1); \
    v8i_t vf0 = VFRAG8(vp_, 0), vf1 = VFRAG8(vp_, 1); \
    PK8(PY1, 0, w4_, w5_); PK8(PY1, 8, w6_, w7_); \
    const v8i_t pf_ = {w0_, w1_, w2_, w3_, w4_, w5_, w6_, w7_}; SBAR(); \
      \
    asm volatile("s_nop 1" ::: "memory"); \
    MFPV(o[0], pf_, vf0); v8i_t vf2 = VFRAG8(vp_, 2); \
    _Pragma("unroll") for (int r_ = 0; r_ < 8; ++r_) CX0[r_] = EX(CX0[r_]); SBAR(); \
    MFPV(o[1], pf_, vf1); v8i_t vf3 = VFRAG8(vp_, 3); \
    _Pragma("unroll") for (int r_ = 8; r_ < 16; ++r_) CX0[r_] = EX(CX0[r_]); PIN(CX0); SBAR(); \
    MFPV(o[2], pf_, vf2); \
    _Pragma("unroll") for (int r_ = 0; r_ < 8; ++r_) CX1[r_] = EX(CX1[r_]); SBAR(); \
    MFPV(o[3], pf_, vf3); MFL(pf_); \
    _Pragma("unroll") for (int r_ = 8; r_ < 16; ++r_) CX1[r_] = EX(CX1[r_]); PIN(CX1); SBAR(); \
  } while (0)
  if (wid >= 4) __builtin_amdgcn_s_setprio(1);
  WAIT_BAR(4);
  { const lds_cptr kp_ = lds3; const v8i_t kf0 = KFRAG(kp_, 0), kf1 = KFRAG(kp_, 1);
    MFQK(pA0, kf0); MFQK(pA1, kf1);
    asm volatile("s_nop 15\n\ts_nop 15\n\ts_nop 15\n\ts_nop 15" ::: "memory");
#pragma unroll
    for (int r = 0; r < 16; ++r) { pA0[r] = EX(pA0[r]); pA1[r] = EX(pA1[r]); } }
  WAIT_BAR(2);
#define SLOT(t) ((((t)) & 3) * SLOT_B)
  int j = 1;
  for (; j + 6 < NT; j += 4) {
    DMA_TILE(j + 2, SLOT(3));
    STEP(pB0, pB1, pA0, pA1, SLOT(1), SLOT(0)); WAIT_BAR(2);
    DMA_TILE(j + 3, SLOT(0));
    STEP(pA0, pA1, pB0, pB1, SLOT(2), SLOT(1)); WAIT_BAR(2);
    DMA_TILE(j + 4, SLOT(1));
    STEP(pB0, pB1, pA0, pA1, SLOT(3), SLOT(2)); WAIT_BAR(2);
    DMA_TILE(j + 5, SLOT(2));
    STEP(pA0, pA1, pB0, pB1, SLOT(0), SLOT(3)); WAIT_BAR(2);
  }
  DMA_TILE(j + 2, SLOT(3));
  STEP(pB0, pB1, pA0, pA1, SLOT(1), SLOT(0)); WAIT_BAR(2);
  STEP(pA0, pA1, pB0, pB1, SLOT(2), SLOT(1)); WAIT_BAR(0);
  STEP(pB0, pB1, pA0, pA1, SLOT(3), SLOT(2));
  { int w0_, w1_, w2_, w3_, w4_, w5_, w6_, w7_;
    PK8(pB0, 0, w0_, w1_); PK8(pB0, 8, w2_, w3_); PK8(pB1, 0, w4_, w5_); PK8(pB1, 8, w6_, w7_);
    const v8i_t pf_ = {w0_, w1_, w2_, w3_, w4_, w5_, w6_, w7_};
    const lds_cptr vp_ = lds3 + SLOT(3);
    const v8i_t vf0 = VFRAG8(vp_, 0), vf1 = VFRAG8(vp_, 1), vf2 = VFRAG8(vp_, 2), vf3 = VFRAG8(vp_, 3);
    asm volatile("s_nop 1" ::: "memory");
    MFPV(o[0], pf_, vf0); MFPV(o[1], pf_, vf1); MFPV(o[2], pf_, vf2); MFPV(o[3], pf_, vf3); MFL(pf_);
    asm volatile("s_nop 15\n\ts_nop 15\n\ts_nop 15\n\ts_nop 15\n\ts_nop 15\n\ts_nop 15" ::: "memory");
  }
#undef STEP
#undef VFRAG8
#undef MFPV
#undef MFL
#undef PK8
#undef KFRAG
#undef MFQK
#undef SLOT
#undef DMA_TILE
#undef EX
#undef PIN
  __builtin_amdgcn_s_setprio(0);
  if ((lane & 15) < 2) { const float cf_ = (comp == 0 ? 1.0f : -lam);
    const v4f_t c4 = {cf_ * __builtin_amdgcn_rcpf(Lacc[0]), cf_ * __builtin_amdgcn_rcpf(Lacc[1]), cf_ * __builtin_amdgcn_rcpf(Lacc[2]), cf_ * __builtin_amdgcn_rcpf(Lacc[3])};
    *(v4f_t*)(wsf + 16 * (lane & 15) + 4 * (lane >> 4)) = c4; }
  asm volatile("s_waitcnt lgkmcnt(0)" ::: "memory");
  float rli[16];
#pragma unroll
  for (int r = 0; r < 16; ++r) rli[r] = wsf[crow(r, hi)];
#pragma unroll
  for (int d0 = 0; d0 < 4; ++d0)
#pragma unroll
    for (int r = 0; r < 16; ++r) o[d0][r] *= rli[r];
  __syncthreads();
  float* comb = (float*)(lds + OFF_COMB) + qs * 4096 + lane;
  if (comp == 1) {
#pragma unroll
    for (int d0 = 0; d0 < 4; ++d0)
#pragma unroll
      for (int r = 0; r < 16; ++r) comb[(d0 * 16 + r) * 64] = o[d0][r];
  }
  __syncthreads();
  if (comp == 0) {
#pragma unroll
    for (int d0 = 0; d0 < 4; ++d0)
#pragma unroll
      for (int r = 0; r < 16; ++r) o[d0][r] += comb[(d0 * 16 + r) * 64];
    float gcol[4];
#pragma unroll
    for (int d0 = 0; d0 < 4; ++d0) gcol[d0] = subg[d0 * 32 + r32] * osc;
    bf16_t* stg = (bf16_t*)(lds + OFF_STG) + qs * 4096;
#pragma unroll
    for (int r = 0; r < 16; ++r) {
      float ss = (o[0][r] * o[0][r] + o[1][r] * o[1][r]) + (o[2][r] * o[2][r] + o[3][r] * o[3][r]);
      ss += __shfl_xor(ss, 1); ss += __shfl_xor(ss, 2); ss += __shfl_xor(ss, 4); ss += __shfl_xor(ss, 8); ss += __shfl_xor(ss, 16);
      const float rn = __builtin_amdgcn_rsqf(ss * (1.0f / 128.0f) + 1e-6f);
      const int orow = crow(r, hi);
#pragma unroll
      for (int d0 = 0; d0 < 4; ++d0) { const float v = o[d0][r] * rn * gcol[d0]; stg[orow * 128 + d0 * 32 + r32] = (bf16_t)(cvtpk(v, v) & 0xffffu); }
    }
    asm volatile("s_waitcnt lgkmcnt(0)" ::: "memory");
    bf16_t* Ow = O + (rowbase + q0 + qs * 32) * 1024 + h * 128;
#pragma unroll
    for (int i = 0; i < 8; ++i) { const int row = i * 4 + (lane >> 4), ch = lane & 15; const u32x4 v = *(const u32x4*)(stg + row * 128 + ch * 8); *(u32x4*)(Ow + (long)row * 1024 + ch * 8) = v; }
  }
  __syncthreads();
}
#undef KSWZ
#undef SBAR
#undef WAIT_BAR
#undef MF
#undef PK4
#undef SUM8
#undef VFRAG
}

constexpr int NWAVES = 8;
constexpr int BATCH = 2, SEQ = 8192, D = 1024, M = BATCH * SEQ, NQKV = 3072, DFF = 2816, NE = 8, DFE = 3584, NH = 8;
constexpr float LAMBDA_INIT = 0.35550906759096934f;
constexpr size_t MiB = 1u << 20, KiB = 1u << 10;
constexpr size_t WS_CTL = 0, CTL_ZERO_BYTES = 1 * MiB;
constexpr size_t WS_ROPE = 1 * MiB, WS_SSQP1 = 2 * MiB, WS_SSQP2 = 3 * MiB;
constexpr size_t WS_SSQ0 = 4 * MiB, WS_TOKE = WS_SSQ0 + 64 * KiB, WS_TOKG = WS_TOKE + 64 * KiB, WS_TOKRS = WS_TOKG + 128 * KiB, WS_TOKSLOT = WS_TOKRS + 64 * KiB,
                 WS_HIST = WS_TOKSLOT + 128 * KiB, WS_SLOTRS = WS_HIST + 64 * KiB, WS_SLOTG = WS_SLOTRS + 192 * KiB, WS_META = WS_SLOTG + 192 * KiB, WS_CONST = WS_META + 4 * KiB, WS_RG = WS_CONST + 4 * KiB;
static_assert(WS_RG + 32 * KiB <= 5 * MiB, "small tables");
constexpr size_t WS_WM13 = 8 * MiB, WS_WM2 = 64 * MiB, WS_WCI = 92 * MiB, WS_WCO = 98 * MiB, WS_WAI = 100 * MiB, WS_WAO = 106 * MiB, WS_W13 = 108 * MiB, WS_W2 = 119 * MiB;
constexpr size_t WS_XB = 126 * MiB, WS_R1 = 158 * MiB, WS_GO = 254 * MiB;
constexpr size_t WS_X8 = 300 * MiB;
constexpr size_t WS_HG = 158 * MiB, WS_Y = 192 * MiB, WS_HIDM = 260 * MiB, WS_YP = 379 * MiB, WS_END = 407 * MiB;
constexpr int MOE_T1 = 128, MOE_LMAX = 8, MOE_NSPLIT = 7, MOE_KS = 512, MOE_TMAX = 136;
constexpr float W8_SCALE = 64.0f, H8_SCALE = 4.0f;
static_assert(WS_WM13 + (size_t)NE * 2 * DFE * D <= WS_WM2 && WS_WM2 + (size_t)NE * D * DFE <= WS_WCI && WS_W13 + (size_t)2 * DFF * D * 2 <= WS_W2 && WS_W2 + (size_t)D * DFF * 2 <= WS_XB, "weights");
static_assert(WS_XB + (size_t)M * D * 2 <= WS_R1 && WS_R1 + (size_t)M * NQKV * 2 <= WS_GO && WS_HG + (size_t)MOE_TMAX * 256 * D <= WS_Y && WS_Y + (size_t)MOE_TMAX * 256 * D * 2 <= WS_HIDM && WS_HIDM + (size_t)MOE_TMAX * 256 * DFE <= WS_YP
              && WS_YP + (size_t)MOE_NSPLIT * MOE_LMAX * 256 * D * 2 <= WS_END && MOE_NSPLIT * MOE_KS == DFE, "activations");
constexpr int CW_BAR = 4096;
constexpr int RING_OFF = 0, RING_BYTES = 135168;
constexpr int LDSCTL_OFF = RING_BYTES, MISC_OFF = LDSCTL_OFF + 320, TEXP_OFF = LDSCTL_OFF + 1024;
constexpr int LDS_BYTES = 147456;
static_assert(dattn::ATTN_LDS_BYTES <= RING_BYTES, "attention scratch");
#define GAS __attribute__((address_space(1)))
#define LAS __attribute__((address_space(3)))
typedef unsigned short bf16;
typedef unsigned v4u __attribute__((ext_vector_type(4)));
typedef float f32x4 __attribute__((ext_vector_type(4)));
typedef GAS unsigned gu32;
#define LDS_WAIT() asm volatile("s_waitcnt lgkmcnt(0)" ::: "memory")
__device__ __forceinline__ unsigned f2bf(float f) { unsigned u = __builtin_bit_cast(unsigned, f); return (u + 0x7fffu + ((u >> 16) & 1u)) >> 16; }
__device__ __forceinline__ unsigned pk2(float lo, float hi) { return f2bf(lo) | (f2bf(hi) << 16); }
struct Inputs { const float* x; const int* positions; const float *norm_mix, *norm_ffn, *conv_in, *conv_w, *conv_out, *attn_in, *q_norm, *k_norm, *lam_q1, *lam_k1, *lam_q2, *lam_k2, *subln, *attn_out,
                *ffn_w1, *ffn_w3, *ffn_w2, *router, *moe_w1, *moe_w3, *moe_w2; };

#define XB_TMO      128
#define XB_XCNT(j)  (256  + 64 * (j))
#define XB_XSUB(j)  (1280 + 64 * (j))
#define XB_XGEN(j)  (2304 + 64 * (j))
#define XB_TOP      3328
#define XB_TOPGEN   3392
#define XCD_BAR_WORDS 3456
#define XB_SPIN_CAP (1u << 18)

__device__ __forceinline__ unsigned xb_ld(unsigned* p)              { return __hip_atomic_load(p, __ATOMIC_RELAXED, __HIP_MEMORY_SCOPE_AGENT); }
__device__ __forceinline__ unsigned xb_add(unsigned* p, unsigned v) { return __hip_atomic_fetch_add(p, v, __ATOMIC_RELAXED, __HIP_MEMORY_SCOPE_AGENT); }
__device__ __forceinline__ unsigned xb_xcc_id() { return (unsigned)__builtin_amdgcn_s_getreg((3 << 11) | 20) & 0xFu; }
#define XB_SPIN(cond, bar) do { unsigned _sp = 0; while (cond) { __builtin_amdgcn_s_sleep(1); \
    if ((++_sp & 255u) == 0u) { if (xb_ld(&(bar)[XB_TMO])) break; if (_sp > XB_SPIN_CAP) { atomicAdd(&(bar)[XB_TMO], 1u); break; } } } } while (0)

struct XcdBarrier {
    unsigned* bar; unsigned x;
    volatile LAS unsigned* st;
};

__device__ __forceinline__ XcdBarrier xcd_barrier_post(unsigned* bar, volatile LAS unsigned* st) {
    XcdBarrier b; b.bar = bar; b.x = xb_xcc_id(); b.st = st;
    if (threadIdx.x == 0) (void)xb_add(&bar[XB_XCNT(b.x)], 1u);
    return b;
}
__device__ __forceinline__ void xcd_barrier_complete(unsigned* bar, unsigned x, unsigned& nloc, unsigned& nx) {
    const unsigned G = gridDim.x * gridDim.y * gridDim.z;
    unsigned sum, cnt, mine, sp = 0u;
    for (;;) {
        sum = 0u; cnt = 0u; mine = 0u;
#pragma unroll
        for (unsigned j = 0; j < 16; ++j) { const unsigned c = xb_ld(&bar[XB_XCNT(j)]); sum += c; cnt += (c > 0u) ? 1u : 0u; mine = (j == x) ? c : mine; }
        if (sum == G) break;
        __builtin_amdgcn_s_sleep(1);
        if ((++sp & 255u) == 0u) { if (xb_ld(&bar[XB_TMO])) break; if (sp > XB_SPIN_CAP) { atomicAdd(&bar[XB_TMO], 1u); break; } }
    }
    nloc = mine > 0u ? mine : 1u; nx = cnt > 0u ? cnt : 1u;
}

__device__ __forceinline__ void xcd_barrier(const XcdBarrier& b) {
    asm volatile("s_waitcnt vmcnt(0)" ::: "memory");
    __syncthreads();
    if (threadIdx.x == 0) {
        unsigned* bar = b.bar;
        __builtin_amdgcn_s_waitcnt(0);
        unsigned nloc = b.st[0], nx = b.st[1];
        if (nloc == 0u) { xcd_barrier_complete(bar, b.x, nloc, nx); b.st[0] = nloc; b.st[1] = nx; }
        const unsigned old = xb_add(&bar[XB_XSUB(b.x)], 1u);
        const unsigned gen = old / nloc;
        if (old + 1u == (gen + 1u) * nloc) {
            __builtin_amdgcn_fence(__ATOMIC_RELEASE, "agent");
            asm volatile("s_waitcnt vmcnt(0)" ::: "memory");
            const unsigned og = xb_add(&bar[XB_TOP], 1u);
            const unsigned tg = og / nx;
            if (og + 1u == (tg + 1u) * nx) xb_add(&bar[XB_TOPGEN], 1u);
            else XB_SPIN(xb_ld(&bar[XB_TOPGEN]) == tg, bar);
            __builtin_amdgcn_fence(__ATOMIC_ACQUIRE, "agent");
            xb_add(&bar[XB_XGEN(b.x)], 1u);
            asm volatile("s_waitcnt vmcnt(0)" ::: "memory");
        } else {
            XB_SPIN(xb_ld(&bar[XB_XGEN(b.x)]) == gen, bar);
            __builtin_amdgcn_fence(__ATOMIC_ACQUIRE, "agent");
            asm volatile("s_waitcnt vmcnt(0)" ::: "memory");
        }
    }
    __syncthreads();
}

struct Frame {
    LAS unsigned char* lds;
    volatile LAS unsigned* MISC;
    gu32* ctl;
    int tid, lane, wave;
    int vcu, G;
};

__device__ __forceinline__ float wave_sum(float v) {
#pragma unroll
    for (int o = 1; o < 64; o <<= 1) v += __shfl_xor(v, o);
    return v;
}
__device__ __forceinline__ float wave_max(float v) {
#pragma unroll
    for (int o = 1; o < 64; o <<= 1) v = fmaxf(v, __shfl_xor(v, o));
    return v;
}
__device__ __forceinline__ float bf2f(unsigned short h) { return __uint_as_float((unsigned)h << 16); }
template <int MAP> __device__ __forceinline__ int rowmap(int n0) {
    if (MAP == 1) return (n0 >> 7) * 256 + (n0 & 127);
    if (MAP == 2) return (n0 >> 7) * 256 + 128 + (n0 & 127);
    if (MAP == 3) return (n0 & ~255) + ((n0 >> 5) & 1) * 128 + ((n0 >> 6) & 3) * 32;
    if (MAP == 4) { if (n0 < D) return n0; const int c = (n0 - D) & (D - 1); return D + (c >> 7) * 256 + (n0 >= 2 * D ? 128 : 0) + (c & 127); }
    return n0;
}
template <int MAP> __device__ __forceinline__ void transpose_item(const float* W, int K, int N, const float* gain, bf16* WT, LAS unsigned* T, int item, int lane) {
    const int nblk = N / 64, kb = item / nblk, nb = item % nblk, k0 = 64 * kb, n0 = 64 * nb;
    const int kk = lane >> 4, nn = (lane & 15) * 4;
    f32x4 a[8], b[8];
    const float* Wp = W + (size_t)(k0 + 2 * kk) * N + n0 + nn;
    float ga[8], gb[8];
#pragma unroll
    for (int i = 0; i < 8; ++i) { ga[i] = gain ? gain[k0 + 8 * i + 2 * kk] : 1.0f; gb[i] = gain ? gain[k0 + 8 * i + 2 * kk + 1] : 1.0f; }
#pragma unroll
    for (int i = 0; i < 8; ++i) { a[i] = __builtin_nontemporal_load((const f32x4*)(Wp + (size_t)(8 * i) * N)); b[i] = __builtin_nontemporal_load((const f32x4*)(Wp + (size_t)(8 * i + 1) * N)); }
    asm volatile("" ::: "memory");
#pragma unroll
    for (int i = 0; i < 8; ++i) {
        if (gain) { a[i] = a[i] * ga[i]; b[i] = b[i] * gb[i]; }
#pragma unroll
        for (int e = 0; e < 4; ++e) T[(nn + e) * 36 + 4 * i + kk] = pg8::cvt_pk_bf16(a[i][e], b[i][e]); }
    LDS_WAIT(); asm volatile("" ::: "memory");
    const int c = lane & 7;
#pragma unroll
    for (int j = 0; j < 8; ++j) { const int n = (lane >> 3) + 8 * j; const v4u o = *(const LAS v4u*)(T + n * 36 + 4 * c);
        const int drow = rowmap<MAP>(n0 + (n & 32)) + (n & 31);
        *(GAS v4u*)(WT + (size_t)drow * K + k0 + 8 * c) = o; }
    LDS_WAIT(); asm volatile("" ::: "memory");
}

template <int MAP> __device__ __forceinline__ void transpose_item8(const float* W, int K, int N, const float* gain, unsigned char* WT, LAS unsigned* T, int item, int lane) {
    const int nblk = N / 64, kb = item / nblk, nb = item % nblk, k0 = 64 * kb, n0 = 64 * nb;
    const int kk = lane >> 4, nn = (lane & 15) * 4;
    f32x4 a[4][4];
    const float* Wp = W + (size_t)(k0 + 4 * kk) * N + n0 + nn;
#pragma unroll
    for (int i = 0; i < 4; ++i)
#pragma unroll
        for (int q = 0; q < 4; ++q) a[i][q] = __builtin_nontemporal_load((const f32x4*)(Wp + (size_t)(16 * i + q) * N));
    asm volatile("" ::: "memory");
#pragma unroll
    for (int i = 0; i < 4; ++i) { const int r = 16 * i + 4 * kk;
        float g[4];
#pragma unroll
        for (int q = 0; q < 4; ++q) g[q] = (gain ? gain[k0 + r + q] : 1.0f) * W8_SCALE;
#pragma unroll
        for (int e = 0; e < 4; ++e) { int p = 0; p = __builtin_amdgcn_cvt_pk_fp8_f32(a[i][0][e] * g[0], a[i][1][e] * g[1], p, false); p = __builtin_amdgcn_cvt_pk_fp8_f32(a[i][2][e] * g[2], a[i][3][e] * g[3], p, true);
            T[(nn + e) * 20 + 4 * i + kk] = (unsigned)p; } }
    LDS_WAIT(); asm volatile("" ::: "memory");
    const int c = lane & 3;
#pragma unroll
    for (int j = 0; j < 4; ++j) { const int n = (lane >> 2) + 16 * j; const v4u o = *(const LAS v4u*)(T + n * 20 + 4 * c);
        const int drow = rowmap<MAP>(n0 + (n & 32)) + (n & 31);
        __builtin_nontemporal_store(o, (GAS v4u*)(WT + (size_t)drow * K + k0 + 16 * c)); }
    LDS_WAIT(); asm volatile("" ::: "memory");
}

__device__ __constant__ double ROPE_TURNS[8] = {
    0.15915494309189535, 0.03086376340470123, 0.005985185712713705, 0.001160663641240061,
    0.00022507907903927653, 4.364795279280289e-05, 8.464330808241401e-06, 1.6414262627950345e-06 };

__device__ __forceinline__ void p0_prologue(Frame& F, const Inputs& I, unsigned char* ws) {
    LAS unsigned* scr = (LAS unsigned*)(F.lds + RING_OFF + F.wave * 16384);
    const int gw = F.vcu * NWAVES + F.wave, NGW = F.G * NWAVES;
    constexpr int I_CI = (D / 64) * (NQKV / 64), I_CO = (D / 64) * (D / 64), I_F13 = (D / 64) * (DFF / 64), I_F2 = (DFF / 64) * (D / 64);
    constexpr int I_M13 = (D / 64) * (DFE / 64), I_M2 = (DFE / 64) * (D / 64);
    constexpr int NITEMS = I_CI + I_CO + 2 * I_F13;
    bf16* WCI = (bf16*)(ws + WS_WCI); bf16* WCO = (bf16*)(ws + WS_WCO); unsigned char* W13 = ws + WS_W13;
    for (int it = gw; it < NITEMS; it += NGW) {
        int r = it;
        if (r < I_CI) { transpose_item<4>(I.conv_in, D, NQKV, I.norm_mix, WCI, scr, r, F.lane); continue; } r -= I_CI;
        if (r < I_CO) { transpose_item<0>(I.conv_out, D, D, nullptr, WCO, scr, r, F.lane); continue; } r -= I_CO;
        if (r < I_F13) { transpose_item8<1>(I.ffn_w1, D, DFF, I.norm_ffn, W13, scr, r, F.lane); continue; } r -= I_F13;
        transpose_item8<2>(I.ffn_w3, D, DFF, I.norm_ffn, W13, scr, r, F.lane);
    }
    bf16* XB = (bf16*)(ws + WS_XB); float* SSQ0 = (float*)(ws + WS_SSQ0); float* ROPE = (float*)(ws + WS_ROPE);
    for (int m0 = gw; m0 < M; m0 += 2 * NGW) {
        f32x4 v[2][4];
#pragma unroll
        for (int h = 0; h < 2; ++h) { const int m = m0 + h * NGW; if (m < M) { const GAS f32x4* xr = (const GAS f32x4*)(I.x + (size_t)m * D) + F.lane;
#pragma unroll
            for (int j = 0; j < 4; ++j) v[h][j] = __builtin_nontemporal_load(xr + 64 * j); } }
#pragma unroll
        for (int h = 0; h < 2; ++h) { const int m = m0 + h * NGW; if (m < M) { GAS unsigned long long* o8 = (GAS unsigned long long*)(XB + (size_t)m * D) + F.lane;
            float s = 0.f;
#pragma unroll
            for (int j = 0; j < 4; ++j) { const f32x4 w = v[h][j]; s += (w.x * w.x + w.y * w.y) + (w.z * w.z + w.w * w.w);
                o8[64 * j] = (unsigned long long)pk2(w.x, w.y) | ((unsigned long long)pk2(w.z, w.w) << 32); }
            s = wave_sum(s);
            if (F.lane == 0) SSQ0[m] = s;
            if (F.lane < 8) { const double t = (double)I.positions[m] * ROPE_TURNS[F.lane]; const float fr = (float)(t - __builtin_floor(t));
                ROPE[(size_t)m * 16 + F.lane] = __builtin_amdgcn_cosf(fr); ROPE[(size_t)m * 16 + 8 + F.lane] = __builtin_amdgcn_sinf(fr); } } }
    }
    { float* RG = (float*)(ws + WS_RG);
      for (int k = gw * 64 + F.lane; k < D; k += NGW * 64) { const float g = I.norm_ffn[D + k];
#pragma unroll
          for (int e = 0; e < 8; ++e) RG[e * D + k] = g * I.router[k * 8 + e]; } }
    if (gw == 0) {
        const float a = wave_sum(I.lam_q1[F.lane] * I.lam_k1[F.lane]), b = wave_sum(I.lam_q2[F.lane] * I.lam_k2[F.lane]);
        const float gq = wave_max(fabsf(I.q_norm[F.lane])), gk = wave_max(fabsf(I.k_norm[F.lane]));
        if (F.lane == 0) { float* C = (float*)(ws + WS_CONST); C[0] = __expf(a) - __expf(b) + LAMBDA_INIT; C[1] = -(8.0f * gq * gk * 1.4426950408889634f * 1.03f + 0.5f); }
    }
}

__device__ __forceinline__ void late_weight_items(Frame& F, const Inputs& I, unsigned char* ws, int gw, int NGW) {
    LAS unsigned* scr = (LAS unsigned*)(F.lds + RING_OFF + F.wave * 16384);
    constexpr int I_CI = (D / 64) * (NQKV / 64), I_CO = (D / 64) * (D / 64), I_F2 = (DFF / 64) * (D / 64);
    constexpr int NITEMS = I_F2 + I_CI + I_CO;
    bf16* WAI = (bf16*)(ws + WS_WAI); bf16* WAO = (bf16*)(ws + WS_WAO); bf16* W2 = (bf16*)(ws + WS_W2);
    for (int it = gw; it < NITEMS; it += NGW) {
        int r = it;
        if (r < I_F2) { transpose_item<0>(I.ffn_w2, DFF, D, nullptr, W2, scr, r, F.lane); continue; } r -= I_F2;
        if (r < I_CI) { transpose_item<3>(I.attn_in, D, NQKV, I.norm_mix + D, WAI, scr, r, F.lane); continue; } r -= I_CI;
        transpose_item<0>(I.attn_out, D, D, nullptr, WAO, scr, r, F.lane);
    }
}

struct W8Item { const float* Wp; const float* gain; unsigned char* WT; int N, K, map, k0, n0; };
__device__ __forceinline__ void w8_desc(const Inputs& I, unsigned char* ws, int it, int lane, W8Item& d) {
    constexpr int I_M13 = (D / 64) * (DFE / 64), I_M2 = (DFE / 64) * (D / 64), PER_E = 2 * I_M13 + I_M2;
    const int e = it / PER_E; int r = it - e * PER_E; const float* W;
    if (r < 2 * I_M13) { const bool second = r >= I_M13; r -= second ? I_M13 : 0; W = (second ? I.moe_w3 : I.moe_w1) + (size_t)e * D * DFE; d.N = DFE; d.K = D; d.gain = I.norm_ffn + D; d.WT = ws + WS_WM13 + (size_t)e * 2 * DFE * D; d.map = second ? 2 : 1; }
    else { r -= 2 * I_M13; W = I.moe_w2 + (size_t)e * DFE * D; d.N = D; d.K = DFE; d.gain = nullptr; d.WT = ws + WS_WM2 + (size_t)e * D * DFE; d.map = 0; }
    const int nblk = d.N / 64, pr = r >> 1, kp = pr / nblk, nb = pr - kp * nblk, kb = 2 * kp + (r & 1); d.k0 = 64 * kb; d.n0 = 64 * nb;
    d.Wp = W + (size_t)(d.k0 + 4 * (lane >> 4)) * d.N + d.n0 + (lane & 15) * 4;
}
__device__ __forceinline__ void w8_load(const W8Item& d, f32x4 (&a)[4][4], f32x4 (&gq)[4], int lane) {
    const int kk = lane >> 4;
#pragma unroll
    for (int i = 0; i < 4; ++i) { const f32x4 one = {1.0f, 1.0f, 1.0f, 1.0f}; gq[i] = d.gain ? *(const f32x4*)(d.gain + d.k0 + 16 * i + 4 * kk) : one; }
#pragma unroll
    for (int i = 0; i < 4; ++i)
#pragma unroll
        for (int q = 0; q < 4; ++q) a[i][q] = __builtin_nontemporal_load((const f32x4*)(d.Wp + (size_t)(16 * i + q) * d.N));
}
__device__ __forceinline__ void w8_finish(const W8Item& d, const f32x4 (&a)[4][4], const f32x4 (&gq)[4], LAS unsigned* T, int lane, int half) {
    const int kk = lane >> 4, nn = (lane & 15) * 4;
#pragma unroll
    for (int i = 0; i < 4; ++i) {
        float g[4];
#pragma unroll
        for (int q = 0; q < 4; ++q) g[q] = gq[i][q] * W8_SCALE;
#pragma unroll
        for (int e = 0; e < 4; ++e) { int p = 0; p = __builtin_amdgcn_cvt_pk_fp8_f32(a[i][0][e] * g[0], a[i][1][e] * g[1], p, false); p = __builtin_amdgcn_cvt_pk_fp8_f32(a[i][2][e] * g[2], a[i][3][e] * g[3], p, true);
            T[(nn + e) * 36 + 16 * half + 4 * i + kk] = (unsigned)p; } }
    if (half) {
        LDS_WAIT(); asm volatile("" ::: "memory");
        const int c = lane & 7;
#pragma unroll
        for (int j = 0; j < 8; ++j) { const int n = (lane >> 3) + 8 * j; const v4u o = *(const LAS v4u*)(T + n * 36 + 4 * c);
            const int nb32 = d.n0 + (n & 32); const int drow = (d.map == 0 ? nb32 : (nb32 >> 7) * 256 + (d.map == 2 ? 128 : 0) + (nb32 & 127)) + (n & 31);
            __builtin_nontemporal_store(o, (GAS v4u*)(d.WT + (size_t)drow * d.K + (d.k0 - 64) + 16 * c)); }
        LDS_WAIT(); asm volatile("" ::: "memory");
    }
}
constexpr int W8_NIT = NE * (2 * (D / 64) * (DFE / 64) + (DFE / 64) * (D / 64)), W8_EARLY = 2048;
__device__ __forceinline__ void moe_weight_items(Frame& F, const Inputs& I, unsigned char* ws, int gw, int NGW, int lo, int NIT) {
    LAS unsigned* scr = (LAS unsigned*)(F.lds + RING_OFF + F.wave * 16384);
#define W8_IDX(j) (lo + 2 * (gw + ((j) >> 1) * NGW) + ((j) & 1))
    f32x4 a0[4][4], a1[4][4], g0[4], g1[4]; W8Item d0, d1;
    int j = 0;
    if (W8_IDX(0) >= NIT) return;
    w8_desc(I, ws, W8_IDX(0), F.lane, d0); w8_load(d0, a0, g0, F.lane);
    for (;;) {
        const bool h1 = W8_IDX(j + 1) < NIT;
        if (h1) { w8_desc(I, ws, W8_IDX(j + 1), F.lane, d1); w8_load(d1, a1, g1, F.lane); }
        w8_finish(d0, a0, g0, scr, F.lane, 0);
        if (!h1) break;
        const bool h2 = W8_IDX(j + 2) < NIT;
        if (h2) { w8_desc(I, ws, W8_IDX(j + 2), F.lane, d0); w8_load(d0, a0, g0, F.lane); }
        w8_finish(d1, a1, g1, scr, F.lane, 1);
        if (!h2) break;
        j += 2;
    }
#undef W8_IDX
}
template <bool SHIFT> __device__ __forceinline__ void attn_phase_loop(Frame& F, const Inputs& I, unsigned char* ws, const bf16* R1, bf16* GO, float lam, float negmb, char* lds, bool early_done) {
    bool conv_done = false; int ui = 0;
    for (int u = F.vcu; u < 2 * NH * (SEQ / 128); u += F.G, ++ui) { const int bh = u >> 6, qb = u & 63;
        dattn::attn_unit<SHIFT>(bh >> 3, bh & 7, qb, (const unsigned char*)R1, (const unsigned char*)(R1 + (size_t)M * D), (const unsigned char*)(R1 + (size_t)2 * M * D), GO, lam, negmb, 1.0f - LAMBDA_INIT, I.subln, lds);
        if (!conv_done && ui == (F.vcu & 3)) { moe_weight_items(F, I, ws, F.vcu * NWAVES + F.wave, F.G * NWAVES, early_done ? W8_EARLY : 0, W8_NIT); conv_done = true; __syncthreads(); }
    }
    if (!conv_done) { moe_weight_items(F, I, ws, F.vcu * NWAVES + F.wave, F.G * NWAVES, early_done ? W8_EARLY : 0, W8_NIT); __syncthreads(); }
}

__device__ __forceinline__ void conv_gate_phase(Frame& F, const Inputs& I, unsigned char* ws) {
    const bf16* Bg = (const bf16*)(ws + WS_R1); const bf16* U = Bg + (size_t)M * D; bf16* Gb = (bf16*)(ws + WS_GO);
    const int rsub = F.tid >> 7, ch = (F.tid & 127) * 8;
    f32x4 w[3][2];
#pragma unroll
    for (int j = 0; j < 3; ++j) { w[j][0] = *(const f32x4*)(I.conv_w + j * D + ch); w[j][1] = *(const f32x4*)(I.conv_w + j * D + ch + 4); }
    for (int rb = F.vcu; rb < M / 64; rb += F.G) {
        const int r0 = rb * 64 + rsub * 16;
        float up[8], uc[8], un[8];
#define LOADU(dst, row) do { const v4u uv = *(const v4u*)(U + (size_t)(row) * D + ch); \
        _Pragma("unroll") for (int q = 0; q < 4; ++q) { const unsigned uw_ = uv[q]; dst[2 * q] = __uint_as_float(uw_ << 16); dst[2 * q + 1] = __uint_as_float(uw_ & 0xffff0000u); } } while (0)
        if ((r0 & (SEQ - 1)) == 0) {
#pragma unroll
            for (int q = 0; q < 8; ++q) up[q] = 0.f; } else LOADU(up, r0 - 1);
        LOADU(uc, r0);
        for (int i = 0; i < 16; ++i) {
            const int r = r0 + i;
            if ((r & (SEQ - 1)) == SEQ - 1) {
#pragma unroll
                for (int q = 0; q < 8; ++q) un[q] = 0.f; } else LOADU(un, r + 1);
            const v4u bv = *(const v4u*)(Bg + (size_t)r * D + ch);
            float g[8];
#pragma unroll
            for (int q = 0; q < 8; ++q) { const float cv = w[0][q >> 2][q & 3] * up[q] + w[1][q >> 2][q & 3] * uc[q] + w[2][q >> 2][q & 3] * un[q];
                const unsigned bw = bv[q >> 1]; const float bg = (q & 1) ? __uint_as_float(bw & 0xffff0000u) : __uint_as_float(bw << 16); g[q] = bg * cv; }
            v4u o; o.x = pk2(g[0], g[1]); o.y = pk2(g[2], g[3]); o.z = pk2(g[4], g[5]); o.w = pk2(g[6], g[7]);
            *(v4u*)(Gb + (size_t)r * D + ch) = o;
#pragma unroll
            for (int q = 0; q < 8; ++q) { up[q] = uc[q]; uc[q] = un[q]; }
        }
#undef LOADU
    }
}

__device__ __forceinline__ void router_phase(Frame& F, const bf16* XBs, unsigned char* ws) {
    LAS float* Rt = (LAS float*)(F.lds + RING_OFF);
    LAS int* hist = (LAS int*)(F.lds + RING_OFF + 32768);
    const f32x4* RG = (const f32x4*)(ws + WS_RG);
    for (int i = F.tid; i < 2 * D; i += NWAVES * 64) ((LAS f32x4*)Rt)[i] = RG[i];
    if (F.tid < 8) hist[F.tid] = 0;
    __syncthreads();
    int* TOK_E = (int*)(ws + WS_TOKE); float* TOK_G = (float*)(ws + WS_TOKG); float* TOK_RS = (float*)(ws + WS_TOKRS); int* HIST = (int*)(ws + WS_HIST);
    for (int tb = F.vcu; tb < M / 64; tb += F.G) {
        for (int i4 = 0; i4 < 8; i4 += 4) {
            v4u xa[4], xb_[4];
#pragma unroll
            for (int q = 0; q < 4; ++q) { const v4u* xr = (const v4u*)(XBs + (size_t)(tb * 64 + F.wave * 8 + i4 + q) * D); xa[q] = xr[F.lane]; xb_[q] = xr[64 + F.lane]; }
#pragma unroll
            for (int q = 0; q < 4; ++q) { const int token = tb * 64 + F.wave * 8 + i4 + q;
                float x[16];
#pragma unroll
                for (int j = 0; j < 4; ++j) { x[2 * j] = __uint_as_float(xa[q][j] << 16); x[2 * j + 1] = __uint_as_float(xa[q][j] & 0xffff0000u); x[8 + 2 * j] = __uint_as_float(xb_[q][j] << 16); x[9 + 2 * j] = __uint_as_float(xb_[q][j] & 0xffff0000u); }
                float ss = 0.f;
#pragma unroll
                for (int j = 0; j < 16; ++j) ss += x[j] * x[j];
                float acc[8];
#pragma unroll
                for (int e = 0; e < 8; ++e) { const LAS f32x4* r = (const LAS f32x4*)(Rt + e * D + 8 * F.lane); const f32x4 r0 = r[0], r1 = r[1], r2 = r[128], r3 = r[129];
                    acc[e] = ((x[0] * r0[0] + x[1] * r0[1]) + (x[2] * r0[2] + x[3] * r0[3])) + ((x[4] * r1[0] + x[5] * r1[1]) + (x[6] * r1[2] + x[7] * r1[3]))
                           + (((x[8] * r2[0] + x[9] * r2[1]) + (x[10] * r2[2] + x[11] * r2[3])) + ((x[12] * r3[0] + x[13] * r3[1]) + (x[14] * r3[2] + x[15] * r3[3]))); }
                ss = wave_sum(ss); const float rs = __builtin_amdgcn_rsqf(ss * (1.0f / D) + 1e-6f);
#pragma unroll
                for (int e = 0; e < 8; ++e) acc[e] = wave_sum(acc[e]) * rs;
                int i1 = 0; float v1 = acc[0];
#pragma unroll
                for (int e = 1; e < 8; ++e) if (acc[e] > v1) { v1 = acc[e]; i1 = e; }
                int i2 = -1; float v2 = -3.0e38f;
#pragma unroll
                for (int e = 0; e < 8; ++e) if (e != i1 && acc[e] > v2) { v2 = acc[e]; i2 = e; }
                const float g1 = 1.0f / (1.0f + __expf(v2 - v1)), g2 = 1.0f - g1;
                if (F.lane == 0) { TOK_E[token] = i1 | (i2 << 8); TOK_G[2 * token] = g1; TOK_G[2 * token + 1] = g2; TOK_RS[token] = rs;
                    atomicAdd((int*)&hist[i1], 1); atomicAdd((int*)&hist[i2], 1); }
            }
        }
        __syncthreads();
        if (F.tid < 8) { HIST[tb * 8 + F.tid] = hist[F.tid]; hist[F.tid] = 0; }
        __syncthreads();
    }
}

__device__ __forceinline__ void dispatch_phase(Frame& F, unsigned char* ws) {
    LAS int* pre = (LAS int*)(F.lds + RING_OFF);
    LAS int* tot = pre + 2048; LAS int* off = tot + 8;
    LAS int* lpos = off + 16;
    const int* HIST = (const int*)(ws + WS_HIST); const int* TOK_E = (const int*)(ws + WS_TOKE); const float* TOK_G = (const float*)(ws + WS_TOKG); const float* TOK_RS = (const float*)(ws + WS_TOKRS);
    int* TOK_SLOT = (int*)(ws + WS_TOKSLOT); float* SLOT_RS = (float*)(ws + WS_SLOTRS); float* SLOT_G = (float*)(ws + WS_SLOTG); int* META = (int*)(ws + WS_META);
    const bf16* XB = (const bf16*)(ws + WS_XB); unsigned char* HG = ws + WS_HG;
    {
      const int e = F.wave; int h[4];
#pragma unroll
      for (int k = 0; k < 4; ++k) h[k] = HIST[(4 * F.lane + k) * 8 + e];
      const int T = (h[0] + h[1]) + (h[2] + h[3]); int inc = T;
#pragma unroll
      for (int d = 1; d < 64; d <<= 1) { const int o = __shfl_up(inc, d); if (F.lane >= d) inc += o; }
      int run = inc - T;
#pragma unroll
      for (int k = 0; k < 4; ++k) { pre[(4 * F.lane + k) * 8 + e] = run; run += h[k]; }
      if (F.lane == 63) tot[e] = inc; }
    __syncthreads();
    if (F.tid == 0) { int o = 0; for (int e = 0; e < 8; ++e) { off[e] = o; o += (tot[e] + 255) & ~255; } off[8] = o; }
    __syncthreads();
    if (F.vcu == 0 && F.tid < 160) {
        if (F.tid == 0) META[0] = off[8] >> 8;
        const int t = F.tid; int e = 0;
#pragma unroll
        for (int q = 1; q < 8; ++q) if (t * 256 >= off[q]) e = q;
        META[16 + t] = e;
    }
    for (int tb = F.vcu; tb < M / 64; tb += F.G) {
        if (F.wave == 0) {
            const int token = tb * 64 + F.lane; const int te = TOK_E[token]; const int e1 = te & 255, e2 = te >> 8; const float g1 = TOK_G[2 * token], g2 = TOK_G[2 * token + 1], rs = TOK_RS[token];
#pragma unroll
            for (int e = 0; e < 8; ++e) { const bool has = (e1 == e) || (e2 == e); const unsigned long long mask = __ballot(has);
                const int rank = __popcll(mask & ((1ull << F.lane) - 1ull));
                if (has) { const int which = (e1 == e) ? 0 : 1; const int pos = off[e] + pre[tb * 8 + e] + rank;
                    SLOT_RS[pos] = rs * (1.0f / W8_SCALE); SLOT_G[pos] = (which ? g2 : g1) * (1.0f / (W8_SCALE * H8_SCALE));   TOK_SLOT[2 * token + which] = pos; lpos[2 * F.lane + which] = pos; } }
        }
        __syncthreads();
        for (int p4 = F.wave * 16; p4 < F.wave * 16 + 16; p4 += 4) {
            v4u s0[4], s1[4]; int pos[4];
#pragma unroll
            for (int q = 0; q < 4; ++q) { const int p = p4 + q; const v4u* src = (const v4u*)(XB + (size_t)(tb * 64 + (p >> 1)) * D); pos[q] = lpos[p]; s0[q] = src[2 * F.lane]; s1[q] = src[2 * F.lane + 1]; }
#pragma unroll
            for (int q = 0; q < 4; ++q) { v4u o;
#pragma unroll
                for (int j = 0; j < 2; ++j) { int w0 = 0, w1 = 0;
                    w0 = __builtin_amdgcn_cvt_pk_fp8_f32(__uint_as_float(s0[q][2 * j] << 16), __uint_as_float(s0[q][2 * j] & 0xffff0000u), w0, false); w0 = __builtin_amdgcn_cvt_pk_fp8_f32(__uint_as_float(s0[q][2 * j + 1] << 16), __uint_as_float(s0[q][2 * j + 1] & 0xffff0000u), w0, true);
                    w1 = __builtin_amdgcn_cvt_pk_fp8_f32(__uint_as_float(s1[q][2 * j] << 16), __uint_as_float(s1[q][2 * j] & 0xffff0000u), w1, false); w1 = __builtin_amdgcn_cvt_pk_fp8_f32(__uint_as_float(s1[q][2 * j + 1] << 16), __uint_as_float(s1[q][2 * j + 1] & 0xffff0000u), w1, true);
                    o[j] = (unsigned)w0; o[2 + j] = (unsigned)w1; }
                ((v4u*)(HG + (size_t)pos[q] * D))[F.lane] = o; } }
        __syncthreads();
    }
    if (F.vcu < 8) {
        const int e = F.vcu, p0 = off[e] + tot[e], p1 = off[e + 1];
        for (int p = p0 + F.wave; p < p1; p += NWAVES) { v4u* dst = (v4u*)(HG + (size_t)p * D); const v4u z = {0u, 0u, 0u, 0u}; dst[F.lane] = z;
            if (F.lane == 0) { SLOT_RS[p] = 0.f; SLOT_G[p] = 0.f; } }
    }
}

__device__ __forceinline__ void bf8_to_f(const v4u a, float (&f)[8]) {
#pragma unroll
    for (int j = 0; j < 4; ++j) { f[2 * j] = __uint_as_float(a[j] << 16); f[2 * j + 1] = __uint_as_float(a[j] & 0xffff0000u); }
}
__device__ __forceinline__ void y_row8(const bf16* Y, const bf16* YP, int s, int c8, float (&r)[8]) {
    if (s < MOE_T1 * 256) bf8_to_f(*((const v4u*)(Y + (size_t)s * D) + c8), r);
    else {
#pragma unroll
        for (int j = 0; j < 8; ++j) r[j] = 0.f;
        for (int p = 0; p < MOE_NSPLIT; ++p) { float t[8]; bf8_to_f(*((const v4u*)(YP + ((size_t)p * MOE_LMAX * 256 + (s - MOE_T1 * 256)) * D) + c8), t);
#pragma unroll
            for (int j = 0; j < 8; ++j) r[j] += t[j]; } }
}
__device__ __forceinline__ void combine_phase(Frame& F, float* X, const bf16* XBs, unsigned char* ws) {
    const int gw = F.vcu * NWAVES + F.wave, NGW = F.G * NWAVES;
    const int* TOK_SLOT = (const int*)(ws + WS_TOKSLOT); const bf16* Y = (const bf16*)(ws + WS_Y); const bf16* YP = (const bf16*)(ws + WS_YP);
    for (int m = gw; m < M; m += NGW) {
        const int s0 = TOK_SLOT[2 * m], s1 = TOK_SLOT[2 * m + 1];
#pragma unroll
        for (int hcol = 0; hcol < 2; ++hcol) { const int c8 = F.lane + 64 * hcol;
            float xv[8], a[8], b[8]; bf8_to_f(*((const v4u*)(XBs + (size_t)m * D) + c8), xv); y_row8(Y, YP, s0, c8, a); y_row8(Y, YP, s1, c8, b);
            f32x4 o0, o1;
#pragma unroll
            for (int j = 0; j < 4; ++j) { o0[j] = xv[j] + (a[j] + b[j]); o1[j] = xv[4 + j] + (a[4 + j] + b[4 + j]); }
            f32x4* dst = (f32x4*)(X + (size_t)m * D + 8 * c8); __builtin_nontemporal_store(o0, dst); __builtin_nontemporal_store(o1, dst + 1); }
    }
}

struct Args { Inputs in; float* out; unsigned char* ws; };
__global__ void __launch_bounds__(NWAVES * 64, 2) mk_fwd(Args args) {
    extern __shared__ __attribute__((aligned(16))) unsigned char lds[];
    Frame F;
    F.lds = (LAS unsigned char*)lds;
    F.MISC = (volatile LAS unsigned*)(F.lds + MISC_OFF);
    F.tid = threadIdx.x; F.lane = F.tid & 63; F.wave = __builtin_amdgcn_readfirstlane(F.tid >> 6);
    F.G = gridDim.x; { const int bx = blockIdx.x; F.vcu = (F.G % 8 == 0) ? (bx % 8) * (F.G / 8) + bx / 8 : bx; }
    unsigned char* ws = args.ws; const Inputs& I = args.in;
    F.ctl = (gu32*)(ws + WS_CTL);
    for (int u = F.tid; u < (LDS_BYTES - LDSCTL_OFF) / 4; u += NWAVES * 64) ((LAS unsigned*)(F.lds + LDSCTL_OFF))[u] = 0u;
    __syncthreads();
    XcdBarrier bar = xcd_barrier_post((unsigned*)(F.ctl + CW_BAR), F.MISC + 8);
#define GRID_BAR() xcd_barrier(bar)
    float* X = args.out;
    bf16* XB = (bf16*)(ws + WS_XB); bf16* R1 = (bf16*)(ws + WS_R1); bf16* GO = (bf16*)(ws + WS_GO);
    float* SSQ0 = (float*)(ws + WS_SSQ0); float* SSQP1 = (float*)(ws + WS_SSQP1); float* SSQP2 = (float*)(ws + WS_SSQP2);

    p0_prologue(F, I, ws);
    GRID_BAR();
    { pg8::Gemm g{XB, (const bf16*)(ws + WS_WCI), M, NQKV, D, 0}; pg8::StaticOrder S; S.init(M, NQKV, F.G, (int)blockIdx.x);
      pg8::EpiConvIn E{R1, R1 + (size_t)M * D, SSQ0};
      pg8::gemm_phase<pg8::EpiConvIn, pg8::StaticOrder, true, true>(F.lds + RING_OFF, g, S, E); }
    GRID_BAR();
    conv_gate_phase(F, I, ws);
    GRID_BAR();
    { pg8::Gemm g{GO, (const bf16*)(ws + WS_WCO), M, D, D, 0}; pg8::StaticOrder S; S.init(M, D, F.G, (int)blockIdx.x);
      pg8::EpiResid E{XB, SSQP1, ws + WS_X8};
      pg8::gemm_phase<pg8::EpiResid, pg8::StaticOrder, true, true>(F.lds + RING_OFF, g, S, E); }
    GRID_BAR();
    { pg8::Gemm g{(const bf16*)(ws + WS_X8), (const bf16*)(ws + WS_W13), M, 2 * DFF, D / 2, 0}; pg8::StaticOrder S; S.init(M, 2 * DFF, F.G, (int)blockIdx.x);
      pg8::EpiSwiGLU<0> E{R1, DFF, SSQP1, 0, 1.0f, 1.0f / W8_SCALE};
      pg8::gemm_phase<pg8::EpiSwiGLU<0>, pg8::StaticOrder, true, true, true>(F.lds + RING_OFF, g, S, E);
      const int ntile = (M / 256) * (2 * DFF / 256), nlast = ntile % F.G;
      if (nlast == 0) late_weight_items(F, I, ws, (int)blockIdx.x * NWAVES + F.wave, F.G * NWAVES);
      else if ((int)blockIdx.x >= nlast) { late_weight_items(F, I, ws, ((int)blockIdx.x - nlast) * NWAVES + F.wave, (F.G - nlast) * NWAVES);
        __syncthreads();
        moe_weight_items(F, I, ws, ((int)blockIdx.x - nlast) * NWAVES + F.wave, (F.G - nlast) * NWAVES, 0, W8_EARLY); } }
    GRID_BAR();
    { pg8::Gemm g{R1, (const bf16*)(ws + WS_W2), M, D, DFF, 0}; pg8::StaticOrder S; S.init(M, D, F.G, (int)blockIdx.x);
      pg8::EpiResid E{XB, SSQP2, nullptr};
      pg8::gemm_phase<pg8::EpiResid, pg8::StaticOrder, true, true>(F.lds + RING_OFF, g, S, E); }
    GRID_BAR();
    { pg8::Gemm g{XB, (const bf16*)(ws + WS_WAI), M, NQKV, D, 0}; pg8::StaticOrder S; S.init(M, NQKV, F.G, (int)blockIdx.x);
      LAS float* gtab = (LAS float*)(F.lds + LDSCTL_OFF + 2048);
      if (F.tid < 128) gtab[F.tid] = F.tid < 64 ? I.q_norm[F.tid] * pg8::QSCALE : I.k_norm[F.tid - 64];
      __syncthreads();
      pg8::EpiQKV E{R1, R1 + (size_t)M * D, R1 + (size_t)2 * M * D, SSQP2, gtab, (const float*)(ws + WS_ROPE)};
      pg8::gemm_phase<pg8::EpiQKV, pg8::StaticOrder, true, true>(F.lds + RING_OFF, g, S, E); }
    GRID_BAR();
    { const float* C = (const float*)(ws + WS_CONST); const float lam = __uint_as_float(__builtin_amdgcn_readfirstlane(__float_as_uint(C[0]))), negmb = __uint_as_float(__builtin_amdgcn_readfirstlane(__float_as_uint(C[1])));
      const bool early_done = ((M / 256) * (2 * DFF / 256)) % F.G != 0;
      if (negmb > -96.0f) attn_phase_loop<false>(F, I, ws, R1, GO, lam, negmb, (char*)lds + RING_OFF, early_done);
      else attn_phase_loop<true>(F, I, ws, R1, GO, lam, negmb, (char*)lds + RING_OFF, early_done); }
    GRID_BAR();
    { pg8::Gemm g{GO, (const bf16*)(ws + WS_WAO), M, D, D, 0}; pg8::StaticOrder S; S.init(M, D, F.G, (int)blockIdx.x);
      pg8::EpiResid E{XB, nullptr, nullptr};
      pg8::gemm_phase<pg8::EpiResid, pg8::StaticOrder, true, true>(F.lds + RING_OFF, g, S, E); }
    GRID_BAR();
    router_phase(F, XB, ws);
    GRID_BAR();
    dispatch_phase(F, ws);
    GRID_BAR();
    { const int* META = (const int*)(ws + WS_META); LAS int* texp = (LAS int*)(F.lds + TEXP_OFF);
      const int ntiles = META[0];
      if (F.tid < 160) texp[F.tid] = META[16 + F.tid];
      __syncthreads();
      const bf16* HG = (const bf16*)(ws + WS_HG); bf16* HIDM = (bf16*)(ws + WS_HIDM); bf16* Y = (bf16*)(ws + WS_Y);
      const float* SLOT_RS = (const float*)(ws + WS_SLOTRS); const float* SLOT_G = (const float*)(ws + WS_SLOTG);
      { pg8::Gemm g{HG, (const bf16*)(ws + WS_WM13), 0, 0, D / 2, 0}; pg8::MoeOrder S; S.init(ntiles, 2 * DFE / 256, F.G, (int)blockIdx.x, 0, 0, texp);
        pg8::EpiSwiGLU<1, true> E{HIDM, DFE, SLOT_RS, 0, H8_SCALE, 1.0f};
        pg8::gemm_phase<pg8::EpiSwiGLU<1, true>, pg8::MoeOrder, true, true, true>(F.lds + RING_OFF, g, S, E); }
      GRID_BAR();
      { const int nfull = ntiles < MOE_T1 ? ntiles : MOE_T1;
        pg8::Gemm g{HIDM, (const bf16*)(ws + WS_WM2), 0, 0, DFE / 2, 0}; pg8::MoeOrder S; S.init(nfull, D / 256, F.G, (int)blockIdx.x, 0, 0, texp);
        pg8::EpiRowBf16<1> E{Y, D, SLOT_G, 0, 0, 0};
        pg8::gemm_phase<pg8::EpiRowBf16<1>, pg8::MoeOrder, true, true, true>(F.lds + RING_OFF, g, S, E); }
      if (ntiles > MOE_T1) {
        pg8::Gemm g{HIDM, (const bf16*)(ws + WS_WM2), 0, 0, MOE_KS / 2, DFE / 2}; pg8::SplitOrder S; S.init(ntiles - MOE_T1, D / 256, MOE_NSPLIT, MOE_KS / 2, F.G, (int)blockIdx.x, MOE_T1, MOE_T1, texp);
        pg8::EpiRowBf16<1> E{(bf16*)(ws + WS_YP), D, SLOT_G, MOE_KS / 2, (size_t)MOE_LMAX * 256 * D, MOE_T1 * 256};
        pg8::gemm_phase<pg8::EpiRowBf16<1>, pg8::SplitOrder, true, true, true>(F.lds + RING_OFF, g, S, E); }
      GRID_BAR();
    }
    combine_phase(F, X, XB, ws);
}

extern "C" void kernel_launch(void* const* d_in, const int* in_sizes, int n_in, void* d_out, int out_size, void* d_ws, size_t ws_size, hipStream_t stream) {
    static int grid = 0;
    if (grid == 0) {
        if (n_in != 23 || in_sizes[0] != M * D || out_size != M * D || ws_size < WS_END) { fprintf(stderr, "kernel_launch: shape/workspace mismatch: n_in %d in0 %d out %d ws %zu (need %zu)\n", n_in, n_in > 0 ? in_sizes[0] : -1, out_size, ws_size, (size_t)WS_END); grid = -1; return; }
        int dev = 0, cus = 0, per_cu = 0;
        if (hipGetDevice(&dev) != hipSuccess || hipDeviceGetAttribute(&cus, hipDeviceAttributeMultiprocessorCount, dev) != hipSuccess) { grid = -1; return; }
        if (hipFuncSetAttribute((const void*)mk_fwd, hipFuncAttributeMaxDynamicSharedMemorySize, LDS_BYTES) != hipSuccess) { fprintf(stderr, "kernel_launch: hipFuncSetAttribute failed\n"); grid = -1; return; }
        if (hipOccupancyMaxActiveBlocksPerMultiprocessor(&per_cu, (const void*)mk_fwd, NWAVES * 64, LDS_BYTES) != hipSuccess || per_cu < 1) fprintf(stderr, "kernel_launch: occupancy query reports %d\n", per_cu);
        (void)hipGetLastError();
        grid = cus;
    }
    if (grid < 0) return;
    if (hipMemsetAsync((char*)d_ws + WS_CTL, 0, CTL_ZERO_BYTES, stream) != hipSuccess) return;
    Args a{};
    a.in.x = (const float*)d_in[0]; a.in.positions = (const int*)d_in[1]; a.in.norm_mix = (const float*)d_in[2]; a.in.norm_ffn = (const float*)d_in[3];
    a.in.conv_in = (const float*)d_in[4]; a.in.conv_w = (const float*)d_in[5]; a.in.conv_out = (const float*)d_in[6]; a.in.attn_in = (const float*)d_in[7];
    a.in.q_norm = (const float*)d_in[8]; a.in.k_norm = (const float*)d_in[9]; a.in.lam_q1 = (const float*)d_in[10]; a.in.lam_k1 = (const float*)d_in[11];
    a.in.lam_q2 = (const float*)d_in[12]; a.in.lam_k2 = (const float*)d_in[13]; a.in.subln = (const float*)d_in[14]; a.in.attn_out = (const float*)d_in[15];
    a.in.ffn_w1 = (const float*)d_in[16]; a.in.ffn_w3 = (const float*)d_in[17]; a.in.ffn_w2 = (const float*)d_in[18]; a.in.router = (const float*)d_in[19];
    a.in.moe_w1 = (const float*)d_in[20]; a.in.moe_w3 = (const float*)d_in[21]; a.in.moe_w2 = (const float*)d_in[22];
    a.out = (float*)d_out; a.ws = (unsigned char*)d_ws;
    hipLaunchKernelGGL(mk_fwd, dim3(grid), dim3(NWAVES * 64), LDS_BYTES, stream, a);
    const hipError_t le = hipPeekAtLastError();
    if (le != hipSuccess) fprintf(stderr, "kernel_launch: launch failed: %s\n", hipGetErrorName(le));
}
```

```cpp
#include <hip/hip_runtime.h>
#include <hip/hip_bf16.h>
#include <cstdio>
#include <cstdint>
namespace pg8 {
#define PG8_LAS __attribute__((address_space(3)))
typedef unsigned short bf16_t;
typedef short bf16x8 __attribute__((ext_vector_type(8)));
typedef float f32x4 __attribute__((ext_vector_type(4)));
typedef unsigned u32x4 __attribute__((ext_vector_type(4)));
typedef unsigned u32x2 __attribute__((ext_vector_type(2)));
typedef int v8i_t __attribute__((ext_vector_type(8)));
typedef int v4i_t __attribute__((ext_vector_type(4)));
__device__ __forceinline__ v8i_t cat8(bf16x8 a, bf16x8 b) { const v4i_t x = __builtin_bit_cast(v4i_t, a), y = __builtin_bit_cast(v4i_t, b); return (v8i_t){x[0], x[1], x[2], x[3], y[0], y[1], y[2], y[3]}; }
constexpr int BM = 256, BK = 64, HALF = 128, HTB = HALF * BK * 2  , STAGE_BYTES = 8 * HTB, NXCD = 8, WGM = 8;
constexpr float RMS_EPS = 1e-6f;

__host__ __device__ __forceinline__ int lds_byte(int r, int c) { const int st = (r >> 4) * 2 + (c >> 5), rr = r & 15, cc = c & 31, ob = rr * 64 + cc * 2; return st * 1024 + (ob ^ (((ob >> 9) & 1) << 5)); }
__host__ __device__ __forceinline__ void stage_rc(int b, int& R, int& C) { const int st = b / 1024, sb = b % 1024, swz = sb ^ (((sb >> 9) & 1) << 5); R = (st >> 1) * 16 + swz / 64; C = (st & 1) * 32 + (swz % 64) / 2; }
__host__ __device__ __forceinline__ int perm32(int rho) { const int n = rho >> 4, i = rho & 15; return 8 * (i >> 2) + 4 * n + (i & 3); }

struct Unit { int pm, pn, t, j, k0; };
struct Gemm { const bf16_t* A; const bf16_t* Bt; int M, N, K, ld; };

struct StaticOrder {
    int nM, nN, nwg, G, c;
    __host__ __device__ void init(int M, int N, int G_, int c_) { nM = M / BM; nN = N / BM; nwg = nM * nN; G = G_; c = c_; }
    __host__ __device__ bool next(int i, Unit& u) const {
        const long L = (long)i * G + c; if (L >= nwg) return false;
        int wgid = (int)L; { const int q = nwg / NXCD, r = nwg % NXCD, xcd = wgid % NXCD, off = wgid / NXCD; wgid = (xcd < r ? xcd * (q + 1) : r * (q + 1) + (xcd - r) * q) + off; }
        const int nig = WGM * nN, gid = wgid / nig, fm = gid * WGM, gsz = (nM - fm) < WGM ? (nM - fm) : WGM;
        u.pm = fm + ((wgid % nig) % gsz); u.pn = (wgid % nig) / gsz; u.t = u.pm; u.j = u.pn; u.k0 = 0; return true;
    }
    __device__ __forceinline__ void a_ready(const Unit&) const {}
    __device__ __forceinline__ void done(const Unit&) const {}
};
struct MoeOrder {
    StaticOrder so; int t0, nN, a_local; const PG8_LAS int* texp;
    __device__ void init(int ntc, int nN_, int G_, int c_, int t0_, int a_local_, const PG8_LAS int* texp_) { so.init(ntc * BM, nN_ * BM, G_, c_); t0 = t0_; nN = nN_; a_local = a_local_; texp = texp_; }
    __device__ __forceinline__ bool next(int i, Unit& u) const {
        if (!so.next(i, u)) return false;
        const int tl = u.pm; u.t = t0 + tl; u.j = u.pn; u.pm = a_local ? tl : u.t; u.pn = texp[u.t] * nN + u.j; u.k0 = 0; return true;
    }
    __device__ __forceinline__ void a_ready(const Unit&) const {}
    __device__ __forceinline__ void done(const Unit&) const {}
};

struct SplitOrder {
    int n, G, c, nsplit, ks, nN, t_first, a_first; const PG8_LAS int* texp;
    __device__ void init(int ntl, int nN_, int nsplit_, int ks_, int G_, int c_, int t_first_, int a_first_, const PG8_LAS int* texp_) { n = ntl * nN_ * nsplit_; G = G_; c = c_; nsplit = nsplit_; ks = ks_; nN = nN_; t_first = t_first_; a_first = a_first_; texp = texp_; }
    __device__ __forceinline__ bool next(int i, Unit& u) const {
        const int L = i * G + c; if (L >= n) return false;
        const int piece = L % nsplit, rest = L / nsplit, pn = rest % nN, tl = rest / nN;
        u.t = t_first + tl; u.j = pn; u.pm = a_first + tl; u.pn = texp[u.t] * nN + pn; u.k0 = piece * ks; return true;
    }
    __device__ __forceinline__ void a_ready(const Unit&) const {}
    __device__ __forceinline__ void done(const Unit&) const {}
};

__device__ __forceinline__ unsigned cvt_pk_bf16(float lo, float hi) { unsigned r; asm volatile("v_cvt_pk_bf16_f32 %0, %1, %2" : "=v"(r) : "v"(lo), "v"(hi)); return r; }
__device__ __forceinline__ float sum16(const float* p) {
    const f32x4 a = *(const f32x4*)p, b = *(const f32x4*)(p + 4), c = *(const f32x4*)(p + 8), d = *(const f32x4*)(p + 12);
    return (((a[0] + a[1]) + (a[2] + a[3])) + ((b[0] + b[1]) + (b[2] + b[3]))) + (((c[0] + c[1]) + (c[2] + c[3])) + ((d[0] + d[1]) + (d[2] + d[3])));
}
__device__ __forceinline__ float sum16x(const float* p, int fq) {
    const f32x4 a = *(const f32x4*)(p + 4 * fq); float s = (a[0] + a[1]) + (a[2] + a[3]);
    s += __shfl_xor(s, 32); s += __shfl_xor(s, 16); return s;
}
__device__ __forceinline__ float rstd_of(float ssq) { return __builtin_amdgcn_rsqf(ssq * (1.0f / 1024.0f) + RMS_EPS); }

template <int MODE> struct EpiRowBf16 {
    static constexpr bool PERM = true, AFTER_DRAIN = false;
    bf16_t* O; int ldc; const float* rowv; int ks; size_t piece_stride; int row_sub;
    __device__ __forceinline__ void operator()(const f32x4 (&acc)[2][2][4][2], const Unit& u, int wr, int wc, int fr, int fq) const {
        const int r0 = u.t * BM + wr * 64 + fr, col0 = u.j * BM + wc * 32 + 8 * fq;
        bf16_t* Ob = O; int rsub = 0; if (ks) { Ob += (size_t)(u.k0 / ks) * piece_stride; rsub = row_sub; }
        float sv[2][4];
#pragma unroll
        for (int ai = 0; ai < 2; ++ai)
#pragma unroll
            for (int m = 0; m < 4; ++m) sv[ai][m] = rowv[r0 + ai * HALF + m * 16];
        asm volatile("" ::: "memory");
#pragma unroll
        for (int ai = 0; ai < 2; ++ai)
#pragma unroll
            for (int m = 0; m < 4; ++m) { const int row = r0 + ai * HALF + m * 16; float s = sv[ai][m]; if (MODE == 0) s = rstd_of(s);
                bf16_t* rowp = Ob + (size_t)(row - rsub) * ldc + col0;
#pragma unroll
                for (int bj = 0; bj < 2; ++bj) { const f32x4 v0 = acc[ai][bj][m][0] * s, v1 = acc[ai][bj][m][1] * s;
                    u32x4 w; w.x = cvt_pk_bf16(v0[0], v0[1]); w.y = cvt_pk_bf16(v0[2], v0[3]); w.z = cvt_pk_bf16(v1[0], v1[1]); w.w = cvt_pk_bf16(v1[2], v1[3]);
                    *(u32x4*)(rowp + bj * HALF) = w; } }
    }
};
struct EpiResid {
    static constexpr bool PERM = true, AFTER_DRAIN = false;
    bf16_t* xb; float* ssqp; unsigned char* x8; float ascale;
    __device__ __forceinline__ void operator()(const f32x4 (&acc)[2][2][4][2], const Unit& u, int wr, int wc, int fr, int fq) const {
        const int r0 = u.pm * BM + wr * 64 + fr, col0 = u.pn * BM + wc * 32 + 8 * fq;
#pragma unroll
        for (int ai = 0; ai < 2; ++ai) {
            u32x4 pre[4][2];
#pragma unroll
            for (int m = 0; m < 4; ++m) { const size_t off = (size_t)(r0 + ai * HALF + m * 16) * 1024 + col0;
#pragma unroll
                for (int bj = 0; bj < 2; ++bj) pre[m][bj] = *(const u32x4*)(xb + off + bj * HALF); }
            asm volatile("" ::: "memory");
#pragma unroll
            for (int m = 0; m < 4; ++m) { const int row = r0 + ai * HALF + m * 16; const size_t off = (size_t)row * 1024 + col0; float ss = 0.f;
#pragma unroll
                for (int bj = 0; bj < 2; ++bj) { const u32x4 p = pre[m][bj]; float v[8];
#pragma unroll
                    for (int q = 0; q < 4; ++q) { v[2 * q] = __uint_as_float(p[q] << 16) + acc[ai][bj][m][q >> 1][(2 * q) & 3] * ascale; v[2 * q + 1] = __uint_as_float(p[q] & 0xffff0000u) + acc[ai][bj][m][q >> 1][(2 * q + 1) & 3] * ascale; }
                    u32x4 w; w.x = cvt_pk_bf16(v[0], v[1]); w.y = cvt_pk_bf16(v[2], v[3]); w.z = cvt_pk_bf16(v[4], v[5]); w.w = cvt_pk_bf16(v[6], v[7]);
                    *(u32x4*)(xb + off + bj * HALF) = w;
                    if (x8) { int p0 = 0, p1 = 0;
                        p0 = __builtin_amdgcn_cvt_pk_fp8_f32(v[0], v[1], p0, false); p0 = __builtin_amdgcn_cvt_pk_fp8_f32(v[2], v[3], p0, true);
                        p1 = __builtin_amdgcn_cvt_pk_fp8_f32(v[4], v[5], p1, false); p1 = __builtin_amdgcn_cvt_pk_fp8_f32(v[6], v[7], p1, true);
                        u32x2 w8; w8.x = (unsigned)p0; w8.y = (unsigned)p1; *(u32x2*)(x8 + off + bj * HALF) = w8; }
#pragma unroll
                    for (int q = 0; q < 8; ++q) ss += v[q] * v[q]; }
                if (ssqp) { ss += __shfl_xor(ss, 16); ss += __shfl_xor(ss, 32); if (fq == 0) ssqp[(size_t)row * 16 + u.pn * 4 + wc] = ss; } }
            asm volatile("" ::: "memory");
        }
    }
};
struct EpiConvIn {
    static constexpr bool PERM = true, AFTER_DRAIN = false;
    bf16_t* Bg; bf16_t* U; const float* ssq;
    __device__ __forceinline__ void operator()(const f32x4 (&acc)[2][2][4][2], const Unit& u, int wr, int wc, int fr, int fq) const {
        const int r0 = u.pm * BM + wr * 64 + fr;
        float sv[2][4];
#pragma unroll
        for (int ai = 0; ai < 2; ++ai)
#pragma unroll
            for (int m = 0; m < 4; ++m) sv[ai][m] = ssq[r0 + ai * HALF + m * 16];
        asm volatile("" ::: "memory");
        if (u.pn < 4) { const int col0 = u.pn * BM + wc * 32 + 8 * fq;
#pragma unroll
            for (int ai = 0; ai < 2; ++ai)
#pragma unroll
                for (int m = 0; m < 4; ++m) { const int row = r0 + ai * HALF + m * 16; const float s = rstd_of(sv[ai][m]);
                    bf16_t* rowp = Bg + (size_t)row * 1024 + col0;
#pragma unroll
                    for (int bj = 0; bj < 2; ++bj) { const f32x4 v0 = acc[ai][bj][m][0] * s, v1 = acc[ai][bj][m][1] * s;
                        u32x4 w; w.x = cvt_pk_bf16(v0[0], v0[1]); w.y = cvt_pk_bf16(v0[2], v0[3]); w.z = cvt_pk_bf16(v1[0], v1[1]); w.w = cvt_pk_bf16(v1[2], v1[3]);
                        *(u32x4*)(rowp + bj * HALF) = w; } }
        } else { const int col0 = (u.pn - 4) * HALF + wc * 32 + 8 * fq;
#pragma unroll
            for (int ai = 0; ai < 2; ++ai)
#pragma unroll
                for (int m = 0; m < 4; ++m) { const int row = r0 + ai * HALF + m * 16; const float s = rstd_of(sv[ai][m]), s2 = s * s;
                    const f32x4 h0 = (acc[ai][0][m][0] * acc[ai][1][m][0]) * s2, h1 = (acc[ai][0][m][1] * acc[ai][1][m][1]) * s2;
                    u32x4 w; w.x = cvt_pk_bf16(h0[0], h0[1]); w.y = cvt_pk_bf16(h0[2], h0[3]); w.z = cvt_pk_bf16(h1[0], h1[1]); w.w = cvt_pk_bf16(h1[2], h1[3]);
                    *(u32x4*)(U + (size_t)row * 1024 + col0) = w; }
        }
    }
};
typedef float f32x2v __attribute__((ext_vector_type(2)));
template <int MODE, bool OUT8 = false> struct EpiSwiGLU {
    static constexpr bool PERM = true, AFTER_DRAIN = false;
    bf16_t* H; int ldh; const float* rowv; int t0; float oscale; float pscale;
    __device__ __forceinline__ void operator()(const f32x4 (&acc)[2][2][4][2], const Unit& u, int wr, int wc, int fr, int fq) const {
        const int rl0 = wr * 64 + fr, col0 = u.j * HALF + wc * 32 + 8 * fq;
        float sv[2][4];
        if constexpr (MODE == 0) { f32x4 pq[2][4];
#pragma unroll
            for (int ai = 0; ai < 2; ++ai)
#pragma unroll
                for (int m = 0; m < 4; ++m) pq[ai][m] = *(const f32x4*)(rowv + (size_t)(u.t * BM + rl0 + ai * HALF + m * 16) * 16 + 4 * fq);
#pragma unroll
            for (int ai = 0; ai < 2; ++ai)
#pragma unroll
                for (int m = 0; m < 4; ++m) { const f32x4 a = pq[ai][m]; float q = (a[0] + a[1]) + (a[2] + a[3]); q += __shfl_xor(q, 32); q += __shfl_xor(q, 16); sv[ai][m] = rstd_of(q) * pscale; }
        } else {
#pragma unroll
            for (int ai = 0; ai < 2; ++ai)
#pragma unroll
                for (int m = 0; m < 4; ++m) sv[ai][m] = rowv[u.t * BM + rl0 + ai * HALF + m * 16];
        }
        asm volatile("" ::: "memory");
#pragma unroll
        for (int ai = 0; ai < 2; ++ai)
#pragma unroll
            for (int m = 0; m < 4; ++m) { const int rl = rl0 + ai * HALF + m * 16;
                const float s = sv[ai][m];
                const float sn = -1.4426950408889634f * s, s2 = OUT8 ? s * s * oscale : s * s;
                const f32x2v sn2 = {sn, sn}, so2 = {s2, s2}, one2 = {1.0f, 1.0f};
                float h[8];
#pragma unroll
                for (int n = 0; n < 2; ++n)
#pragma unroll
                    for (int q = 0; q < 2; ++q) { const f32x4 A = acc[ai][0][m][n], B = acc[ai][1][m][n];
                        const f32x2v a2 = {A[2 * q], A[2 * q + 1]}, b2 = {B[2 * q], B[2 * q + 1]};
                        const f32x2v t2 = a2 * sn2; f32x2v e2; e2.x = __builtin_amdgcn_exp2f(t2.x); e2.y = __builtin_amdgcn_exp2f(t2.y);
                        const f32x2v d2 = e2 + one2; f32x2v r2; r2.x = __builtin_amdgcn_rcpf(d2.x); r2.y = __builtin_amdgcn_rcpf(d2.y);
                        const f32x2v h2 = (a2 * b2) * (r2 * so2); h[n * 4 + 2 * q] = h2.x; h[n * 4 + 2 * q + 1] = h2.y; }
                if constexpr (OUT8) { int p0 = 0, p1 = 0;
                    p0 = __builtin_amdgcn_cvt_pk_fp8_f32(h[0], h[1], p0, false); p0 = __builtin_amdgcn_cvt_pk_fp8_f32(h[2], h[3], p0, true);
                    p1 = __builtin_amdgcn_cvt_pk_fp8_f32(h[4], h[5], p1, false); p1 = __builtin_amdgcn_cvt_pk_fp8_f32(h[6], h[7], p1, true);
                    u32x2 w; w.x = (unsigned)p0; w.y = (unsigned)p1; *(u32x2*)((unsigned char*)H + (size_t)((u.t - t0) * BM + rl) * ldh + col0) = w; }
                else { u32x4 w; w.x = cvt_pk_bf16(h[0], h[1]); w.y = cvt_pk_bf16(h[2], h[3]); w.z = cvt_pk_bf16(h[4], h[5]); w.w = cvt_pk_bf16(h[6], h[7]);
                    *(u32x4*)(H + (size_t)((u.t - t0) * BM + rl) * ldh + col0) = w; } }
    }
};
constexpr float QSCALE = 0.125f * 1.4426950408889634f;
struct EpiQKV {
    static constexpr bool PERM = true, AFTER_DRAIN = false;
    bf16_t* O; bf16_t* KH; bf16_t* VH; const float* ssqp; const PG8_LAS float* gtab; const float* rope;
    __device__ __forceinline__ void operator()(const f32x4 (&acc)[2][2][4][2], const Unit& u, int wr, int wc, int fr, int fq) const {
        const int type = u.pn >> 2;
        const PG8_LAS float* gn = gtab + (type == 0 ? 0 : 64) + 8 * fq;
        const int r0 = u.pm * BM + wr * 64 + fr, col0 = u.pn * BM + 64 * wc + 8 * fq;
        const float sg = fq == 0 ? -1.f : 1.f;
        float rsv[2][4];
        { f32x4 pq[2][4];
#pragma unroll
          for (int ai = 0; ai < 2; ++ai)
#pragma unroll
              for (int m = 0; m < 4; ++m) { const size_t row = (size_t)(r0 + ai * HALF + m * 16); pq[ai][m] = *(const f32x4*)(ssqp + row * 16 + 4 * fq); }
#pragma unroll
          for (int ai = 0; ai < 2; ++ai)
#pragma unroll
              for (int m = 0; m < 4; ++m) { const f32x4 a = pq[ai][m]; float q = (a[0] + a[1]) + (a[2] + a[3]); q += __shfl_xor(q, 32); q += __shfl_xor(q, 16); rsv[ai][m] = rstd_of(q); } }
        asm volatile("" ::: "memory");
        const int lfr = fr;
#pragma unroll
        for (int ai = 0; ai < 2; ++ai) {
            f32x4 rq[4];
            if (type < 2) {
#pragma unroll
                for (int m = 0; m < 4; ++m) rq[m] = *(const f32x4*)(rope + (size_t)(r0 + ai * HALF + m * 16) * 16 + 4 * fq); }
            asm volatile("" ::: "memory");
#pragma unroll
            for (int m = 0; m < 4; ++m) { const int row = r0 + ai * HALF + m * 16; const float rs = rsv[ai][m];
                f32x4 v[2][2];
                if (type < 2) {
                    float ss = 0.f;
#pragma unroll
                    for (int bj = 0; bj < 2; ++bj)
#pragma unroll
                        for (int n = 0; n < 2; ++n) { const f32x4 a = acc[ai][bj][m][n]; ss += (a[0] * a[0] + a[1] * a[1]) + (a[2] * a[2] + a[3] * a[3]); }
                    ss += __shfl_xor(ss, 16); ss += __shfl_xor(ss, 32);
                    const float sc = rs * __builtin_amdgcn_rsqf(ss * (rs * rs * (1.0f / 64.0f)) + RMS_EPS);
#pragma unroll
                    for (int bj = 0; bj < 2; ++bj)
#pragma unroll
                        for (int n = 0; n < 2; ++n) v[bj][n] = acc[ai][bj][m][n] * (*(const PG8_LAS f32x4*)(gn + 32 * bj + 4 * n) * sc);
                    f32x4 p[2];
#pragma unroll
                    for (int n = 0; n < 2; ++n)
#pragma unroll
                        for (int e = 0; e < 4; ++e) p[n][e] = __shfl_xor(v[0][n][e], 16);
                    { const f32x4 mine = rq[m];
#pragma unroll
                      for (int n = 0; n < 2; ++n) { f32x4 c_, s_;
#pragma unroll
                          for (int e = 0; e < 4; ++e) { c_[e] = __shfl(mine[e], 16 * n + lfr); s_[e] = __shfl(mine[e], 32 + 16 * n + lfr); }
                          if (fq < 2) v[0][n] = v[0][n] * c_ + (p[n] * s_) * sg; } }
                } else {
#pragma unroll
                    for (int bj = 0; bj < 2; ++bj)
#pragma unroll
                        for (int n = 0; n < 2; ++n) v[bj][n] = acc[ai][bj][m][n] * rs;
                }
                if (type < 2) {
                    unsigned char* rowp8; if (type == 0) rowp8 = (unsigned char*)O + (size_t)row * 1024 + col0;
                    else { const int hh = 2 * (u.pn & 3) + (wc >> 1), bb = row >> 13, ss_ = row & 8191; rowp8 = (unsigned char*)KH + ((size_t)(bb * 8 + hh) * 8192 + ss_) * 128 + (wc & 1) * 64 + 8 * fq; }
#pragma unroll
                    for (int bj = 0; bj < 2; ++bj) { int p0 = 0, p1 = 0;
                        p0 = __builtin_amdgcn_cvt_pk_fp8_f32(v[bj][0][0], v[bj][0][1], p0, false); p0 = __builtin_amdgcn_cvt_pk_fp8_f32(v[bj][0][2], v[bj][0][3], p0, true);
                        p1 = __builtin_amdgcn_cvt_pk_fp8_f32(v[bj][1][0], v[bj][1][1], p1, false); p1 = __builtin_amdgcn_cvt_pk_fp8_f32(v[bj][1][2], v[bj][1][3], p1, true);
                        u32x2 w; w.x = (unsigned)p0; w.y = (unsigned)p1; *(u32x2*)(rowp8 + 32 * bj) = w; }
                } else {
                    const int hh = 2 * (u.pn & 3) + (wc >> 1), bb = row >> 13, ss_ = row & 8191, tt = ss_ >> 6;
                    const int kk = 16 * (m & 1) + fr, pos = 32 * ((kk >> 2) & 1) + (kk & 3) + 4 * (kk >> 3) + 16 * (m >> 1);
                    unsigned char* tb = (unsigned char*)VH + (((size_t)(bb * 8 + hh) * 128 + tt) * 128 + (wc & 1) * 64 + 8 * fq) * 64 + pos;
#pragma unroll
                    for (int bj = 0; bj < 2; ++bj)
#pragma unroll
                        for (int n = 0; n < 2; ++n) { int pk = 0; pk = __builtin_amdgcn_cvt_pk_fp8_f32(v[bj][n][0], v[bj][n][1], pk, false); pk = __builtin_amdgcn_cvt_pk_fp8_f32(v[bj][n][2], v[bj][n][3], pk, true);
#pragma unroll
                            for (int e = 0; e < 4; ++e) tb[(32 * bj + 4 * n + e) * 64] = (unsigned char)((unsigned)pk >> (8 * e)); }
                } }
        }
    }
};

template <class Epi, class Sched, bool ALIGN_EPI = false, bool SP2 = false, bool F8 = false>
__device__ __forceinline__ void gemm_phase(PG8_LAS unsigned char* lds, const Gemm g, const Sched& S, const Epi& E) {
    int tid = threadIdx.x; asm volatile("" : "+v"(tid));
    const int wid = __builtin_amdgcn_readfirstlane(tid >> 6), lane = tid & 63, wr = wid >> 2, wc = wid & 3, fr = lane & 15, fq = lane >> 4;
    const int K = g.K, nt = K / BK, LD = g.ld ? g.ld : g.K;
    unsigned voffA[2], voffB[2];
#pragma unroll
    for (int i = 0; i < 2; ++i) { int R, C; stage_rc(tid * 16 + i * 8192, R, C); const int Rb = Epi::PERM ? ((R & ~31) + perm32(R & 31)) : R;
        voffA[i] = (unsigned)(R * LD + C) * 2u; voffB[i] = (unsigned)(Rb * LD + C) * 2u; }
    const size_t kstep = (size_t)(BK * 2);
    const size_t hstep = (size_t)HALF * LD * 2;
    const size_t tstep = 2 * hstep;
    const unsigned ldsw = (unsigned)wid * 1024u;
    const int aoff = lds_byte(wr * 64 + fr, fq * 8), boff = lds_byte(wc * 32 + fr, fq * 8);
#define PG8_SA(b, h) (((b) * 2 + (h)) * HTB)
#define PG8_SB(b, h) ((4 + (b) * 2 + (h)) * HTB)
#define PG8_STAGE(bufoff, gbase, voff) do { _Pragma("unroll") for (int _i = 0; _i < 2; ++_i) \
        __builtin_amdgcn_global_load_lds((const unsigned*)((const char*)(gbase) + (voff)[_i]), (PG8_LAS unsigned*)(lds + (bufoff) + ldsw + _i * 8192), 16, 0, 0); } while (0)
#define PG8_LDA(dst, b, h) do { if constexpr (F8) { _Pragma("unroll") for (int m = 0; m < 4; ++m) { const v4i_t x_ = *(const PG8_LAS v4i_t*)(lds + PG8_SA(b, h) + aoff + m * 2048), y_ = *(const PG8_LAS v4i_t*)(lds + PG8_SA(b, h) + aoff + m * 2048 + 1024); \
        dst##8[m] = (v8i_t){x_[0], x_[1], x_[2], x_[3], y_[0], y_[1], y_[2], y_[3]}; } } \
    else { _Pragma("unroll") for (int m = 0; m < 4; ++m) _Pragma("unroll") for (int k = 0; k < 2; ++k) dst[m][k] = *(const PG8_LAS bf16x8*)(lds + PG8_SA(b, h) + aoff + m * 2048 + k * 1024); } } while (0)
#define PG8_LDB(dst, b, h) do { if constexpr (F8) { _Pragma("unroll") for (int n = 0; n < 2; ++n) { const v4i_t x_ = *(const PG8_LAS v4i_t*)(lds + PG8_SB(b, h) + boff + n * 2048), y_ = *(const PG8_LAS v4i_t*)(lds + PG8_SB(b, h) + boff + n * 2048 + 1024); \
        dst##8[n] = (v8i_t){x_[0], x_[1], x_[2], x_[3], y_[0], y_[1], y_[2], y_[3]}; } } \
    else { _Pragma("unroll") for (int n = 0; n < 2; ++n) _Pragma("unroll") for (int k = 0; k < 2; ++k) dst[n][k] = *(const PG8_LAS bf16x8*)(lds + PG8_SB(b, h) + boff + n * 2048 + k * 1024); } } while (0)
#define PG8_MMA(ai, bj, At, Bt) do { if constexpr (F8) __builtin_amdgcn_sched_barrier(0); __builtin_amdgcn_s_setprio(1); \
    if constexpr (F8) { _Pragma("unroll") for (int m = 0; m < 4; ++m) _Pragma("unroll") for (int n = 0; n < 2; ++n) \
        asm volatile("v_mfma_f32_16x16x128_f8f6f4 %0, %1, %2, %0" : "+v"(acc[ai][bj][m][n]) : "v"(Bt##8[n]), "v"(At##8[m])); } \
    else { _Pragma("unroll") for (int m = 0; m < 4; ++m) _Pragma("unroll") for (int n = 0; n < 2; ++n) _Pragma("unroll") for (int k = 0; k < 2; ++k) \
        acc[ai][bj][m][n] = __builtin_amdgcn_mfma_f32_16x16x32_bf16(Bt[n][k], At[m][k], acc[ai][bj][m][n], 0, 0, 0); } \
    __builtin_amdgcn_s_setprio(0); if constexpr (F8) __builtin_amdgcn_sched_barrier(0); } while (0)
#define PG8_WAIT_V(n) asm volatile("s_waitcnt vmcnt(" #n ")" ::: "memory")
#define PG8_WAIT_L(n) asm volatile("s_waitcnt lgkmcnt(" #n ")" ::: "memory")
#define PG8_BAR __builtin_amdgcn_s_barrier()
#define PG8_SCHED __builtin_amdgcn_sched_barrier(0)
    Unit cur, nxt; int ui = 0;
    if (!S.next(0, cur)) return;
    f32x4 acc[2][2][4][2];
#pragma unroll
    for (int a = 0; a < 2; ++a)
#pragma unroll
        for (int b = 0; b < 2; ++b)
#pragma unroll
            for (int m = 0; m < 4; ++m)
#pragma unroll
                for (int n = 0; n < 2; ++n) acc[a][b][m][n] = (f32x4){0.f, 0.f, 0.f, 0.f};
    bf16x8 At[4][2], B0[2][2], B1[2][2]; v8i_t At8[4], B08[2], B18[2];
    const char* cA = (const char*)g.A + (size_t)cur.pm * tstep + (size_t)cur.k0 * 2; const char* cB = (const char*)g.Bt + (size_t)cur.pn * tstep + (size_t)cur.k0 * 2;
    S.a_ready(cur);
    if constexpr (SP2) {
        PG8_STAGE(PG8_SB(0, 0), cB, voffB); PG8_STAGE(PG8_SB(0, 1), cB + hstep, voffB); PG8_STAGE(PG8_SA(0, 0), cA, voffA); PG8_STAGE(PG8_SA(0, 1), cA + hstep, voffA);
        if (wr == 1) PG8_BAR;
        PG8_WAIT_V(2); PG8_BAR;
        PG8_STAGE(PG8_SB(1, 0), cB + kstep, voffB); PG8_STAGE(PG8_SA(1, 0), cA + kstep, voffA); PG8_STAGE(PG8_SB(1, 1), cB + hstep + kstep, voffB);
        PG8_WAIT_V(6); PG8_BAR;
    } else {
        PG8_STAGE(PG8_SB(0, 0), cB, voffB); PG8_STAGE(PG8_SA(0, 0), cA, voffA); PG8_STAGE(PG8_SB(0, 1), cB + hstep, voffB); PG8_STAGE(PG8_SA(0, 1), cA + hstep, voffA);
        if (wr == 1) PG8_BAR;
        PG8_WAIT_V(4); PG8_BAR;
        PG8_STAGE(PG8_SB(1, 0), cB + kstep, voffB); PG8_STAGE(PG8_SA(1, 0), cA + kstep, voffA); PG8_STAGE(PG8_SB(1, 1), cB + hstep + kstep, voffB);
        PG8_WAIT_V(6); PG8_BAR;
    }
    for (;;) {
        const bool has_next = S.next(ui + 1, nxt);
        const char* nA = has_next ? (const char*)g.A + (size_t)nxt.pm * tstep + (size_t)nxt.k0 * 2 : cA; const char* nB = has_next ? (const char*)g.Bt + (size_t)nxt.pn * tstep + (size_t)nxt.k0 * 2 : cB;
#pragma clang loop unroll(disable)
        for (int t = 0; t < nt; t += 2) {
            const bool last = (t == nt - 2);
            const char* a1 = cA + (size_t)(t + 1) * kstep;
            const char* a2 = last ? nA : cA + (size_t)(t + 2) * kstep; const char* b2 = last ? nB : cB + (size_t)(t + 2) * kstep;
            const char* a3 = a2 + kstep; const char* b3 = b2 + kstep;
            if (last && has_next) S.a_ready(nxt);
            if constexpr (SP2) {
            PG8_LDB(B0, 0, 0); PG8_LDB(B1, 0, 1); PG8_SCHED; PG8_LDA(At, 0, 0); PG8_STAGE(PG8_SA(1, 1), a1 + hstep, voffA);
            PG8_WAIT_V(8); PG8_WAIT_L(0); PG8_BAR; PG8_MMA(0, 0, At, B0); PG8_MMA(0, 1, At, B1); PG8_BAR; PG8_SCHED;
            PG8_LDA(At, 0, 1); PG8_STAGE(PG8_SB(0, 0), b2, voffB); PG8_STAGE(PG8_SB(0, 1), b2 + hstep, voffB); PG8_STAGE(PG8_SA(0, 0), a2, voffA);
            PG8_WAIT_V(8); PG8_WAIT_L(0); PG8_BAR; PG8_MMA(1, 0, At, B0); PG8_MMA(1, 1, At, B1); PG8_BAR; PG8_SCHED;
            PG8_LDB(B0, 1, 0); PG8_LDB(B1, 1, 1); PG8_SCHED; PG8_LDA(At, 1, 0); PG8_STAGE(PG8_SA(0, 1), a2 + hstep, voffA);
            PG8_WAIT_V(8); PG8_WAIT_L(0); PG8_BAR; PG8_MMA(0, 0, At, B0); PG8_MMA(0, 1, At, B1); PG8_BAR; PG8_SCHED;
            PG8_LDA(At, 1, 1); PG8_STAGE(PG8_SB(1, 0), b3, voffB); PG8_STAGE(PG8_SB(1, 1), b3 + hstep, voffB); PG8_STAGE(PG8_SA(1, 0), a3, voffA);
            PG8_WAIT_V(8); PG8_WAIT_L(0); PG8_BAR; PG8_MMA(1, 0, At, B0); PG8_MMA(1, 1, At, B1); PG8_BAR; PG8_SCHED;
            } else {
            PG8_LDB(B0, 0, 0); PG8_SCHED; PG8_LDA(At, 0, 0); PG8_STAGE(PG8_SA(1, 1), a1 + hstep, voffA);
            PG8_WAIT_L(8); PG8_BAR; PG8_WAIT_L(0); PG8_MMA(0, 0, At, B0); PG8_BAR; PG8_SCHED;
            PG8_LDB(B1, 0, 1); PG8_STAGE(PG8_SB(0, 0), b2, voffB);
            PG8_BAR; PG8_WAIT_L(0); PG8_MMA(0, 1, At, B1); PG8_BAR;
            PG8_LDA(At, 0, 1); PG8_STAGE(PG8_SA(0, 0), a2, voffA);
            PG8_BAR; PG8_WAIT_L(0); PG8_MMA(1, 0, At, B0); PG8_BAR; PG8_SCHED;
            PG8_STAGE(PG8_SB(0, 1), b2 + hstep, voffB);
            PG8_WAIT_V(6); PG8_BAR; PG8_MMA(1, 1, At, B1); PG8_BAR;
            PG8_LDB(B0, 1, 0); PG8_SCHED; PG8_LDA(At, 1, 0); PG8_STAGE(PG8_SA(0, 1), a2 + hstep, voffA);
            PG8_WAIT_L(8); PG8_BAR; PG8_WAIT_L(0); PG8_MMA(0, 0, At, B0); PG8_BAR; PG8_SCHED;
            PG8_LDB(B1, 1, 1); PG8_STAGE(PG8_SB(1, 0), b3, voffB);
            PG8_BAR; PG8_WAIT_L(0); PG8_MMA(0, 1, At, B1); PG8_BAR;
            PG8_LDA(At, 1, 1); PG8_STAGE(PG8_SA(1, 0), a3, voffA);
            PG8_BAR; PG8_WAIT_L(0); PG8_MMA(1, 0, At, B0); PG8_BAR; PG8_SCHED;
            PG8_STAGE(PG8_SB(1, 1), b3 + hstep, voffB);
            PG8_WAIT_V(6); PG8_BAR; PG8_MMA(1, 1, At, B1); PG8_BAR;
            }
        }
        if constexpr (F8) asm volatile("s_nop 15\n\ts_nop 15" ::: "memory");
        if constexpr (ALIGN_EPI) { if (wr == 0) PG8_BAR; }
        if constexpr (!Epi::AFTER_DRAIN) { E(acc, cur, wr, wc, fr, fq); S.done(cur); }
        if (!has_next) break;
#pragma unroll
        for (int a = 0; a < 2; ++a)
#pragma unroll
            for (int b = 0; b < 2; ++b)
#pragma unroll
                for (int m = 0; m < 4; ++m)
#pragma unroll
                    for (int n = 0; n < 2; ++n) acc[a][b][m][n] = (f32x4){0.f, 0.f, 0.f, 0.f};
        cur = nxt; cA = nA; cB = nB; ++ui;
        if constexpr (ALIGN_EPI) { if (wr == 1) PG8_BAR; }
    }
    PG8_WAIT_V(0);
    if constexpr (!ALIGN_EPI) { if (wr == 0) PG8_BAR; }
    PG8_BAR;
    if constexpr (Epi::AFTER_DRAIN) { E.fused(acc, cur, wr, wc, fr, fq, lds, wid, lane); S.done(cur); }
#undef PG8_SA
#undef PG8_SB
#undef PG8_STAGE
#undef PG8_LDA
#undef PG8_LDB
#undef PG8_MMA
#undef PG8_WAIT_V
#undef PG8_WAIT_L
#undef PG8_BAR
#undef PG8_SCHED
}
}

namespace dattn {
using bf16x8 = __attribute__((ext_vector_type(8))) short;
using s16x4  = __attribute__((ext_vector_type(4))) short;
using f32x16 = __attribute__((ext_vector_type(16))) float;
using u32x4  = __attribute__((ext_vector_type(4))) unsigned;
typedef unsigned short bf16_t;
typedef __attribute__((address_space(3))) const char* lds_cptr;
typedef short v4i16_t __attribute__((ext_vector_type(4)));
typedef int v8i_t __attribute__((ext_vector_type(8)));
typedef int v4i_t __attribute__((ext_vector_type(4)));
constexpr int SEQ = 8192, LDQ = 1024, LDR = 128, KVBLK = 64, NT = SEQ / KVBLK;
constexpr int SLOT_B = 16384, NSLOT = 4, V_IN_SLOT = 8192;
constexpr int OFF_COMB = 0, OFF_STG = 65536, OFF_WS = 131072, ATTN_LDS_BYTES = OFF_WS + 8 * 64 * 4;
#define KSWZ(row, colB) ((row) * 256 + ((colB) ^ (((row) & 7) << 4)))
#define SBAR() __builtin_amdgcn_sched_barrier(0)
__device__ __forceinline__ int crow(int r, int hi) { return (r & 3) + 8 * (r >> 2) + 4 * hi; }
__device__ __forceinline__ unsigned cvtpk(float lo, float hi) { unsigned r; asm volatile("v_cvt_pk_bf16_f32 %0, %1, %2" : "=v"(r) : "v"(lo), "v"(hi)); return r; }
__device__ __forceinline__ void glds16(const void* gsrc, unsigned lds_dst) { unsigned keep;
  asm volatile("s_mov_b32 %0, m0\n\ts_mov_b32 m0, %2\n\ts_nop 0\n\tglobal_load_lds_dwordx4 %1, off\n\ts_mov_b32 m0, %0" : "=&s"(keep) : "v"(gsrc), "s"(lds_dst) : "memory"); }
__device__ __forceinline__ s16x4 vtr(lds_cptr p) { return __builtin_bit_cast(s16x4, __builtin_amdgcn_ds_read_tr16_b64_v4i16((__attribute__((address_space(3))) v4i16_t*)p)); }
__device__ __forceinline__ v8i_t kfrag32(lds_cptr p0, lds_cptr p1) { const v4i_t x_ = *(const __attribute__((address_space(3))) v4i_t*)p0, y_ = *(const __attribute__((address_space(3))) v4i_t*)p1; return (v8i_t){x_[0], x_[1], x_[2], x_[3], y_[0], y_[1], y_[2], y_[3]}; }
__device__ __forceinline__ int v_rd_base(int lane) { return ((lane & 3) << 3) | (((lane >> 2) & 3) << 6) | (((lane >> 4) & 1) << 5) | (((lane >> 5) & 1) << 8); }
constexpr int v_rd_off(int d0, int ks, int half) { return d0 * 512 + ks * 4096 + half * 2048; }
#define WAIT_BAR(N) asm volatile("s_waitcnt vmcnt(" #N ") lgkmcnt(0)\n\ts_barrier" ::: "memory")
#define MF(A, B, C) __builtin_amdgcn_mfma_f32_32x32x16_bf16(A, B, C, 0, 0, 0)
typedef short v2s_t __attribute__((ext_vector_type(2)));
typedef float v4f_t __attribute__((ext_vector_type(4)));
__device__ __forceinline__ void glds_kv(const void* kbase, const void* vbase, unsigned koff, unsigned voff, unsigned lds_k, unsigned lds_v) { unsigned keep;
  asm volatile("s_mov_b32 %0, m0\n\ts_mov_b32 m0, %5\n\ts_nop 0\n\tglobal_load_lds_dwordx4 %1, %3\n\ts_mov_b32 m0, %6\n\ts_nop 0\n\tglobal_load_lds_dwordx4 %2, %4\n\ts_mov_b32 m0, %0"
               : "=&s"(keep) : "v"(koff), "v"(voff), "s"(kbase), "s"(vbase), "s"(lds_k), "s"(lds_v) : "memory"); }
__device__ __forceinline__ int pk4_bf8(float a, float b, float c, float d) { int r;
  asm("v_cvt_scalef32_pk_bf8_f32 %0, %1, %2, %3" : "=v"(r) : "v"(a), "v"(b), "s"(16.0f));
  asm("v_cvt_scalef32_pk_bf8_f32 %0, %1, %2, %3 op_sel:[0,0,0,1]" : "+v"(r) : "v"(c), "v"(d), "s"(16.0f)); return r; }
#define PK8(P, B, W0, W1) do { W0 = pk4_bf8(P[B], P[B + 1], P[B + 2], P[B + 3]); W1 = pk4_bf8(P[B + 4], P[B + 5], P[B + 6], P[B + 7]); } while (0)
__device__ __forceinline__ float fadd_s(float a, float b) { float r; asm("v_add_f32_e32 %0, %1, %2" : "=v"(r) : "v"(a), "v"(b)); return r; }
#define SUM8(P, B) fadd_s(fadd_s(fadd_s(P[B], P[B + 1]), fadd_s(P[B + 2], P[B + 3])), fadd_s(fadd_s(P[B + 4], P[B + 5]), fadd_s(P[B + 6], P[B + 7])))
__device__ __forceinline__ bf16x8 vfrag(lds_cptr vp, int off0, int off1) { const s16x4 l_ = vtr(vp + off0), h_ = vtr(vp + off1); return (bf16x8){l_[0], l_[1], l_[2], l_[3], h_[0], h_[1], h_[2], h_[3]}; }
#define VFRAG(d0, ks) vfrag(vp_, v_rd_off(d0, ks, 0), v_rd_off(d0, ks, 1))

template <bool SHIFT> __device__ __forceinline__ void attn_unit(int b, int h, int qb, const unsigned char* __restrict__ Q8, const unsigned char* __restrict__ KH8, const unsigned char* __restrict__ VT8, bf16_t* __restrict__ O, float lam, float negmb, float osc, const float* __restrict__ subg, char* lds) {
  int tid = threadIdx.x; asm volatile("" : "+v"(tid));
  const int lane = tid & 63, r32 = lane & 31, hi = lane >> 5; const int wid = __builtin_amdgcn_readfirstlane(tid >> 6);
  const int comp = wid >> 2, qs = wid & 3;
  const unsigned lds0 = (unsigned)(uintptr_t)lds; const lds_cptr lds3 = (lds_cptr)lds;
  float* wsf = (float*)(lds + OFF_WS) + wid * 64;
  const long rowbase = (long)b * SEQ; const int q0 = qb * 128;
  const unsigned char* Kh = KH8 + (long)(b * 8 + h) * SEQ * 128; const unsigned char* Vh = VT8 + (long)(b * 8 + h) * SEQ * 128;
  int kso, vso;
  { const int row = 8 * wid + (lane >> 3), ch = (lane & 7) ^ ((row >> 1) & 7); kso = row * 128 + ch * 16; }
  { const int d = 16 * wid + (lane >> 2), ch = (lane & 3) ^ ((d >> 2) & 3); vso = d * 64 + ch * 16; }
  const unsigned ldsw = (unsigned)__builtin_amdgcn_readfirstlane(lds0 + wid * 1024);
#define DMA_TILE(t, slotoff) do { const long tb_ = (long)(t) * (KVBLK * 128); glds_kv(Kh + tb_, Vh + tb_, kso, vso, ldsw + (slotoff), ldsw + (slotoff) + V_IN_SLOT); } while (0)
  v8i_t qf;
  { const v4i_t* Qw = (const v4i_t*)(Q8 + (rowbase + q0 + qs * 32 + r32) * 1024 + h * 128 + comp * 64 + hi * 32); const v4i_t x_ = Qw[0], y_ = Qw[1];
    qf = (v8i_t){x_[0], x_[1], x_[2], x_[3], y_[0], y_[1], y_[2], y_[3]}; }
  asm volatile("" ::: "memory");
  DMA_TILE(0, 0); DMA_TILE(1, SLOT_B); DMA_TILE(2, 2 * SLOT_B);
  const int ob_ = ((lane & 15) == ((lane >> 4) & 1)) ? 0x22222222 : 0; const v4i_t onesB = {ob_, ob_, ob_, ob_};
  v4f_t Lacc = {0.f, 0.f, 0.f, 0.f};
#define MFL(PF) asm volatile("v_mfma_f32_16x16x128_f8f6f4 %0, %1, %2, %0 cbsz:1 blgp:4" : "+v"(Lacc) : "v"(PF), "v"(onesB))
  const int ka0 = r32 * 128 + (((comp * 4 + 2 * hi) ^ ((r32 >> 1) & 7)) << 4), ka1 = r32 * 128 + (((comp * 4 + 2 * hi + 1) ^ ((r32 >> 1) & 7)) << 4);
#define KFRAG(kp, hb) kfrag32((kp) + ka0 + (hb) * 4096, (kp) + ka1 + (hb) * 4096)
#define VFRAG8(vp, d0) kfrag32((vp) + va0_ + (d0) * 2048, (vp) + va1_ + (d0) * 2048)
#define MFPV(OD, PF, VF) asm volatile("v_mfma_f32_32x32x64_f8f6f4 %0, %1, %2, %0 cbsz:1" : "+v"(OD) : "v"(PF), "v"(VF))
#define MFQK(C, KF) asm volatile("v_mfma_f32_32x32x64_f8f6f4 %0, %1, %2, 0" : "=&v"(C) : "v"(KF), "v"(qf))
  const int va0_ = V_IN_SLOT + r32 * 64 + (((2 * hi) ^ ((r32 >> 2) & 3)) << 4), va1_ = V_IN_SLOT + r32 * 64 + (((2 * hi + 1) ^ ((r32 >> 2) & 3)) << 4);
  f32x16 o[4];
#pragma unroll
  for (int d0 = 0; d0 < 4; ++d0) o[d0] = f32x16{};
  f32x16 pA0, pA1, pB0, pB1;
#define EX(v) __builtin_amdgcn_exp2f(SHIFT ? (v) + negmb : (v))
#define PIN(x) asm volatile("" : "+v"(x))
#define STEP(CX0, CX1, PY0, PY1, ks_, vs_) do { \
    const lds_cptr kp_ = lds3 + (ks_); const lds_cptr vp_ = lds3 + (vs_); \
    const v8i_t kf0 = KFRAG(kp_, 0), kf1 = KFRAG(kp_, 1); \
    int w0_, w1_, w2_, w3_, w4_, w5_, w6_, w7_; SBAR(); \
    MFQK(CX0, kf0); \
    PK8(PY0, 0, w0_, w1_); PK8(PY0, 8, w2_, w3_); SBAR(); \
    MFQK(CX1, kf1); \
    v8i_t vf0 = VFRAG8(vp_, 0), vf1 = VFRAG8(vp_, 1); \
    PK8(PY1, 0, w4_, w5_); PK8(PY1, 8, w6_, w7_); \
    const v8i_t pf_ = {w0_, w1_, w2_, w3_, w4_, w5_, w6_, w7_}; SBAR(); \
      \
    asm volatile("s_nop 1" ::: "memory"); \
    MFPV(o[0], pf_, vf0); v8i_t vf2 = VFRAG8(vp_, 2); \
    _Pragma("unroll") for (int r_ = 0; r_ < 8; ++r_) CX0[r_] = EX(CX0[r_]); SBAR(); \
    MFPV(o[1], pf_, vf1); v8i_t vf3 = VFRAG8(vp_, 3); \
    _Pragma("unroll") for (int r_ = 8; r_ < 16; ++r_) CX0[r_] = EX(CX0[r_]); PIN(CX0); SBAR(); \
    MFPV(o[2], pf_, vf2); \
    _Pragma("unroll") for (int r_ = 0; r_ < 8; ++r_) CX1[r_] = EX(CX1[r_]); SBAR(); \
    MFPV(o[3], pf_, vf3); MFL(pf_); \
    _Pragma("unroll") for (int r_ = 8; r_ < 16; ++r_) CX1[r_] = EX(CX1[r_]); PIN(CX1); SBAR(); \
  } while (0)
  if (wid >= 4) __builtin_amdgcn_s_setprio(1);
  WAIT_BAR(4);
  { const lds_cptr kp_ = lds3; const v8i_t kf0 = KFRAG(kp_, 0), kf1 = KFRAG(kp_, 1);
    MFQK(pA0, kf0); MFQK(pA1, kf1);
    asm volatile("s_nop 15\n\ts_nop 15\n\ts_nop 15\n\ts_nop 15" ::: "memory");
#pragma unroll
    for (int r = 0; r < 16; ++r) { pA0[r] = EX(pA0[r]); pA1[r] = EX(pA1[r]); } }
  WAIT_BAR(2);
#define SLOT(t) ((((t)) & 3) * SLOT_B)
  int j = 1;
  for (; j + 6 < NT; j += 4) {
    DMA_TILE(j + 2, SLOT(3));
    STEP(pB0, pB1, pA0, pA1, SLOT(1), SLOT(0)); WAIT_BAR(2);
    DMA_TILE(j + 3, SLOT(0));
    STEP(pA0, pA1, pB0, pB1, SLOT(2), SLOT(1)); WAIT_BAR(2);
    DMA_TILE(j + 4, SLOT(1));
    STEP(pB0, pB1, pA0, pA1, SLOT(3), SLOT(2)); WAIT_BAR(2);
    DMA_TILE(j + 5, SLOT(2));
    STEP(pA0, pA1, pB0, pB1, SLOT(0), SLOT(3)); WAIT_BAR(2);
  }
  DMA_TILE(j + 2, SLOT(3));
  STEP(pB0, pB1, pA0, pA1, SLOT(1), SLOT(0)); WAIT_BAR(2);
  STEP(pA0, pA1, pB0, pB1, SLOT(2), SLOT(1)); WAIT_BAR(0);
  STEP(pB0, pB1, pA0, pA1, SLOT(3), SLOT(2));
  { int w0_, w1_, w2_, w3_, w4_, w5_, w6_, w7_;
    PK8(pB0, 0, w0_, w1_); PK8(pB0, 8, w2_, w3_); PK8(pB1, 0, w4_, w5_); PK8(pB1, 8, w6_, w7_);
    const v8i_t pf_ = {w0_, w1_, w2_, w3_, w4_, w5_, w6_, w7_};
    const lds_cptr vp_ = lds3 + SLOT(3);
    const v8i_t vf0 = VFRAG8(vp_, 0), vf1 = VFRAG8(vp_, 1), vf2 = VFRAG8(vp_, 2), vf3 = VFRAG8(vp_, 3);
    asm volatile("s_nop 1" ::: "memory");
    MFPV(o[0], pf_, vf0); MFPV(o[1], pf_, vf1); MFPV(o[2], pf_, vf2); MFPV(o[3], pf_, vf3); MFL(pf_);
    asm volatile("s_nop 15\n\ts_nop 15\n\ts_nop 15\n\ts_nop 15\n\ts_nop 15\n\ts_nop 15" ::: "memory");
  }
#undef STEP
#undef VFRAG8
#undef MFPV
#undef MFL
#undef PK8
#undef KFRAG
#undef MFQK
#undef SLOT
#undef DMA_TILE
#undef EX
#undef PIN
  __builtin_amdgcn_s_setprio(0);
  if ((lane & 15) < 2) { const float cf_ = (comp == 0 ? 1.0f : -lam);
    const v4f_t c4 = {cf_ * __builtin_amdgcn_rcpf(Lacc[0]), cf_ * __builtin_amdgcn_rcpf(Lacc[1]), cf_ * __builtin_amdgcn_rcpf(Lacc[2]), cf_ * __builtin_amdgcn_rcpf(Lacc[3])};
    *(v4f_t*)(wsf + 16 * (lane & 15) + 4 * (lane >> 4)) = c4; }
  asm volatile("s_waitcnt lgkmcnt(0)" ::: "memory");
  float rli[16];
#pragma unroll
  for (int r = 0; r < 16; ++r) rli[r] = wsf[crow(r, hi)];
#pragma unroll
  for (int d0 = 0; d0 < 4; ++d0)
#pragma unroll
    for (int r = 0; r < 16; ++r) o[d0][r] *= rli[r];
  __syncthreads();
  float* comb = (float*)(lds + OFF_COMB) + qs * 4096 + lane;
  if (comp == 1) {
#pragma unroll
    for (int d0 = 0; d0 < 4; ++d0)
#pragma unroll
      for (int r = 0; r < 16; ++r) comb[(d0 * 16 + r) * 64] = o[d0][r];
  }
  __syncthreads();
  if (comp == 0) {
#pragma unroll
    for (int d0 = 0; d0 < 4; ++d0)
#pragma unroll
      for (int r = 0; r < 16; ++r) o[d0][r] += comb[(d0 * 16 + r) * 64];
    float gcol[4];
#pragma unroll
    for (int d0 = 0; d0 < 4; ++d0) gcol[d0] = subg[d0 * 32 + r32] * osc;
    bf16_t* stg = (bf16_t*)(lds + OFF_STG) + qs * 4096;
#pragma unroll
    for (int r = 0; r < 16; ++r) {
      float ss = (o[0][r] * o[0][r] + o[1][r] * o[1][r]) + (o[2][r] * o[2][r] + o[3][r] * o[3][r]);
      ss += __shfl_xor(ss, 1); ss += __shfl_xor(ss, 2); ss += __shfl_xor(ss, 4); ss += __shfl_xor(ss, 8); ss += __shfl_xor(ss, 16);
      const float rn = __builtin_amdgcn_rsqf(ss * (1.0f / 128.0f) + 1e-6f);
      const int orow = crow(r, hi);
#pragma unroll
      for (int d0 = 0; d0 < 4; ++d0) { const float v = o[d0][r] * rn * gcol[d0]; stg[orow * 128 + d0 * 32 + r32] = (bf16_t)(cvtpk(v, v) & 0xffffu); }
    }
    asm volatile("s_waitcnt lgkmcnt(0)" ::: "memory");
    bf16_t* Ow = O + (rowbase + q0 + qs * 32) * 1024 + h * 128;
#pragma unroll
    for (int i = 0; i < 8; ++i) { const int row = i * 4 + (lane >> 4), ch = lane & 15; const u32x4 v = *(const u32x4*)(stg + row * 128 + ch * 8); *(u32x4*)(Ow + (long)row * 1024 + ch * 8) = v; }
  }
  __syncthreads();
}
#undef KSWZ
#undef SBAR
#undef WAIT_BAR
#undef MF
#undef PK4
#undef SUM8
#undef VFRAG
}

constexpr int NWAVES = 8;
constexpr int BATCH = 2, SEQ = 8192, D = 1024, M = BATCH * SEQ, NQKV = 3072, DFF = 2816, NE = 8, DFE = 3584, NH = 8;
constexpr float LAMBDA_INIT = 0.35550906759096934f;
constexpr size_t MiB = 1u << 20, KiB = 1u << 10;
constexpr size_t WS_CTL = 0, CTL_ZERO_BYTES = 1 * MiB;
constexpr size_t WS_ROPE = 1 * MiB, WS_SSQP1 = 2 * MiB, WS_SSQP2 = 3 * MiB;
constexpr size_t WS_SSQ0 = 4 * MiB, WS_TOKE = WS_SSQ0 + 64 * KiB, WS_TOKG = WS_TOKE + 64 * KiB, WS_TOKRS = WS_TOKG + 128 * KiB, WS_TOKSLOT = WS_TOKRS + 64 * KiB,
                 WS_HIST = WS_TOKSLOT + 128 * KiB, WS_SLOTRS = WS_HIST + 64 * KiB, WS_SLOTG = WS_SLOTRS + 192 * KiB, WS_META = WS_SLOTG + 192 * KiB, WS_CONST = WS_META + 4 * KiB, WS_RG = WS_CONST + 4 * KiB;
static_assert(WS_RG + 32 * KiB <= 5 * MiB, "small tables");
constexpr size_t WS_WM13 = 8 * MiB, WS_WM2 = 64 * MiB, WS_WCI = 92 * MiB, WS_WCO = 98 * MiB, WS_WAI = 100 * MiB, WS_WAO = 106 * MiB, WS_W13 = 108 * MiB, WS_W2 = 119 * MiB;
constexpr size_t WS_XB = 126 * MiB, WS_R1 = 158 * MiB, WS_GO = 254 * MiB;
constexpr size_t WS_X8 = 300 * MiB;
constexpr size_t WS_HG = 158 * MiB, WS_Y = 192 * MiB, WS_HIDM = 260 * MiB, WS_YP = 379 * MiB, WS_END = 407 * MiB;
constexpr int MOE_T1 = 128, MOE_LMAX = 8, MOE_NSPLIT = 7, MOE_KS = 512, MOE_TMAX = 136;
constexpr float W8_SCALE = 64.0f, H8_SCALE = 4.0f;
static_assert(WS_WM13 + (size_t)NE * 2 * DFE * D <= WS_WM2 && WS_WM2 + (size_t)NE * D * DFE <= WS_WCI && WS_W13 + (size_t)2 * DFF * D * 2 <= WS_W2 && WS_W2 + (size_t)D * DFF * 2 <= WS_XB, "weights");
static_assert(WS_XB + (size_t)M * D * 2 <= WS_R1 && WS_R1 + (size_t)M * NQKV * 2 <= WS_GO && WS_HG + (size_t)MOE_TMAX * 256 * D <= WS_Y && WS_Y + (size_t)MOE_TMAX * 256 * D * 2 <= WS_HIDM && WS_HIDM + (size_t)MOE_TMAX * 256 * DFE <= WS_YP
              && WS_YP + (size_t)MOE_NSPLIT * MOE_LMAX * 256 * D * 2 <= WS_END && MOE_NSPLIT * MOE_KS == DFE, "activations");
constexpr int CW_BAR = 4096;
constexpr int RING_OFF = 0, RING_BYTES = 135168;
constexpr int LDSCTL_OFF = RING_BYTES, MISC_OFF = LDSCTL_OFF + 320, TEXP_OFF = LDSCTL_OFF + 1024;
constexpr int LDS_BYTES = 147456;
static_assert(dattn::ATTN_LDS_BYTES <= RING_BYTES, "attention scratch");
#define GAS __attribute__((address_space(1)))
#define LAS __attribute__((address_space(3)))
typedef unsigned short bf16;
typedef unsigned v4u __attribute__((ext_vector_type(4)));
typedef float f32x4 __attribute__((ext_vector_type(4)));
typedef GAS unsigned gu32;
#define LDS_WAIT() asm volatile("s_waitcnt lgkmcnt(0)" ::: "memory")
__device__ __forceinline__ unsigned f2bf(float f) { unsigned u = __builtin_bit_cast(unsigned, f); return (u + 0x7fffu + ((u >> 16) & 1u)) >> 16; }
__device__ __forceinline__ unsigned pk2(float lo, float hi) { return f2bf(lo) | (f2bf(hi) << 16); }
struct Inputs { const float* x; const int* positions; const float *norm_mix, *norm_ffn, *conv_in, *conv_w, *conv_out, *attn_in, *q_norm, *k_norm, *lam_q1, *lam_k1, *lam_q2, *lam_k2, *subln, *attn_out,
                *ffn_w1, *ffn_w3, *ffn_w2, *router, *moe_w1, *moe_w3, *moe_w2; };

#define XB_TMO      128
#define XB_XCNT(j)  (256  + 64 * (j))
#define XB_XSUB(j)  (1280 + 64 * (j))
#define XB_XGEN(j)  (2304 + 64 * (j))
#define XB_TOP      3328
#define XB_TOPGEN   3392
#define XCD_BAR_WORDS 3456
#define XB_SPIN_CAP (1u << 18)

__device__ __forceinline__ unsigned xb_ld(unsigned* p)              { return __hip_atomic_load(p, __ATOMIC_RELAXED, __HIP_MEMORY_SCOPE_AGENT); }
__device__ __forceinline__ unsigned xb_add(unsigned* p, unsigned v) { return __hip_atomic_fetch_add(p, v, __ATOMIC_RELAXED, __HIP_MEMORY_SCOPE_AGENT); }
__device__ __forceinline__ unsigned xb_xcc_id() { return (unsigned)__builtin_amdgcn_s_getreg((3 << 11) | 20) & 0xFu; }
#define XB_SPIN(cond, bar) do { unsigned _sp = 0; while (cond) { __builtin_amdgcn_s_sleep(1); \
    if ((++_sp & 255u) == 0u) { if (xb_ld(&(bar)[XB_TMO])) break; if (_sp > XB_SPIN_CAP) { atomicAdd(&(bar)[XB_TMO], 1u); break; } } } } while (0)

struct XcdBarrier {
    unsigned* bar; unsigned x;
    volatile LAS unsigned* st;
};

__device__ __forceinline__ XcdBarrier xcd_barrier_post(unsigned* bar, volatile LAS unsigned* st) {
    XcdBarrier b; b.bar = bar; b.x = xb_xcc_id(); b.st = st;
    if (threadIdx.x == 0) (void)xb_add(&bar[XB_XCNT(b.x)], 1u);
    return b;
}
__device__ __forceinline__ void xcd_barrier_complete(unsigned* bar, unsigned x, unsigned& nloc, unsigned& nx) {
    const unsigned G = gridDim.x * gridDim.y * gridDim.z;
    unsigned sum, cnt, mine, sp = 0u;
    for (;;) {
        sum = 0u; cnt = 0u; mine = 0u;
#pragma unroll
        for (unsigned j = 0; j < 16; ++j) { const unsigned c = xb_ld(&bar[XB_XCNT(j)]); sum += c; cnt += (c > 0u) ? 1u : 0u; mine = (j == x) ? c : mine; }
        if (sum == G) break;
        __builtin_amdgcn_s_sleep(1);
        if ((++sp & 255u) == 0u) { if (xb_ld(&bar[XB_TMO])) break; if (sp > XB_SPIN_CAP) { atomicAdd(&bar[XB_TMO], 1u); break; } }
    }
    nloc = mine > 0u ? mine : 1u; nx = cnt > 0u ? cnt : 1u;
}

__device__ __forceinline__ void xcd_barrier(const XcdBarrier& b) {
    asm volatile("s_waitcnt vmcnt(0)" ::: "memory");
    __syncthreads();
    if (threadIdx.x == 0) {
        unsigned* bar = b.bar;
        __builtin_amdgcn_s_waitcnt(0);
        unsigned nloc = b.st[0], nx = b.st[1];
        if (nloc == 0u) { xcd_barrier_complete(bar, b.x, nloc, nx); b.st[0] = nloc; b.st[1] = nx; }
        const unsigned old = xb_add(&bar[XB_XSUB(b.x)], 1u);
        const unsigned gen = old / nloc;
        if (old + 1u == (gen + 1u) * nloc) {
            __builtin_amdgcn_fence(__ATOMIC_RELEASE, "agent");
            asm volatile("s_waitcnt vmcnt(0)" ::: "memory");
            const unsigned og = xb_add(&bar[XB_TOP], 1u);
            const unsigned tg = og / nx;
            if (og + 1u == (tg + 1u) * nx) xb_add(&bar[XB_TOPGEN], 1u);
            else XB_SPIN(xb_ld(&bar[XB_TOPGEN]) == tg, bar);
            __builtin_amdgcn_fence(__ATOMIC_ACQUIRE, "agent");
            xb_add(&bar[XB_XGEN(b.x)], 1u);
            asm volatile("s_waitcnt vmcnt(0)" ::: "memory");
        } else {
            XB_SPIN(xb_ld(&bar[XB_XGEN(b.x)]) == gen, bar);
            __builtin_amdgcn_fence(__ATOMIC_ACQUIRE, "agent");
            asm volatile("s_waitcnt vmcnt(0)" ::: "memory");
        }
    }
    __syncthreads();
}

struct Frame {
    LAS unsigned char* lds;
    volatile LAS unsigned* MISC;
    gu32* ctl;
    int tid, lane, wave;
    int vcu, G;
};

__device__ __forceinline__ float wave_sum(float v) {
#pragma unroll
    for (int o = 1; o < 64; o <<= 1) v += __shfl_xor(v, o);
    return v;
}
__device__ __forceinline__ float wave_max(float v) {
#pragma unroll
    for (int o = 1; o < 64; o <<= 1) v = fmaxf(v, __shfl_xor(v, o));
    return v;
}
__device__ __forceinline__ float bf2f(unsigned short h) { return __uint_as_float((unsigned)h << 16); }
template <int MAP> __device__ __forceinline__ int rowmap(int n0) {
    if (MAP == 1) return (n0 >> 7) * 256 + (n0 & 127);
    if (MAP == 2) return (n0 >> 7) * 256 + 128 + (n0 & 127);
    if (MAP == 3) return (n0 & ~255) + ((n0 >> 5) & 1) * 128 + ((n0 >> 6) & 3) * 32;
    if (MAP == 4) { if (n0 < D) return n0; const int c = (n0 - D) & (D - 1); return D + (c >> 7) * 256 + (n0 >= 2 * D ? 128 : 0) + (c & 127); }
    return n0;
}
template <int MAP> __device__ __forceinline__ void transpose_item(const float* W, int K, int N, const float* gain, bf16* WT, LAS unsigned* T, int item, int lane) {
    const int nblk = N / 64, kb = item / nblk, nb = item % nblk, k0 = 64 * kb, n0 = 64 * nb;
    const int kk = lane >> 4, nn = (lane & 15) * 4;
    f32x4 a[8], b[8];
    const float* Wp = W + (size_t)(k0 + 2 * kk) * N + n0 + nn;
    float ga[8], gb[8];
#pragma unroll
    for (int i = 0; i < 8; ++i) { ga[i] = gain ? gain[k0 + 8 * i + 2 * kk] : 1.0f; gb[i] = gain ? gain[k0 + 8 * i + 2 * kk + 1] : 1.0f; }
#pragma unroll
    for (int i = 0; i < 8; ++i) { a[i] = __builtin_nontemporal_load((const f32x4*)(Wp + (size_t)(8 * i) * N)); b[i] = __builtin_nontemporal_load((const f32x4*)(Wp + (size_t)(8 * i + 1) * N)); }
    asm volatile("" ::: "memory");
#pragma unroll
    for (int i = 0; i < 8; ++i) {
        if (gain) { a[i] = a[i] * ga[i]; b[i] = b[i] * gb[i]; }
#pragma unroll
        for (int e = 0; e < 4; ++e) T[(nn + e) * 36 + 4 * i + kk] = pg8::cvt_pk_bf16(a[i][e], b[i][e]); }
    LDS_WAIT(); asm volatile("" ::: "memory");
    const int c = lane & 7;
#pragma unroll
    for (int j = 0; j < 8; ++j) { const int n = (lane >> 3) + 8 * j; const v4u o = *(const LAS v4u*)(T + n * 36 + 4 * c);
        const int drow = rowmap<MAP>(n0 + (n & 32)) + (n & 31);
        *(GAS v4u*)(WT + (size_t)drow * K + k0 + 8 * c) = o; }
    LDS_WAIT(); asm volatile("" ::: "memory");
}

template <int MAP> __device__ __forceinline__ void transpose_item8(const float* W, int K, int N, const float* gain, unsigned char* WT, LAS unsigned* T, int item, int lane) {
    const int nblk = N / 64, kb = item / nblk, nb = item % nblk, k0 = 64 * kb, n0 = 64 * nb;
    const int kk = lane >> 4, nn = (lane & 15) * 4;
    f32x4 a[4][4];
    const float* Wp = W + (size_t)(k0 + 4 * kk) * N + n0 + nn;
#pragma unroll
    for (int i = 0; i < 4; ++i)
#pragma unroll
        for (int q = 0; q < 4; ++q) a[i][q] = __builtin_nontemporal_load((const f32x4*)(Wp + (size_t)(16 * i + q) * N));
    asm volatile("" ::: "memory");
#pragma unroll
    for (int i = 0; i < 4; ++i) { const int r = 16 * i + 4 * kk;
        float g[4];
#pragma unroll
        for (int q = 0; q < 4; ++q) g[q] = (gain ? gain[k0 + r + q] : 1.0f) * W8_SCALE;
#pragma unroll
        for (int e = 0; e < 4; ++e) { int p = 0; p = __builtin_amdgcn_cvt_pk_fp8_f32(a[i][0][e] * g[0], a[i][1][e] * g[1], p, false); p = __builtin_amdgcn_cvt_pk_fp8_f32(a[i][2][e] * g[2], a[i][3][e] * g[3], p, true);
            T[(nn + e) * 20 + 4 * i + kk] = (unsigned)p; } }
    LDS_WAIT(); asm volatile("" ::: "memory");
    const int c = lane & 3;
#pragma unroll
    for (int j = 0; j < 4; ++j) { const int n = (lane >> 2) + 16 * j; const v4u o = *(const LAS v4u*)(T + n * 20 + 4 * c);
        const int drow = rowmap<MAP>(n0 + (n & 32)) + (n & 31);
        __builtin_nontemporal_store(o, (GAS v4u*)(WT + (size_t)drow * K + k0 + 16 * c)); }
    LDS_WAIT(); asm volatile("" ::: "memory");
}

__device__ __constant__ double ROPE_TURNS[8] = {
    0.15915494309189535, 0.03086376340470123, 0.005985185712713705, 0.001160663641240061,
    0.00022507907903927653, 4.364795279280289e-05, 8.464330808241401e-06, 1.6414262627950345e-06 };

__device__ __forceinline__ void p0_prologue(Frame& F, const Inputs& I, unsigned char* ws) {
    LAS unsigned* scr = (LAS unsigned*)(F.lds + RING_OFF + F.wave * 16384);
    const int gw = F.vcu * NWAVES + F.wave, NGW = F.G * NWAVES;
    constexpr int I_CI = (D / 64) * (NQKV / 64), I_CO = (D / 64) * (D / 64), I_F13 = (D / 64) * (DFF / 64), I_F2 = (DFF / 64) * (D / 64);
    constexpr int I_M13 = (D / 64) * (DFE / 64), I_M2 = (DFE / 64) * (D / 64);
    constexpr int NITEMS = I_CI + I_CO + 2 * I_F13;
    bf16* WCI = (bf16*)(ws + WS_WCI); bf16* WCO = (bf16*)(ws + WS_WCO); unsigned char* W13 = ws + WS_W13;
    for (int it = gw; it < NITEMS; it += NGW) {
        int r = it;
        if (r < I_CI) { transpose_item<4>(I.conv_in, D, NQKV, I.norm_mix, WCI, scr, r, F.lane); continue; } r -= I_CI;
        if (r < I_CO) { transpose_item<0>(I.conv_out, D, D, nullptr, WCO, scr, r, F.lane); continue; } r -= I_CO;
        if (r < I_F13) { transpose_item8<1>(I.ffn_w1, D, DFF, I.norm_ffn, W13, scr, r, F.lane); continue; } r -= I_F13;
        transpose_item8<2>(I.ffn_w3, D, DFF, I.norm_ffn, W13, scr, r, F.lane);
    }
    bf16* XB = (bf16*)(ws + WS_XB); float* SSQ0 = (float*)(ws + WS_SSQ0); float* ROPE = (float*)(ws + WS_ROPE);
    for (int m0 = gw; m0 < M; m0 += 2 * NGW) {
        f32x4 v[2][4];
#pragma unroll
        for (int h = 0; h < 2; ++h) { const int m = m0 + h * NGW; if (m < M) { const GAS f32x4* xr = (const GAS f32x4*)(I.x + (size_t)m * D) + F.lane;
#pragma unroll
            for (int j = 0; j < 4; ++j) v[h][j] = __builtin_nontemporal_load(xr + 64 * j); } }
#pragma unroll
        for (int h = 0; h < 2; ++h) { const int m = m0 + h * NGW; if (m < M) { GAS unsigned long long* o8 = (GAS unsigned long long*)(XB + (size_t)m * D) + F.lane;
            float s = 0.f;
#pragma unroll
            for (int j = 0; j < 4; ++j) { const f32x4 w = v[h][j]; s += (w.x * w.x + w.y * w.y) + (w.z * w.z + w.w * w.w);
                o8[64 * j] = (unsigned long long)pk2(w.x, w.y) | ((unsigned long long)pk2(w.z, w.w) << 32); }
            s = wave_sum(s);
            if (F.lane == 0) SSQ0[m] = s;
            if (F.lane < 8) { const double t = (double)I.positions[m] * ROPE_TURNS[F.lane]; const float fr = (float)(t - __builtin_floor(t));
                ROPE[(size_t)m * 16 + F.lane] = __builtin_amdgcn_cosf(fr); ROPE[(size_t)m * 16 + 8 + F.lane] = __builtin_amdgcn_sinf(fr); } } }
    }
    { float* RG = (float*)(ws + WS_RG);
      for (int k = gw * 64 + F.lane; k < D; k += NGW * 64) { const float g = I.norm_ffn[D + k];
#pragma unroll
          for (int e = 0; e < 8; ++e) RG[e * D + k] = g * I.router[k * 8 + e]; } }
    if (gw == 0) {
        const float a = wave_sum(I.lam_q1[F.lane] * I.lam_k1[F.lane]), b = wave_sum(I.lam_q2[F.lane] * I.lam_k2[F.lane]);
        const float gq = wave_max(fabsf(I.q_norm[F.lane])), gk = wave_max(fabsf(I.k_norm[F.lane]));
        if (F.lane == 0) { float* C = (float*)(ws + WS_CONST); C[0] = __expf(a) - __expf(b) + LAMBDA_INIT; C[1] = -(8.0f * gq * gk * 1.4426950408889634f * 1.03f + 0.5f); }
    }
}

__device__ __forceinline__ void late_weight_items(Frame& F, const Inputs& I, unsigned char* ws, int gw, int NGW) {
    LAS unsigned* scr = (LAS unsigned*)(F.lds + RING_OFF + F.wave * 16384);
    constexpr int I_CI = (D / 64) * (NQKV / 64), I_CO = (D / 64) * (D / 64), I_F2 = (DFF / 64) * (D / 64);
    constexpr int NITEMS = I_F2 + I_CI + I_CO;
    bf16* WAI = (bf16*)(ws + WS_WAI); bf16* WAO = (bf16*)(ws + WS_WAO); unsigned char* W2 = ws + WS_W2;
    for (int it = gw; it < NITEMS; it += NGW) {
        int r = it;
        if (r < I_F2) { transpose_item8<0>(I.ffn_w2, DFF, D, nullptr, W2, scr, r, F.lane); continue; } r -= I_F2;
        if (r < I_CI) { transpose_item<3>(I.attn_in, D, NQKV, I.norm_mix + D, WAI, scr, r, F.lane); continue; } r -= I_CI;
        transpose_item<0>(I.attn_out, D, D, nullptr, WAO, scr, r, F.lane);
    }
}

struct W8Item { const float* Wp; const float* gain; unsigned char* WT; int N, K, map, k0, n0; };
__device__ __forceinline__ void w8_desc(const Inputs& I, unsigned char* ws, int it, int lane, W8Item& d) {
    constexpr int I_M13 = (D / 64) * (DFE / 64), I_M2 = (DFE / 64) * (D / 64), PER_E = 2 * I_M13 + I_M2;
    const int e = it / PER_E; int r = it - e * PER_E; const float* W;
    if (r < 2 * I_M13) { const bool second = r >= I_M13; r -= second ? I_M13 : 0; W = (second ? I.moe_w3 : I.moe_w1) + (size_t)e * D * DFE; d.N = DFE; d.K = D; d.gain = I.norm_ffn + D; d.WT = ws + WS_WM13 + (size_t)e * 2 * DFE * D; d.map = second ? 2 : 1; }
    else { r -= 2 * I_M13; W = I.moe_w2 + (size_t)e * DFE * D; d.N = D; d.K = DFE; d.gain = nullptr; d.WT = ws + WS_WM2 + (size_t)e * D * DFE; d.map = 0; }
    const int nblk = d.N / 64, pr = r >> 1, kp = pr / nblk, nb = pr - kp * nblk, kb = 2 * kp + (r & 1); d.k0 = 64 * kb; d.n0 = 64 * nb;
    d.Wp = W + (size_t)(d.k0 + 4 * (lane >> 4)) * d.N + d.n0 + (lane & 15) * 4;
}
__device__ __forceinline__ void w8_load(const W8Item& d, f32x4 (&a)[4][4], f32x4 (&gq)[4], int lane) {
    const int kk = lane >> 4;
#pragma unroll
    for (int i = 0; i < 4; ++i) { const f32x4 one = {1.0f, 1.0f, 1.0f, 1.0f}; gq[i] = d.gain ? *(const f32x4*)(d.gain + d.k0 + 16 * i + 4 * kk) : one; }
#pragma unroll
    for (int i = 0; i < 4; ++i)
#pragma unroll
        for (int q = 0; q < 4; ++q) a[i][q] = __builtin_nontemporal_load((const f32x4*)(d.Wp + (size_t)(16 * i + q) * d.N));
}
__device__ __forceinline__ void w8_finish(const W8Item& d, const f32x4 (&a)[4][4], const f32x4 (&gq)[4], LAS unsigned* T, int lane, int half) {
    const int kk = lane >> 4, nn = (lane & 15) * 4;
#pragma unroll
    for (int i = 0; i < 4; ++i) {
        float g[4];
#pragma unroll
        for (int q = 0; q < 4; ++q) g[q] = gq[i][q] * W8_SCALE;
#pragma unroll
        for (int e = 0; e < 4; ++e) { int p = 0; p = __builtin_amdgcn_cvt_pk_fp8_f32(a[i][0][e] * g[0], a[i][1][e] * g[1], p, false); p = __builtin_amdgcn_cvt_pk_fp8_f32(a[i][2][e] * g[2], a[i][3][e] * g[3], p, true);
            T[(nn + e) * 36 + 16 * half + 4 * i + kk] = (unsigned)p; } }
    if (half) {
        LDS_WAIT(); asm volatile("" ::: "memory");
        const int c = lane & 7;
#pragma unroll
        for (int j = 0; j < 8; ++j) { const int n = (lane >> 3) + 8 * j; const v4u o = *(const LAS v4u*)(T + n * 36 + 4 * c);
            const int nb32 = d.n0 + (n & 32); const int drow = (d.map == 0 ? nb32 : (nb32 >> 7) * 256 + (d.map == 2 ? 128 : 0) + (nb32 & 127)) + (n & 31);
            __builtin_nontemporal_store(o, (GAS v4u*)(d.WT + (size_t)drow * d.K + (d.k0 - 64) + 16 * c)); }
        LDS_WAIT(); asm volatile("" ::: "memory");
    }
}
constexpr int W8_NIT = NE * (2 * (D / 64) * (DFE / 64) + (DFE / 64) * (D / 64)), W8_EARLY = 2048;
__device__ __forceinline__ void moe_weight_items(Frame& F, const Inputs& I, unsigned char* ws, int gw, int NGW, int lo, int NIT) {
    LAS unsigned* scr = (LAS unsigned*)(F.lds + RING_OFF + F.wave * 16384);
#define W8_IDX(j) (lo + 2 * (gw + ((j) >> 1) * NGW) + ((j) & 1))
    f32x4 a0[4][4], a1[4][4], g0[4], g1[4]; W8Item d0, d1;
    int j = 0;
    if (W8_IDX(0) >= NIT) return;
    w8_desc(I, ws, W8_IDX(0), F.lane, d0); w8_load(d0, a0, g0, F.lane);
    for (;;) {
        const bool h1 = W8_IDX(j + 1) < NIT;
        if (h1) { w8_desc(I, ws, W8_IDX(j + 1), F.lane, d1); w8_load(d1, a1, g1, F.lane); }
        w8_finish(d0, a0, g0, scr, F.lane, 0);
        if (!h1) break;
        const bool h2 = W8_IDX(j + 2) < NIT;
        if (h2) { w8_desc(I, ws, W8_IDX(j + 2), F.lane, d0); w8_load(d0, a0, g0, F.lane); }
        w8_finish(d1, a1, g1, scr, F.lane, 1);
        if (!h2) break;
        j += 2;
    }
#undef W8_IDX
}
template <bool SHIFT> __device__ __forceinline__ void attn_phase_loop(Frame& F, const Inputs& I, unsigned char* ws, const bf16* R1, bf16* GO, float lam, float negmb, char* lds, bool early_done) {
    bool conv_done = false; int ui = 0;
    for (int u = F.vcu; u < 2 * NH * (SEQ / 128); u += F.G, ++ui) { const int bh = u >> 6, qb = u & 63;
        dattn::attn_unit<SHIFT>(bh >> 3, bh & 7, qb, (const unsigned char*)R1, (const unsigned char*)(R1 + (size_t)M * D), (const unsigned char*)(R1 + (size_t)2 * M * D), GO, lam, negmb, 1.0f - LAMBDA_INIT, I.subln, lds);
        if (!conv_done && ui == (F.vcu & 3)) { moe_weight_items(F, I, ws, F.vcu * NWAVES + F.wave, F.G * NWAVES, early_done ? W8_EARLY : 0, W8_NIT); conv_done = true; __syncthreads(); }
    }
    if (!conv_done) { moe_weight_items(F, I, ws, F.vcu * NWAVES + F.wave, F.G * NWAVES, early_done ? W8_EARLY : 0, W8_NIT); __syncthreads(); }
}

__device__ __forceinline__ void conv_gate_phase(Frame& F, const Inputs& I, unsigned char* ws) {
    const bf16* Bg = (const bf16*)(ws + WS_R1); const bf16* U = Bg + (size_t)M * D; bf16* Gb = (bf16*)(ws + WS_GO);
    const int rsub = F.tid >> 7, ch = (F.tid & 127) * 8;
    f32x4 w[3][2];
#pragma unroll
    for (int j = 0; j < 3; ++j) { w[j][0] = *(const f32x4*)(I.conv_w + j * D + ch); w[j][1] = *(const f32x4*)(I.conv_w + j * D + ch + 4); }
    for (int rb = F.vcu; rb < M / 64; rb += F.G) {
        const int r0 = rb * 64 + rsub * 16;
        float up[8], uc[8], un[8];
#define LOADU(dst, row) do { const v4u uv = *(const v4u*)(U + (size_t)(row) * D + ch); \
        _Pragma("unroll") for (int q = 0; q < 4; ++q) { const unsigned uw_ = uv[q]; dst[2 * q] = __uint_as_float(uw_ << 16); dst[2 * q + 1] = __uint_as_float(uw_ & 0xffff0000u); } } while (0)
        if ((r0 & (SEQ - 1)) == 0) {
#pragma unroll
            for (int q = 0; q < 8; ++q) up[q] = 0.f; } else LOADU(up, r0 - 1);
        LOADU(uc, r0);
        for (int i = 0; i < 16; ++i) {
            const int r = r0 + i;
            if ((r & (SEQ - 1)) == SEQ - 1) {
#pragma unroll
                for (int q = 0; q < 8; ++q) un[q] = 0.f; } else LOADU(un, r + 1);
            const v4u bv = *(const v4u*)(Bg + (size_t)r * D + ch);
            float g[8];
#pragma unroll
            for (int q = 0; q < 8; ++q) { const float cv = w[0][q >> 2][q & 3] * up[q] + w[1][q >> 2][q & 3] * uc[q] + w[2][q >> 2][q & 3] * un[q];
                const unsigned bw = bv[q >> 1]; const float bg = (q & 1) ? __uint_as_float(bw & 0xffff0000u) : __uint_as_float(bw << 16); g[q] = bg * cv; }
            v4u o; o.x = pk2(g[0], g[1]); o.y = pk2(g[2], g[3]); o.z = pk2(g[4], g[5]); o.w = pk2(g[6], g[7]);
            *(v4u*)(Gb + (size_t)r * D + ch) = o;
#pragma unroll
            for (int q = 0; q < 8; ++q) { up[q] = uc[q]; uc[q] = un[q]; }
        }
#undef LOADU
    }
}

__device__ __forceinline__ void router_phase(Frame& F, const bf16* XBs, unsigned char* ws) {
    LAS float* Rt = (LAS float*)(F.lds + RING_OFF);
    LAS int* hist = (LAS int*)(F.lds + RING_OFF + 32768);
    const f32x4* RG = (const f32x4*)(ws + WS_RG);
    for (int i = F.tid; i < 2 * D; i += NWAVES * 64) ((LAS f32x4*)Rt)[i] = RG[i];
    if (F.tid < 8) hist[F.tid] = 0;
    __syncthreads();
    int* TOK_E = (int*)(ws + WS_TOKE); float* TOK_G = (float*)(ws + WS_TOKG); float* TOK_RS = (float*)(ws + WS_TOKRS); int* HIST = (int*)(ws + WS_HIST);
    for (int tb = F.vcu; tb < M / 64; tb += F.G) {
        for (int i4 = 0; i4 < 8; i4 += 4) {
            v4u xa[4], xb_[4];
#pragma unroll
            for (int q = 0; q < 4; ++q) { const v4u* xr = (const v4u*)(XBs + (size_t)(tb * 64 + F.wave * 8 + i4 + q) * D); xa[q] = xr[F.lane]; xb_[q] = xr[64 + F.lane]; }
#pragma unroll
            for (int q = 0; q < 4; ++q) { const int token = tb * 64 + F.wave * 8 + i4 + q;
                float x[16];
#pragma unroll
                for (int j = 0; j < 4; ++j) { x[2 * j] = __uint_as_float(xa[q][j] << 16); x[2 * j + 1] = __uint_as_float(xa[q][j] & 0xffff0000u); x[8 + 2 * j] = __uint_as_float(xb_[q][j] << 16); x[9 + 2 * j] = __uint_as_float(xb_[q][j] & 0xffff0000u); }
                float ss = 0.f;
#pragma unroll
                for (int j = 0; j < 16; ++j) ss += x[j] * x[j];
                float acc[8];
#pragma unroll
                for (int e = 0; e < 8; ++e) { const LAS f32x4* r = (const LAS f32x4*)(Rt + e * D + 8 * F.lane); const f32x4 r0 = r[0], r1 = r[1], r2 = r[128], r3 = r[129];
                    acc[e] = ((x[0] * r0[0] + x[1] * r0[1]) + (x[2] * r0[2] + x[3] * r0[3])) + ((x[4] * r1[0] + x[5] * r1[1]) + (x[6] * r1[2] + x[7] * r1[3]))
                           + (((x[8] * r2[0] + x[9] * r2[1]) + (x[10] * r2[2] + x[11] * r2[3])) + ((x[12] * r3[0] + x[13] * r3[1]) + (x[14] * r3[2] + x[15] * r3[3]))); }
                ss = wave_sum(ss); const float rs = __builtin_amdgcn_rsqf(ss * (1.0f / D) + 1e-6f);
#pragma unroll
                for (int e = 0; e < 8; ++e) acc[e] = wave_sum(acc[e]) * rs;
                int i1 = 0; float v1 = acc[0];
#pragma unroll
                for (int e = 1; e < 8; ++e) if (acc[e] > v1) { v1 = acc[e]; i1 = e; }
                int i2 = -1; float v2 = -3.0e38f;
#pragma unroll
                for (int e = 0; e < 8; ++e) if (e != i1 && acc[e] > v2) { v2 = acc[e]; i2 = e; }
                const float g1 = 1.0f / (1.0f + __expf(v2 - v1)), g2 = 1.0f - g1;
                if (F.lane == 0) { TOK_E[token] = i1 | (i2 << 8); TOK_G[2 * token] = g1; TOK_G[2 * token + 1] = g2; TOK_RS[token] = rs;
                    atomicAdd((int*)&hist[i1], 1); atomicAdd((int*)&hist[i2], 1); }
            }
        }
        __syncthreads();
        if (F.tid < 8) { HIST[tb * 8 + F.tid] = hist[F.tid]; hist[F.tid] = 0; }
        __syncthreads();
    }
}

__device__ __forceinline__ void dispatch_phase(Frame& F, unsigned char* ws) {
    LAS int* pre = (LAS int*)(F.lds + RING_OFF);
    LAS int* tot = pre + 2048; LAS int* off = tot + 8;
    LAS int* lpos = off + 16;
    const int* HIST = (const int*)(ws + WS_HIST); const int* TOK_E = (const int*)(ws + WS_TOKE); const float* TOK_G = (const float*)(ws + WS_TOKG); const float* TOK_RS = (const float*)(ws + WS_TOKRS);
    int* TOK_SLOT = (int*)(ws + WS_TOKSLOT); float* SLOT_RS = (float*)(ws + WS_SLOTRS); float* SLOT_G = (float*)(ws + WS_SLOTG); int* META = (int*)(ws + WS_META);
    const bf16* XB = (const bf16*)(ws + WS_XB); unsigned char* HG = ws + WS_HG;
    {
      const int e = F.wave; int h[4];
#pragma unroll
      for (int k = 0; k < 4; ++k) h[k] = HIST[(4 * F.lane + k) * 8 + e];
      const int T = (h[0] + h[1]) + (h[2] + h[3]); int inc = T;
#pragma unroll
      for (int d = 1; d < 64; d <<= 1) { const int o = __shfl_up(inc, d); if (F.lane >= d) inc += o; }
      int run = inc - T;
#pragma unroll
      for (int k = 0; k < 4; ++k) { pre[(4 * F.lane + k) * 8 + e] = run; run += h[k]; }
      if (F.lane == 63) tot[e] = inc; }
    __syncthreads();
    if (F.tid == 0) { int o = 0; for (int e = 0; e < 8; ++e) { off[e] = o; o += (tot[e] + 255) & ~255; } off[8] = o; }
    __syncthreads();
    if (F.vcu == 0 && F.tid < 160) {
        if (F.tid == 0) META[0] = off[8] >> 8;
        const int t = F.tid; int e = 0;
#pragma unroll
        for (int q = 1; q < 8; ++q) if (t * 256 >= off[q]) e = q;
        META[16 + t] = e;
    }
    for (int tb = F.vcu; tb < M / 64; tb += F.G) {
        if (F.wave == 0) {
            const int token = tb * 64 + F.lane; const int te = TOK_E[token]; const int e1 = te & 255, e2 = te >> 8; const float g1 = TOK_G[2 * token], g2 = TOK_G[2 * token + 1], rs = TOK_RS[token];
#pragma unroll
            for (int e = 0; e < 8; ++e) { const bool has = (e1 == e) || (e2 == e); const unsigned long long mask = __ballot(has);
                const int rank = __popcll(mask & ((1ull << F.lane) - 1ull));
                if (has) { const int which = (e1 == e) ? 0 : 1; const int pos = off[e] + pre[tb * 8 + e] + rank;
                    SLOT_RS[pos] = rs * (1.0f / W8_SCALE); SLOT_G[pos] = (which ? g2 : g1) * (1.0f / (W8_SCALE * H8_SCALE));   TOK_SLOT[2 * token + which] = pos; lpos[2 * F.lane + which] = pos; } }
        }
        __syncthreads();
        for (int p4 = F.wave * 16; p4 < F.wave * 16 + 16; p4 += 4) {
            v4u s0[4], s1[4]; int pos[4];
#pragma unroll
            for (int q = 0; q < 4; ++q) { const int p = p4 + q; const v4u* src = (const v4u*)(XB + (size_t)(tb * 64 + (p >> 1)) * D); pos[q] = lpos[p]; s0[q] = src[2 * F.lane]; s1[q] = src[2 * F.lane + 1]; }
#pragma unroll
            for (int q = 0; q < 4; ++q) { v4u o;
#pragma unroll
                for (int j = 0; j < 2; ++j) { int w0 = 0, w1 = 0;
                    w0 = __builtin_amdgcn_cvt_pk_fp8_f32(__uint_as_float(s0[q][2 * j] << 16), __uint_as_float(s0[q][2 * j] & 0xffff0000u), w0, false); w0 = __builtin_amdgcn_cvt_pk_fp8_f32(__uint_as_float(s0[q][2 * j + 1] << 16), __uint_as_float(s0[q][2 * j + 1] & 0xffff0000u), w0, true);
                    w1 = __builtin_amdgcn_cvt_pk_fp8_f32(__uint_as_float(s1[q][2 * j] << 16), __uint_as_float(s1[q][2 * j] & 0xffff0000u), w1, false); w1 = __builtin_amdgcn_cvt_pk_fp8_f32(__uint_as_float(s1[q][2 * j + 1] << 16), __uint_as_float(s1[q][2 * j + 1] & 0xffff0000u), w1, true);
                    o[j] = (unsigned)w0; o[2 + j] = (unsigned)w1; }
                ((v4u*)(HG + (size_t)pos[q] * D))[F.lane] = o; } }
        __syncthreads();
    }
    if (F.vcu < 8) {
        const int e = F.vcu, p0 = off[e] + tot[e], p1 = off[e + 1];
        for (int p = p0 + F.wave; p < p1; p += NWAVES) { v4u* dst = (v4u*)(HG + (size_t)p * D); const v4u z = {0u, 0u, 0u, 0u}; dst[F.lane] = z;
            if (F.lane == 0) { SLOT_RS[p] = 0.f; SLOT_G[p] = 0.f; } }
    }
}

__device__ __forceinline__ void bf8_to_f(const v4u a, float (&f)[8]) {
#pragma unroll
    for (int j = 0; j < 4; ++j) { f[2 * j] = __uint_as_float(a[j] << 16); f[2 * j + 1] = __uint_as_float(a[j] & 0xffff0000u); }
}
__device__ __forceinline__ void y_row8(const bf16* Y, const bf16* YP, int s, int c8, float (&r)[8]) {
    if (s < MOE_T1 * 256) bf8_to_f(*((const v4u*)(Y + (size_t)s * D) + c8), r);
    else {
#pragma unroll
        for (int j = 0; j < 8; ++j) r[j] = 0.f;
        for (int p = 0; p < MOE_NSPLIT; ++p) { float t[8]; bf8_to_f(*((const v4u*)(YP + ((size_t)p * MOE_LMAX * 256 + (s - MOE_T1 * 256)) * D) + c8), t);
#pragma unroll
            for (int j = 0; j < 8; ++j) r[j] += t[j]; } }
}
__device__ __forceinline__ void combine_phase(Frame& F, float* X, const bf16* XBs, unsigned char* ws) {
    const int gw = F.vcu * NWAVES + F.wave, NGW = F.G * NWAVES;
    const int* TOK_SLOT = (const int*)(ws + WS_TOKSLOT); const bf16* Y = (const bf16*)(ws + WS_Y); const bf16* YP = (const bf16*)(ws + WS_YP);
    for (int m = gw; m < M; m += NGW) {
        const int s0 = TOK_SLOT[2 * m], s1 = TOK_SLOT[2 * m + 1];
#pragma unroll
        for (int hcol = 0; hcol < 2; ++hcol) { const int c8 = F.lane + 64 * hcol;
            float xv[8], a[8], b[8]; bf8_to_f(*((const v4u*)(XBs + (size_t)m * D) + c8), xv); y_row8(Y, YP, s0, c8, a); y_row8(Y, YP, s1, c8, b);
            f32x4 o0, o1;
#pragma unroll
            for (int j = 0; j < 4; ++j) { o0[j] = xv[j] + (a[j] + b[j]); o1[j] = xv[4 + j] + (a[4 + j] + b[4 + j]); }
            f32x4* dst = (f32x4*)(X + (size_t)m * D + 8 * c8); __builtin_nontemporal_store(o0, dst); __builtin_nontemporal_store(o1, dst + 1); }
    }
}

struct Args { Inputs in; float* out; unsigned char* ws; };
__global__ void __launch_bounds__(NWAVES * 64, 2) mk_fwd(Args args) {
    extern __shared__ __attribute__((aligned(16))) unsigned char lds[];
    Frame F;
    F.lds = (LAS unsigned char*)lds;
    F.MISC = (volatile LAS unsigned*)(F.lds + MISC_OFF);
    F.tid = threadIdx.x; F.lane = F.tid & 63; F.wave = __builtin_amdgcn_readfirstlane(F.tid >> 6);
    F.G = gridDim.x; { const int bx = blockIdx.x; F.vcu = (F.G % 8 == 0) ? (bx % 8) * (F.G / 8) + bx / 8 : bx; }
    unsigned char* ws = args.ws; const Inputs& I = args.in;
    F.ctl = (gu32*)(ws + WS_CTL);
    for (int u = F.tid; u < (LDS_BYTES - LDSCTL_OFF) / 4; u += NWAVES * 64) ((LAS unsigned*)(F.lds + LDSCTL_OFF))[u] = 0u;
    __syncthreads();
    XcdBarrier bar = xcd_barrier_post((unsigned*)(F.ctl + CW_BAR), F.MISC + 8);
#define GRID_BAR() xcd_barrier(bar)
    float* X = args.out;
    bf16* XB = (bf16*)(ws + WS_XB); bf16* R1 = (bf16*)(ws + WS_R1); bf16* GO = (bf16*)(ws + WS_GO);
    float* SSQ0 = (float*)(ws + WS_SSQ0); float* SSQP1 = (float*)(ws + WS_SSQP1); float* SSQP2 = (float*)(ws + WS_SSQP2);

    p0_prologue(F, I, ws);
    GRID_BAR();
    { pg8::Gemm g{XB, (const bf16*)(ws + WS_WCI), M, NQKV, D, 0}; pg8::StaticOrder S; S.init(M, NQKV, F.G, (int)blockIdx.x);
      pg8::EpiConvIn E{R1, R1 + (size_t)M * D, SSQ0};
      pg8::gemm_phase<pg8::EpiConvIn, pg8::StaticOrder, true, true>(F.lds + RING_OFF, g, S, E); }
    GRID_BAR();
    conv_gate_phase(F, I, ws);
    GRID_BAR();
    { pg8::Gemm g{GO, (const bf16*)(ws + WS_WCO), M, D, D, 0}; pg8::StaticOrder S; S.init(M, D, F.G, (int)blockIdx.x);
      pg8::EpiResid E{XB, SSQP1, ws + WS_X8, 1.0f};
      pg8::gemm_phase<pg8::EpiResid, pg8::StaticOrder, true, true>(F.lds + RING_OFF, g, S, E); }
    GRID_BAR();
    { pg8::Gemm g{(const bf16*)(ws + WS_X8), (const bf16*)(ws + WS_W13), M, 2 * DFF, D / 2, 0}; pg8::StaticOrder S; S.init(M, 2 * DFF, F.G, (int)blockIdx.x);
      pg8::EpiSwiGLU<0, true> E{R1, DFF, SSQP1, 0, H8_SCALE, 1.0f / W8_SCALE};
      pg8::gemm_phase<pg8::EpiSwiGLU<0, true>, pg8::StaticOrder, true, true, true>(F.lds + RING_OFF, g, S, E);
      const int ntile = (M / 256) * (2 * DFF / 256), nlast = ntile % F.G;
      if (nlast == 0) late_weight_items(F, I, ws, (int)blockIdx.x * NWAVES + F.wave, F.G * NWAVES);
      else if ((int)blockIdx.x >= nlast) { late_weight_items(F, I, ws, ((int)blockIdx.x - nlast) * NWAVES + F.wave, (F.G - nlast) * NWAVES);
        __syncthreads();
        moe_weight_items(F, I, ws, ((int)blockIdx.x - nlast) * NWAVES + F.wave, (F.G - nlast) * NWAVES, 0, W8_EARLY); } }
    GRID_BAR();
    { pg8::Gemm g{R1, (const bf16*)(ws + WS_W2), M, D, DFF / 2, 0}; pg8::StaticOrder S; S.init(M, D, F.G, (int)blockIdx.x);
      pg8::EpiResid E{XB, SSQP2, nullptr, 1.0f / (W8_SCALE * H8_SCALE)};
      pg8::gemm_phase<pg8::EpiResid, pg8::StaticOrder, true, true, true>(F.lds + RING_OFF, g, S, E); }
    GRID_BAR();
    { pg8::Gemm g{XB, (const bf16*)(ws + WS_WAI), M, NQKV, D, 0}; pg8::StaticOrder S; S.init(M, NQKV, F.G, (int)blockIdx.x);
      LAS float* gtab = (LAS float*)(F.lds + LDSCTL_OFF + 2048);
      if (F.tid < 128) gtab[F.tid] = F.tid < 64 ? I.q_norm[F.tid] * pg8::QSCALE : I.k_norm[F.tid - 64];
      __syncthreads();
      pg8::EpiQKV E{R1, R1 + (size_t)M * D, R1 + (size_t)2 * M * D, SSQP2, gtab, (const float*)(ws + WS_ROPE)};
      pg8::gemm_phase<pg8::EpiQKV, pg8::StaticOrder, true, true>(F.lds + RING_OFF, g, S, E); }
    GRID_BAR();
    { const float* C = (const float*)(ws + WS_CONST); const float lam = __uint_as_float(__builtin_amdgcn_readfirstlane(__float_as_uint(C[0]))), negmb = __uint_as_float(__builtin_amdgcn_readfirstlane(__float_as_uint(C[1])));
      const bool early_done = ((M / 256) * (2 * DFF / 256)) % F.G != 0;
      if (negmb > -96.0f) attn_phase_loop<false>(F, I, ws, R1, GO, lam, negmb, (char*)lds + RING_OFF, early_done);
      else attn_phase_loop<true>(F, I, ws, R1, GO, lam, negmb, (char*)lds + RING_OFF, early_done); }
    GRID_BAR();
    { pg8::Gemm g{GO, (const bf16*)(ws + WS_WAO), M, D, D, 0}; pg8::StaticOrder S; S.init(M, D, F.G, (int)blockIdx.x);
      pg8::EpiResid E{XB, nullptr, nullptr, 1.0f};
      pg8::gemm_phase<pg8::EpiResid, pg8::StaticOrder, true, true>(F.lds + RING_OFF, g, S, E); }
    GRID_BAR();
    router_phase(F, XB, ws);
    GRID_BAR();
    dispatch_phase(F, ws);
    GRID_BAR();
    { const int* META = (const int*)(ws + WS_META); LAS int* texp = (LAS int*)(F.lds + TEXP_OFF);
      const int ntiles = META[0];
      if (F.tid < 160) texp[F.tid] = META[16 + F.tid];
      __syncthreads();
      const bf16* HG = (const bf16*)(ws + WS_HG); bf16* HIDM = (bf16*)(ws + WS_HIDM); bf16* Y = (bf16*)(ws + WS_Y);
      const float* SLOT_RS = (const float*)(ws + WS_SLOTRS); const float* SLOT_G = (const float*)(ws + WS_SLOTG);
      { pg8::Gemm g{HG, (const bf16*)(ws + WS_WM13), 0, 0, D / 2, 0}; pg8::MoeOrder S; S.init(ntiles, 2 * DFE / 256, F.G, (int)blockIdx.x, 0, 0, texp);
        pg8::EpiSwiGLU<1, true> E{HIDM, DFE, SLOT_RS, 0, H8_SCALE, 1.0f};
        pg8::gemm_phase<pg8::EpiSwiGLU<1, true>, pg8::MoeOrder, true, true, true>(F.lds + RING_OFF, g, S, E); }
      GRID_BAR();
      { const int nfull = ntiles < MOE_T1 ? ntiles : MOE_T1;
        pg8::Gemm g{HIDM, (const bf16*)(ws + WS_WM2), 0, 0, DFE / 2, 0}; pg8::MoeOrder S; S.init(nfull, D / 256, F.G, (int)blockIdx.x, 0, 0, texp);
        pg8::EpiRowBf16<1> E{Y, D, SLOT_G, 0, 0, 0};
        pg8::gemm_phase<pg8::EpiRowBf16<1>, pg8::MoeOrder, true, true, true>(F.lds + RING_OFF, g, S, E); }
      if (ntiles > MOE_T1) {
        pg8::Gemm g{HIDM, (const bf16*)(ws + WS_WM2), 0, 0, MOE_KS / 2, DFE / 2}; pg8::SplitOrder S; S.init(ntiles - MOE_T1, D / 256, MOE_NSPLIT, MOE_KS / 2, F.G, (int)blockIdx.x, MOE_T1, MOE_T1, texp);
        pg8::EpiRowBf16<1> E{(bf16*)(ws + WS_YP), D, SLOT_G, MOE_KS / 2, (size_t)MOE_LMAX * 256 * D, MOE_T1 * 256};
        pg8::gemm_phase<pg8::EpiRowBf16<1>, pg8::SplitOrder, true, true, true>(F.lds + RING_OFF, g, S, E); }
      GRID_BAR();
    }
    combine_phase(F, X, XB, ws);
}

extern "C" void kernel_launch(void* const* d_in, const int* in_sizes, int n_in, void* d_out, int out_size, void* d_ws, size_t ws_size, hipStream_t stream) {
    static int grid = 0;
    if (grid == 0) {
        if (n_in != 23 || in_sizes[0] != M * D || out_size != M * D || ws_size < WS_END) { fprintf(stderr, "kernel_launch: shape/workspace mismatch: n_in %d in0 %d out %d ws %zu (need %zu)\n", n_in, n_in > 0 ? in_sizes[0] : -1, out_size, ws_size, (size_t)WS_END); grid = -1; return; }
        int dev = 0, cus = 0, per_cu = 0;
        if (hipGetDevice(&dev) != hipSuccess || hipDeviceGetAttribute(&cus, hipDeviceAttributeMultiprocessorCount, dev) != hipSuccess) { grid = -1; return; }
        if (hipFuncSetAttribute((const void*)mk_fwd, hipFuncAttributeMaxDynamicSharedMemorySize, LDS_BYTES) != hipSuccess) { fprintf(stderr, "kernel_launch: hipFuncSetAttribute failed\n"); grid = -1; return; }
        if (hipOccupancyMaxActiveBlocksPerMultiprocessor(&per_cu, (const void*)mk_fwd, NWAVES * 64, LDS_BYTES) != hipSuccess || per_cu < 1) fprintf(stderr, "kernel_launch: occupancy query reports %d\n", per_cu);
        (void)hipGetLastError();
        grid = cus;
    }
    if (grid < 0) return;
    if (hipMemsetAsync((char*)d_ws + WS_CTL, 0, CTL_ZERO_BYTES, stream) != hipSuccess) return;
    Args a{};
    a.in.x = (const float*)d_in[0]; a.in.positions = (const int*)d_in[1]; a.in.norm_mix = (const float*)d_in[2]; a.in.norm_ffn = (const float*)d_in[3];
    a.in.conv_in = (const float*)d_in[4]; a.in.conv_w = (const float*)d_in[5]; a.in.conv_out = (const float*)d_in[6]; a.in.attn_in = (const float*)d_in[7];
    a.in.q_norm = (const float*)d_in[8]; a.in.k_norm = (const float*)d_in[9]; a.in.lam_q1 = (const float*)d_in[10]; a.in.lam_k1 = (const float*)d_in[11];
    a.in.lam_q2 = (const float*)d_in[12]; a.in.lam_k2 = (const float*)d_in[13]; a.in.subln = (const float*)d_in[14]; a.in.attn_out = (const float*)d_in[15];
    a.in.ffn_w1 = (const float*)d_in[16]; a.in.ffn_w3 = (const float*)d_in[17]; a.in.ffn_w2 = (const float*)d_in[18]; a.in.router = (const float*)d_in[19];
    a.in.moe_w1 = (const float*)d_in[20]; a.in.moe_w3 = (const float*)d_in[21]; a.in.moe_w2 = (const float*)d_in[22];
    a.out = (float*)d_out; a.ws = (unsigned char*)d_ws;
    hipLaunchKernelGGL(mk_fwd, dim3(grid), dim3(NWAVES * 64), LDS_BYTES, stream, a);
    const hipError_t le = hipPeekAtLastError();
    if (le != hipSuccess) fprintf(stderr, "kernel_launch: launch failed: %s\n", hipGetErrorName(le));
}
```
